# Optimizing an MI355X kernel written in HIP

```python
import math
import jax, jax.numpy as jnp
from jax import lax
import numpy as np

D_MODEL = 1024
BATCH = 32
SEQ = 2048
DEPTH = 1

GRID_W = 64
CTX_LEN = 256
HEAD_DIM = 64
MIX_WIDTH = D_MODEL
DIFF_WIDTH = MIX_WIDTH // 2
NA_WIDTH = MIX_WIDTH - DIFF_WIDTH
DIFF_HEADS = DIFF_WIDTH // (2 * HEAD_DIM)
NA_HEADS = NA_WIDTH // HEAD_DIM
NA_KH_MAX = 8
NA_KW = 16
D_FF = 4 * D_MODEL
ROPE_BASE = 10000.0
ROPE_FREQS = HEAD_DIM // 4
Q_BLOCK = 128
EPS = 1e-6
NEG_INF = -1e30

kernel_name = 'hybrid_diffattn_natten_dit_block'


def rmsnorm(x, g):
    xf = x.astype(jnp.float32)
    y = xf * lax.rsqrt(jnp.mean(xf * xf, axis=-1, keepdims=True) + EPS)
    return (y * g.astype(jnp.float32)).astype(x.dtype)


def modulate(h, shift, scale):
    return h * (1.0 + scale) + shift


def adaln_chunks(cond, w_mod_l, b_mod_l):
    mod = jax.nn.silu(cond) @ w_mod_l + b_mod_l
    return jnp.split(mod, 6, axis=-1)


def squared_relu_mlp(h, w1, w2):
    return jnp.square(jax.nn.relu(h @ w1)) @ w2


def axial_rope_tables(rows, cols):
    inv = ROPE_BASE ** (-jnp.arange(ROPE_FREQS, dtype=jnp.float32) / ROPE_FREQS)
    ang = jnp.stack([rows, cols], axis=-1).astype(jnp.float32)[..., None] * inv
    return jnp.cos(ang), jnp.sin(ang)


def apply_axial_rope(x, cos, sin):
    shape = x.shape
    xr = x.reshape(shape[:-1] + (2, 2, ROPE_FREQS))
    bshape = (shape[1],) + (1,) * (x.ndim - 3) + (2, ROPE_FREQS)
    c = cos.reshape(bshape).astype(x.dtype)
    s = sin.reshape(bshape).astype(x.dtype)
    x1 = xr[..., 0, :]
    x2 = xr[..., 1, :]
    out = jnp.stack([x1 * c - x2 * s, x1 * s + x2 * c], axis=-2)
    return out.reshape(shape)


def unpack_q(q):
    B, L = q.shape[:2]
    q_d = q[..., :DIFF_WIDTH].reshape(B, L, DIFF_HEADS, 2, HEAD_DIM)
    q_n = q[..., DIFF_WIDTH:].reshape(B, L, NA_HEADS, HEAD_DIM)
    return q_d, q_n


def unpack_kv(kv):
    B, L = kv.shape[:2]
    k_d = kv[..., :DIFF_WIDTH].reshape(B, L, DIFF_HEADS, 2, HEAD_DIM)
    k_n = kv[..., DIFF_WIDTH:MIX_WIDTH].reshape(B, L, NA_HEADS, HEAD_DIM)
    v_d = kv[..., MIX_WIDTH:MIX_WIDTH + DIFF_WIDTH].reshape(B, L, DIFF_HEADS, 2 * HEAD_DIM)
    v_n = kv[..., MIX_WIDTH + DIFF_WIDTH:].reshape(B, L, NA_HEADS, HEAD_DIM)
    return k_d, k_n, v_d, v_n


def diff_lambda(lq1, lk1, lq2, lk2, lam_init):
    f = jnp.float32
    return (jnp.exp(jnp.sum(lq1.astype(f) * lk1.astype(f)))
            - jnp.exp(jnp.sum(lq2.astype(f) * lk2.astype(f))) + lam_init)


def diff_attend(qi, k, v, lam):
    s = jnp.einsum('bqhid,bkhid->bhiqk', qi, k).astype(jnp.float32) * HEAD_DIM ** -0.5
    p = jax.nn.softmax(s, axis=-1)
    a = p[:, :, 0] - lam * p[:, :, 1]
    return jnp.einsum('bhqk,bkhd->bqhd', a.astype(v.dtype), v)


def diff_head_norm(o, g, lam_init):
    return rmsnorm(o, g) * (1.0 - lam_init)


def diff_attention_latent(q, k, v, k_ctx, v_ctx, lam):
    B, S = q.shape[:2]
    keys = jnp.concatenate([k, k_ctx], axis=1)
    vals = jnp.concatenate([v, v_ctx], axis=1)
    nb = S // Q_BLOCK
    qb = jnp.moveaxis(q.reshape((B, nb, Q_BLOCK) + q.shape[2:]), 1, 0)
    o = lax.map(lambda qi: diff_attend(qi, keys, vals, lam), qb)
    return jnp.moveaxis(o, 0, 1).reshape(B, S, DIFF_HEADS, 2 * HEAD_DIM)


def softmax_attention(q, k, v):
    s = jnp.einsum('bqhd,bkhd->bhqk', q, k).astype(jnp.float32) * HEAD_DIM ** -0.5
    p = jax.nn.softmax(s, axis=-1)
    return jnp.einsum('bhqk,bkhd->bqhd', p.astype(v.dtype), v)


def neighbourhood_attention_latent(q, k, v, k_ctx, v_ctx, rpb):
    B, S, H, dh = q.shape
    rows = S // GRID_W
    kh = min(NA_KH_MAX, rows)
    qg = q.reshape(B, rows, GRID_W, H, dh)
    kg = k.reshape(B, rows, GRID_W, H, dh)
    vg = v.reshape(B, rows, GRID_W, H, dh)
    jq = jnp.arange(GRID_W)
    col_start = jnp.clip(jq - NA_KW // 2, 0, GRID_W - NA_KW)
    in_win = (jq[None, :] >= col_start[:, None]) & (jq[None, :] < col_start[:, None] + NA_KW)
    dc_idx = jnp.clip(jq[None, :] - jq[:, None] + NA_KW - 1, 0, 2 * NA_KW - 2)
    kr = jnp.arange(kh)
    scale = HEAD_DIM ** -0.5

    def row_block(r):
        start = jnp.clip(r - kh // 2, 0, rows - kh)
        q_r = lax.dynamic_index_in_dim(qg, r, axis=1, keepdims=False)
        k_s = lax.dynamic_slice_in_dim(kg, start, kh, axis=1)
        v_s = lax.dynamic_slice_in_dim(vg, start, kh, axis=1)
        s_lat = jnp.einsum('bqhd,bxkhd->bhqxk', q_r, k_s).astype(jnp.float32) * scale
        dr_idx = start + kr - r + NA_KH_MAX - 1
        bias = jnp.transpose(rpb[:, dr_idx][:, :, dc_idx], (0, 2, 1, 3))
        s_lat = jnp.where(in_win[:, None, :], s_lat + bias.astype(jnp.float32), NEG_INF)
        s_lat = s_lat.reshape(B, H, GRID_W, kh * GRID_W)
        s_ctx = jnp.einsum('bqhd,bchd->bhqc', q_r, k_ctx).astype(jnp.float32) * scale
        p = jax.nn.softmax(jnp.concatenate([s_lat, s_ctx], axis=-1), axis=-1).astype(v.dtype)
        n_lat = kh * GRID_W
        o = (jnp.einsum('bhqn,bnhd->bqhd', p[..., :n_lat], v_s.reshape(B, n_lat, H, dh))
             + jnp.einsum('bhqc,bchd->bqhd', p[..., n_lat:], v_ctx))
        return o

    o = lax.map(row_block, jnp.arange(rows))
    return jnp.moveaxis(o, 0, 1).reshape(B, S, H, dh)


def setup_inputs(seed: int = 0) -> dict:
    key = jax.random.key(seed)
    ks = jax.random.split(key, 19)

    def nrm(k, shape, s):
        return s * jax.random.normal(k, shape, jnp.float32)

    return {
        'x': nrm(ks[0], (BATCH, SEQ, D_MODEL), 1.0),
        'c': nrm(ks[1], (BATCH, D_MODEL), 1.0),
        'ctx': nrm(ks[2], (BATCH, CTX_LEN, D_MODEL), 1.0),
        'c_ctx': nrm(ks[3], (D_MODEL,), 1.0),
        'w_mod': nrm(ks[4], (DEPTH, D_MODEL, 6 * D_MODEL), 0.5 * D_MODEL ** -0.5),
        'b_mod': nrm(ks[5], (DEPTH, 6 * D_MODEL), 0.02),
        'norm1_g': 1.0 + nrm(ks[6], (DEPTH, D_MODEL), 0.02),
        'w_in': nrm(ks[7], (DEPTH, D_MODEL, 3 * MIX_WIDTH), D_MODEL ** -0.5),
        'lam_q1': nrm(ks[8], (DEPTH, HEAD_DIM), 0.1),
        'lam_k1': nrm(ks[9], (DEPTH, HEAD_DIM), 0.1),
        'lam_q2': nrm(ks[10], (DEPTH, HEAD_DIM), 0.1),
        'lam_k2': nrm(ks[11], (DEPTH, HEAD_DIM), 0.1),
        'diff_subln_g': 1.0 + nrm(ks[12], (DEPTH, 2 * HEAD_DIM), 0.02),
        'na_rpb': nrm(ks[13], (DEPTH, NA_HEADS, 2 * NA_KH_MAX - 1, 2 * NA_KW - 1), 0.1),
        'w_out': nrm(ks[14], (DEPTH, MIX_WIDTH, D_MODEL), MIX_WIDTH ** -0.5),
        'norm2_g': 1.0 + nrm(ks[15], (DEPTH, D_MODEL), 0.02),
        'w_fc1': nrm(ks[16], (DEPTH, D_MODEL, D_FF), D_MODEL ** -0.5),
        'w_fc2': nrm(ks[17], (DEPTH, D_FF, D_MODEL), D_FF ** -0.5),
        'final_g': 1.0 + nrm(ks[18], (D_MODEL,), 0.02),
    }


def reference(x, c, ctx, c_ctx, w_mod, b_mod, norm1_g, w_in, lam_q1, lam_k1, lam_q2, lam_k2,
              diff_subln_g, na_rpb, w_out, norm2_g, w_fc1, w_fc2, final_g):
    B, S, _ = x.shape
    pos = jnp.arange(S)
    cos, sin = axial_rope_tables(pos // GRID_W, pos % GRID_W)
    for l in range(DEPTH):
        lam_init = 0.8 - 0.6 * math.exp(-0.3 * l)
        lam = diff_lambda(lam_q1[l], lam_k1[l], lam_q2[l], lam_k2[l], lam_init)
        sh_a, sc_a, g_a, sh_m, sc_m, g_m = [m[:, None, :] for m in adaln_chunks(c, w_mod[l], b_mod[l])]
        csh_a, csc_a, cg_a, csh_m, csc_m, cg_m = adaln_chunks(c_ctx, w_mod[l], b_mod[l])

        h = modulate(rmsnorm(x, norm1_g[l]), sh_a, sc_a)
        hc = modulate(rmsnorm(ctx, norm1_g[l]), csh_a, csc_a)
        proj = h @ w_in[l]
        q_d, q_n = unpack_q(proj[..., :MIX_WIDTH])
        k_d, k_n, v_d, v_n = unpack_kv(proj[..., MIX_WIDTH:])
        kc_d, kc_n, vc_d, vc_n = unpack_kv(hc @ w_in[l, :, MIX_WIDTH:])
        q_d = apply_axial_rope(q_d, cos, sin)
        k_d = apply_axial_rope(k_d, cos, sin)
        o_d = diff_head_norm(diff_attention_latent(q_d, k_d, v_d, kc_d, vc_d, lam),
                             diff_subln_g[l], lam_init)
        o_n = neighbourhood_attention_latent(q_n, k_n, v_n, kc_n, vc_n, na_rpb[l])
        mixed = jnp.concatenate([o_d.reshape(B, S, DIFF_WIDTH), o_n.reshape(B, S, NA_WIDTH)], axis=-1)

        if l < DEPTH - 1:
            qc_d, qc_n = unpack_q(hc @ w_in[l, :, :MIX_WIDTH])
            oc_d = diff_head_norm(diff_attend(qc_d, kc_d, vc_d, lam), diff_subln_g[l], lam_init)
            oc_n = softmax_attention(qc_n, kc_n, vc_n)
            mixed_c = jnp.concatenate([oc_d.reshape(B, CTX_LEN, DIFF_WIDTH),
                                       oc_n.reshape(B, CTX_LEN, NA_WIDTH)], axis=-1)
            ctx = ctx + cg_a * (mixed_c @ w_out[l])
            hc2 = modulate(rmsnorm(ctx, norm2_g[l]), csh_m, csc_m)
            ctx = ctx + cg_m * squared_relu_mlp(hc2, w_fc1[l], w_fc2[l])

        x = x + g_a * (mixed @ w_out[l])
        h2 = modulate(rmsnorm(x, norm2_g[l]), sh_m, sc_m)
        x = x + g_m * squared_relu_mlp(h2, w_fc1[l], w_fc2[l])
    return rmsnorm(x, final_g)
```

```cpp
#include <hip/hip_runtime.h>
#include <cstdio>
#include <cstdint>

typedef unsigned short bf16_t;
typedef float f32x4 __attribute__((ext_vector_type(4)));
typedef float f32x2 __attribute__((ext_vector_type(2)));
typedef unsigned u32x4 __attribute__((ext_vector_type(4)));
typedef unsigned u32x2 __attribute__((ext_vector_type(2)));
typedef __bf16 bf16x2_t __attribute__((ext_vector_type(2)));

constexpr int NB = 32, SEQ = 2048, DM = 1024, CTX = 256, FF = 4096, NQKV = 3072, NKVC = 2048;
constexpr int MLAT = NB * SEQ, MCTX = NB * CTX, MALL = MLAT + MCTX;
constexpr int MODN = 6 * DM;
constexpr float EPS = 1e-6f;
constexpr float LOG2E = 1.4426950408889634f;
constexpr float C2 = 0.125f * LOG2E;
constexpr float LAM_INIT = 0.2f;
constexpr float NEGBIG = -1e30f;

constexpr size_t MiB = 1u << 20;
constexpr size_t WS_CTL = 0;
constexpr size_t WS_MOD = 1 * MiB;
constexpr size_t WS_BIAS1 = 2 * MiB;
constexpr size_t WS_ROPE = 3 * MiB;
constexpr size_t WS_LAM = 3 * MiB + 65536;
constexpr size_t WS_ZERO_BYTES = 3 * MiB;
constexpr size_t WS_SSQ1 = 4 * MiB;
constexpr size_t WS_SSQ2 = 8 * MiB;
constexpr size_t WS_WIN = 12 * MiB;
constexpr size_t WS_WOUT = 18 * MiB;
constexpr size_t WS_W1 = 20 * MiB;
constexpr size_t WS_W2 = 28 * MiB;
constexpr size_t WS_KVC = 36 * MiB;
constexpr size_t WS_A2 = 84 * MiB;
constexpr size_t WS_MIX = 212 * MiB;
constexpr size_t WS_A1 = 340 * MiB;
constexpr size_t WS_QKV = 484 * MiB;
constexpr size_t WS_HID = 340 * MiB;
constexpr size_t WS_END = 868 * MiB;

struct Params {
    const float *x, *c, *ctx, *c_ctx, *w_mod, *b_mod, *norm1_g, *w_in, *lam_q1, *lam_k1, *lam_q2, *lam_k2, *subln_g, *rpb, *w_out, *norm2_g, *w_fc1, *w_fc2, *final_g;
    float* out; unsigned char* ws;
};

__device__ __forceinline__ unsigned pk2(float lo, float hi) { f32x2 v = {lo, hi}; bf16x2_t b = __builtin_convertvector(v, bf16x2_t); return __builtin_bit_cast(unsigned, b); }
__device__ __forceinline__ float bf_lo(unsigned w) { return __uint_as_float(w << 16); }
__device__ __forceinline__ float bf_hi(unsigned w) { return __uint_as_float(w & 0xffff0000u); }
__device__ __forceinline__ float bf2f(bf16_t v) { return __uint_as_float(((unsigned)v) << 16); }
__device__ __forceinline__ float wave_sum(float v) {
#pragma unroll
    for (int o = 1; o < 64; o <<= 1) v += __shfl_xor(v, o);
    return v;
}
__device__ __forceinline__ float wave_max(float v) {
#pragma unroll
    for (int o = 1; o < 64; o <<= 1) v = fmaxf(v, __shfl_xor(v, o));
    return v;
}
__host__ __device__ __forceinline__ int win_src_col(int n) {
    const bool perm = (n < 512) || (n >= 1024 && n < 1536);
    if (!perm) return n;
    const int nd = n & 63, base = n - nd, i = nd >> 1, par = nd & 1;
    const int old = (i < 16 ? i : 32 + (i - 16)) + 16 * par;
    return base + old;
}

template <bool PERMW>
__device__ __forceinline__ void transpose_item(const float* __restrict__ W, int K, int N, bf16_t* __restrict__ WT, float* scr, int item, int lane) {
    const int nblk = N / 32, kb = item / nblk, nb = item % nblk, k0 = 64 * kb, n0 = 32 * nb;
    const int nsrc = PERMW ? win_src_col(n0 + (lane & 31)) : (n0 + (lane & 31));
#pragma unroll 8
    for (int i = 0; i < 32; ++i) { const int kk = 2 * i + (lane >> 5); scr[kk * 33 + (lane & 31)] = W[(size_t)(k0 + kk) * N + nsrc]; }
    __builtin_amdgcn_s_waitcnt(0xC07F); asm volatile("" ::: "memory");
    const int c = lane & 7;
#pragma unroll
    for (int j = 0; j < 4; ++j) { const int n = (lane >> 3) + 8 * j; const float* s = scr + (8 * c) * 33 + n;
        u32x4 o; o.x = pk2(s[0 * 33], s[1 * 33]); o.y = pk2(s[2 * 33], s[3 * 33]); o.z = pk2(s[4 * 33], s[5 * 33]); o.w = pk2(s[6 * 33], s[7 * 33]);
        *(u32x4*)(WT + (size_t)(n0 + n) * K + k0 + 8 * c) = o; }
    __builtin_amdgcn_s_waitcnt(0xC07F); asm volatile("" ::: "memory");
}
template <int NR, bool SILU>
__device__ __forceinline__ void small_mm_task(const float* __restrict__ src, size_t src_stride, const float* __restrict__ last_row, const float* __restrict__ W, int N,
                                              int k0, int n0, float* out, size_t out_stride, const float* __restrict__ bias, float* scr, int lane) {
#pragma unroll
    for (int r = 0; r < NR; ++r) {
        const float* sr = (last_row && r == NR - 1) ? last_row : src + (size_t)r * src_stride;
        float v = sr[k0 + lane];
        if (SILU) v = v / (1.0f + __expf(-v));
        scr[r * 64 + lane] = v;
    }
    __builtin_amdgcn_s_waitcnt(0xC07F); asm volatile("" ::: "memory");
    float acc[NR];
#pragma unroll
    for (int r = 0; r < NR; ++r) acc[r] = 0.f;
#pragma unroll 1
    for (int kk = 0; kk < 64; kk += 4) {
        const float w0 = W[(size_t)(k0 + kk + 0) * N + n0 + lane], w1 = W[(size_t)(k0 + kk + 1) * N + n0 + lane];
        const float w2 = W[(size_t)(k0 + kk + 2) * N + n0 + lane], w3 = W[(size_t)(k0 + kk + 3) * N + n0 + lane];
#pragma unroll
        for (int r = 0; r < NR; ++r) { const f32x4 s = *(const f32x4*)(scr + r * 64 + kk); acc[r] += s.x * w0 + s.y * w1 + s.z * w2 + s.w * w3; }
    }
    const float bv = (bias && k0 == 0) ? bias[n0 + lane] : 0.f;
#pragma unroll
    for (int r = 0; r < NR; ++r) atomicAdd(out + (size_t)r * out_stride + n0 + lane, acc[r] + bv);
    __builtin_amdgcn_s_waitcnt(0xC07F); asm volatile("" ::: "memory");
}

__device__ __forceinline__ void phase_prep_a(const Params& p, float* scr  , int gw, int NGW, int lane) {
    unsigned char* ws = p.ws;
    constexpr int T_MOD = (MODN / 64) * (DM / 64);
    constexpr int I_IN = (DM / 64) * (NQKV / 32), I_OUT = (DM / 64) * (DM / 32), I_1 = (DM / 64) * (FF / 32), I_2 = (FF / 64) * (DM / 32);
    constexpr int T_ALL = T_MOD + I_IN + I_OUT + I_1 + I_2 + 17;
    for (int t = gw; t < T_ALL; t += NGW) {
        int r = t;
        if (r < T_MOD) { const int nb = r % (MODN / 64), kc = r / (MODN / 64);
            small_mm_task<33, true>(p.c, DM, p.c_ctx, p.w_mod, MODN, kc * 64, nb * 64, (float*)(ws + WS_MOD), MODN, p.b_mod, scr, lane); continue; }
        r -= T_MOD;
        if (r < I_IN) { transpose_item<true>(p.w_in, DM, NQKV, (bf16_t*)(ws + WS_WIN), scr, r, lane); continue; } r -= I_IN;
        if (r < I_OUT) { transpose_item<false>(p.w_out, DM, DM, (bf16_t*)(ws + WS_WOUT), scr, r, lane); continue; } r -= I_OUT;
        if (r < I_1) { transpose_item<false>(p.w_fc1, DM, FF, (bf16_t*)(ws + WS_W1), scr, r, lane); continue; } r -= I_1;
        if (r < I_2) { transpose_item<false>(p.w_fc2, FF, DM, (bf16_t*)(ws + WS_W2), scr, r, lane); continue; } r -= I_2;
        if (r < 16) {
            const int pos = 4 * r + (lane >> 4), f = lane & 15;
            const float inv = powf(10000.0f, -(float)f / 16.0f);
            const float ang = (float)pos * inv;
            float* T = (float*)(ws + WS_ROPE) + (pos * 16 + f) * 2;
            T[0] = cosf(ang); T[1] = sinf(ang);
        } else {
            const float a = wave_sum(p.lam_q1[lane] * p.lam_k1[lane]), b = wave_sum(p.lam_q2[lane] * p.lam_k2[lane]);
            if (lane == 0) *(float*)(ws + WS_LAM) = expf(a) - expf(b) + LAM_INIT;
        }
    }
}
__device__ __forceinline__ void phase_prep_b(const Params& p, float* scr, int gw, int NGW, int lane) {
    unsigned char* ws = p.ws;
    const float* mod = (const float*)(ws + WS_MOD);
    constexpr int T_B1 = (FF / 64) * (DM / 64);
    for (int t = gw; t < T_B1; t += NGW) { const int nb = t % (FF / 64), kc = t / (FF / 64);
        small_mm_task<32, false>(mod + 3 * DM, MODN, nullptr, p.w_fc1, FF, kc * 64, nb * 64, (float*)(ws + WS_BIAS1), FF, nullptr, scr, lane); }
    bf16_t* A1 = (bf16_t*)(ws + WS_A1);
    for (int row = gw; row < MALL; row += NGW) {
        const float* xr; const float* mrow;
        if (row < MLAT) { xr = p.x + (size_t)row * DM; mrow = mod + (size_t)(row >> 11) * MODN; }
        else { xr = p.ctx + (size_t)(row - MLAT) * DM; mrow = mod + (size_t)32 * MODN; }
        f32x4 v[4]; float ss = 0.f;
#pragma unroll
        for (int j = 0; j < 4; ++j) { v[j] = *((const f32x4*)xr + lane + 64 * j); ss += (v[j].x * v[j].x + v[j].y * v[j].y) + (v[j].z * v[j].z + v[j].w * v[j].w); }
        const float rstd = rsqrtf(wave_sum(ss) * (1.0f / DM) + EPS);
#pragma unroll
        for (int j = 0; j < 4; ++j) {
            const int col = 4 * lane + 256 * j;
            const f32x4 g = *(const f32x4*)(p.norm1_g + col), sh = *(const f32x4*)(mrow + col), sc = *(const f32x4*)(mrow + DM + col);
            const f32x4 h = (v[j] * rstd) * g * (sc + 1.0f) + sh;
            u32x2 o; o.x = pk2(h.x, h.y); o.y = pk2(h.z, h.w);
            *(u32x2*)(A1 + (size_t)row * DM + col) = o;
        }
    }
}
__global__ __launch_bounds__(512) void k_prep_a(Params p) {
    __shared__ __attribute__((aligned(16))) float scr[8][2112];
    const int wid = threadIdx.x >> 6, lane = threadIdx.x & 63;
    phase_prep_a(p, scr[wid], blockIdx.x * 8 + wid, gridDim.x * 8, lane);
}
__global__ __launch_bounds__(512) void k_prep_b(Params p) {
    __shared__ __attribute__((aligned(16))) float scr[8][2112];
    const int wid = threadIdx.x >> 6, lane = threadIdx.x & 63;
    phase_prep_b(p, scr[wid], blockIdx.x * 8 + wid, gridDim.x * 8, lane);
}

struct E_QKV {
    static constexpr bool SSQ = false;
    bf16_t* qkv; bf16_t* kvc; const float* rope;
    struct Col {};
    __device__ __forceinline__ float rowval(int) const { return 0.f; }
    __device__ __forceinline__ Col col_prep(int, int) const { return Col{}; }
    __device__ __forceinline__ float epi8(int row, int col0, const Col&, const float (&a)[8], float) const {
        float v[8];
#pragma unroll
        for (int j = 0; j < 8; ++j) v[j] = a[j];
        if (row < MLAT) {
            const bool rope_cols = (col0 < 512) || (col0 >= 1024 && col0 < 1536);
            if (rope_cols) {
                const int s = row & (SEQ - 1), gr = s >> 6, gc = s & 63;
                const int i0 = (col0 & 63) >> 1, pos = (i0 >= 16) ? gc : gr, f0 = i0 & 15;
                const f32x4* T = (const f32x4*)(rope + (pos * 16 + f0) * 2);
                const f32x4 t0 = T[0], t1 = T[1];
                const float cs[4] = {t0.x, t0.z, t1.x, t1.z}, sn[4] = {t0.y, t0.w, t1.y, t1.w};
#pragma unroll
                for (int q = 0; q < 4; ++q) { const float x1 = v[2 * q], x2 = v[2 * q + 1]; v[2 * q] = x1 * cs[q] - x2 * sn[q]; v[2 * q + 1] = x1 * sn[q] + x2 * cs[q]; }
            }
            if (col0 < 1024) {
#pragma unroll
                for (int j = 0; j < 8; ++j) v[j] *= C2;
            }
            u32x4 o; o.x = pk2(v[0], v[1]); o.y = pk2(v[2], v[3]); o.z = pk2(v[4], v[5]); o.w = pk2(v[6], v[7]);
            *(u32x4*)(qkv + (size_t)row * NQKV + col0) = o;
        } else if (col0 >= 1024) {
            u32x4 o; o.x = pk2(v[0], v[1]); o.y = pk2(v[2], v[3]); o.z = pk2(v[4], v[5]); o.w = pk2(v[6], v[7]);
            *(u32x4*)(kvc + (size_t)(row - MLAT) * NKVC + (col0 - 1024)) = o;
        }
        return 0.f;
    }
};
struct E_OUT {
    static constexpr bool SSQ = true;
    const float* x; float* x1; bf16_t* a2; const float* mod; const float* g2;
    struct Col { float ga[8], gm[8]; };
    __device__ __forceinline__ float rowval(int) const { return 0.f; }
    __device__ __forceinline__ Col col_prep(int b, int col0) const {
        Col c; const float* m = mod + (size_t)b * MODN;
#pragma unroll
        for (int j = 0; j < 8; ++j) { c.ga[j] = m[2 * DM + col0 + j]; c.gm[j] = g2[col0 + j] * (1.0f + m[4 * DM + col0 + j]); }
        return c;
    }
    __device__ __forceinline__ float epi8(int row, int col0, const Col& c, const float (&a)[8], float) const {
        const size_t off = (size_t)row * DM + col0;
        const f32x4 x0 = *(const f32x4*)(x + off), x4 = *(const f32x4*)(x + off + 4);
        float v[8] = {x0.x, x0.y, x0.z, x0.w, x4.x, x4.y, x4.z, x4.w}; float ss = 0.f;
#pragma unroll
        for (int j = 0; j < 8; ++j) { v[j] += c.ga[j] * a[j]; ss += v[j] * v[j]; }
        *(f32x4*)(x1 + off) = (f32x4){v[0], v[1], v[2], v[3]}; *(f32x4*)(x1 + off + 4) = (f32x4){v[4], v[5], v[6], v[7]};
        u32x4 o; o.x = pk2(v[0] * c.gm[0], v[1] * c.gm[1]); o.y = pk2(v[2] * c.gm[2], v[3] * c.gm[3]); o.z = pk2(v[4] * c.gm[4], v[5] * c.gm[5]); o.w = pk2(v[6] * c.gm[6], v[7] * c.gm[7]);
        *(u32x4*)(a2 + off) = o;
        return ss;
    }
};
struct E_FC1 {
    static constexpr bool SSQ = false;
    const float* ssq1; const float* bias1; bf16_t* hid;
    struct Col { float bs[8]; };
    __device__ __forceinline__ float rowval(int row) const {
        const f32x4* s = (const f32x4*)(ssq1 + (size_t)row * 16); const f32x4 a = s[0], b = s[1], c = s[2], d = s[3];
        const float t = ((a.x + a.y) + (a.z + a.w)) + ((b.x + b.y) + (b.z + b.w)) + ((c.x + c.y) + (c.z + c.w)) + ((d.x + d.y) + (d.z + d.w));
        return rsqrtf(t * (1.0f / DM) + EPS);
    }
    __device__ __forceinline__ Col col_prep(int b, int col0) const { Col c;
#pragma unroll
        for (int j = 0; j < 8; ++j) c.bs[j] = bias1[(size_t)b * FF + col0 + j];
        return c; }
    __device__ __forceinline__ float epi8(int row, int col0, const Col& c, const float (&a)[8], float rv) const {
        float v[8];
#pragma unroll
        for (int j = 0; j < 8; ++j) { const float z = fmaxf(rv * a[j] + c.bs[j], 0.f); v[j] = z * z; }
        u32x4 o; o.x = pk2(v[0], v[1]); o.y = pk2(v[2], v[3]); o.z = pk2(v[4], v[5]); o.w = pk2(v[6], v[7]);
        *(u32x4*)(hid + (size_t)row * FF + col0) = o;
        return 0.f;
    }
};
struct E_FC2 {
    static constexpr bool SSQ = true;
    float* xio; const float* mod;
    struct Col { float gm[8]; };
    __device__ __forceinline__ float rowval(int) const { return 0.f; }
    __device__ __forceinline__ Col col_prep(int b, int col0) const { Col c; const float* m = mod + (size_t)b * MODN + 5 * DM + col0;
#pragma unroll
        for (int j = 0; j < 8; ++j) c.gm[j] = m[j];
        return c; }
    __device__ __forceinline__ float epi8(int row, int col0, const Col& c, const float (&a)[8], float) const {
        const size_t off = (size_t)row * DM + col0;
        const f32x4 x0 = *(const f32x4*)(xio + off), x4 = *(const f32x4*)(xio + off + 4);
        float v[8] = {x0.x, x0.y, x0.z, x0.w, x4.x, x4.y, x4.z, x4.w}; float ss = 0.f;
#pragma unroll
        for (int j = 0; j < 8; ++j) { v[j] += c.gm[j] * a[j]; ss += v[j] * v[j]; }
        *(f32x4*)(xio + off) = (f32x4){v[0], v[1], v[2], v[3]}; *(f32x4*)(xio + off + 4) = (f32x4){v[4], v[5], v[6], v[7]};
        return ss;
    }
};

template <class E8>
__global__ __launch_bounds__(256) void k_gemm_slow(const bf16_t* __restrict__ A, const bf16_t* __restrict__ Bt, int M, int N, int K, int ctx_skip_cols, E8 e) {
    const int col0 = (blockIdx.x * 32 + (threadIdx.x & 31)) * 8;
    const int row0 = (blockIdx.y * 8 + (threadIdx.x >> 5)) * 4;
    if (row0 >= M || col0 >= N) return;
    if (row0 >= MLAT && col0 < ctx_skip_cols) return;
    float acc[4][8];
#pragma unroll
    for (int r = 0; r < 4; ++r)
#pragma unroll
        for (int j = 0; j < 8; ++j) acc[r][j] = 0.f;
    for (int k = 0; k < K; k += 8) {
        u32x4 av[4], bv[8];
#pragma unroll
        for (int r = 0; r < 4; ++r) av[r] = *(const u32x4*)(A + (size_t)(row0 + r) * K + k);
#pragma unroll
        for (int j = 0; j < 8; ++j) bv[j] = *(const u32x4*)(Bt + (size_t)(col0 + j) * K + k);
#pragma unroll
        for (int r = 0; r < 4; ++r)
#pragma unroll
            for (int j = 0; j < 8; ++j) {
                acc[r][j] += bf_lo(av[r].x) * bf_lo(bv[j].x) + bf_hi(av[r].x) * bf_hi(bv[j].x) + bf_lo(av[r].y) * bf_lo(bv[j].y) + bf_hi(av[r].y) * bf_hi(bv[j].y)
                           + bf_lo(av[r].z) * bf_lo(bv[j].z) + bf_hi(av[r].z) * bf_hi(bv[j].z) + bf_lo(av[r].w) * bf_lo(bv[j].w) + bf_hi(av[r].w) * bf_hi(bv[j].w);
            }
    }
    const int b = (row0 < MLAT) ? (row0 >> 11) : 0;
    const typename E8::Col cc = e.col_prep(b, col0);
#pragma unroll
    for (int r = 0; r < 4; ++r) { const float rv = e.rowval(row0 + r); (void)e.epi8(row0 + r, col0, cc, acc[r], rv); }
}
__global__ __launch_bounds__(512) void k_ssq_slow(const float* __restrict__ xin, float* __restrict__ ssq) {
    const int lane = threadIdx.x & 63, row = blockIdx.x * 8 + (threadIdx.x >> 6);
    float ss = 0.f;
#pragma unroll
    for (int j = 0; j < 4; ++j) { const f32x4 v = *((const f32x4*)(xin + (size_t)row * DM) + lane + 64 * j); ss += (v.x * v.x + v.y * v.y) + (v.z * v.z + v.w * v.w); }
    ss = wave_sum(ss);
    if (lane < 16) ssq[(size_t)row * 16 + lane] = (lane == 0) ? ss : 0.f;
}
__device__ __forceinline__ void phase_final(const Params& p, int gw, int NGW, int lane) {
    const float* ssq2 = (const float*)(p.ws + WS_SSQ2);
    for (int row = gw; row < MLAT; row += NGW) {
        const float sv = (lane < 16) ? ssq2[(size_t)row * 16 + lane] : 0.f;
        const float rstd = rsqrtf(wave_sum(sv) * (1.0f / DM) + EPS);
        float* o = p.out + (size_t)row * DM;
#pragma unroll
        for (int j = 0; j < 4; ++j) { const int col = 4 * lane + 256 * j; const f32x4 v = *(const f32x4*)(o + col), g = *(const f32x4*)(p.final_g + col); *(f32x4*)(o + col) = v * rstd * g; }
    }
}
__global__ __launch_bounds__(512) void k_final(Params p) { phase_final(p, blockIdx.x * 8 + (threadIdx.x >> 6), gridDim.x * 8, threadIdx.x & 63); }

__global__ __launch_bounds__(512) void k_attn_slow(Params p) {
    __shared__ float sq[8][128];
    const int wid = threadIdx.x >> 6, lane = threadIdx.x & 63;
    const long gwl = (long)blockIdx.x * 8 + wid;
    const int slot = (int)(gwl % 12), tok = (int)(gwl / 12), b = tok >> 11, s = tok & (SEQ - 1);
    const bf16_t* qkv = (const bf16_t*)(p.ws + WS_QKV); const bf16_t* kvc = (const bf16_t*)(p.ws + WS_KVC); bf16_t* mix = (bf16_t*)(p.ws + WS_MIX);
    float* q = sq[wid];
    if (slot < 4) {
        const int h = slot;
        const bf16_t* qrow = qkv + (size_t)tok * NQKV + 128 * h;
        q[lane] = bf2f(qrow[lane]); q[64 + lane] = bf2f(qrow[64 + lane]);
        float m0 = NEGBIG, m1 = NEGBIG, l0 = 0.f, l1 = 0.f, o0a = 0.f, o0b = 0.f, o1a = 0.f, o1b = 0.f;
        for (int t = 0; t < 36; ++t) {
            const bf16_t* krow; const bf16_t* vbase; int vpitch;
            if (t < 32) { krow = qkv + (size_t)(b * SEQ + t * 64 + lane) * NQKV + 1024 + 128 * h; vbase = qkv + (size_t)(b * SEQ + t * 64) * NQKV + 2048 + 128 * h; vpitch = NQKV; }
            else { krow = kvc + (size_t)(b * CTX + (t - 32) * 64 + lane) * NKVC + 128 * h; vbase = kvc + (size_t)(b * CTX + (t - 32) * 64) * NKVC + 1024 + 128 * h; vpitch = NKVC; }
            float s0 = 0.f, s1 = 0.f;
#pragma unroll
            for (int d = 0; d < 64; d += 8) {
                const u32x4 k0 = *(const u32x4*)(krow + d), k1 = *(const u32x4*)(krow + 64 + d);
                const f32x4 qa = *(const f32x4*)(q + d), qb = *(const f32x4*)(q + d + 4), qc = *(const f32x4*)(q + 64 + d), qd = *(const f32x4*)(q + 64 + d + 4);
                s0 += qa.x * bf_lo(k0.x) + qa.y * bf_hi(k0.x) + qa.z * bf_lo(k0.y) + qa.w * bf_hi(k0.y) + qb.x * bf_lo(k0.z) + qb.y * bf_hi(k0.z) + qb.z * bf_lo(k0.w) + qb.w * bf_hi(k0.w);
                s1 += qc.x * bf_lo(k1.x) + qc.y * bf_hi(k1.x) + qc.z * bf_lo(k1.y) + qc.w * bf_hi(k1.y) + qd.x * bf_lo(k1.z) + qd.y * bf_hi(k1.z) + qd.z * bf_lo(k1.w) + qd.w * bf_hi(k1.w);
            }
            const float n0 = fmaxf(m0, wave_max(s0)), n1 = fmaxf(m1, wave_max(s1));
            const float a0 = exp2f(m0 - n0), a1 = exp2f(m1 - n1), p0 = exp2f(s0 - n0), p1 = exp2f(s1 - n1);
            l0 = l0 * a0 + wave_sum(p0); l1 = l1 * a1 + wave_sum(p1); m0 = n0; m1 = n1;
            o0a *= a0; o0b *= a0; o1a *= a1; o1b *= a1;
            for (int j = 0; j < 64; ++j) {
                const float pj0 = __shfl(p0, j), pj1 = __shfl(p1, j);
                const unsigned vv = *(const unsigned*)(vbase + (size_t)j * vpitch + 2 * lane);
                const float va = bf_lo(vv), vb = bf_hi(vv);
                o0a += pj0 * va; o0b += pj0 * vb; o1a += pj1 * va; o1b += pj1 * vb;
            }
        }
        const float lam = *(const float*)(p.ws + WS_LAM);
        const float oa = o0a / l0 - lam * (o1a / l1), ob = o0b / l0 - lam * (o1b / l1);
        const float rstd = rsqrtf(wave_sum(oa * oa + ob * ob) * (1.0f / 128.0f) + EPS);
        const float ya = oa * rstd * p.subln_g[2 * lane] * (1.0f - LAM_INIT), yb = ob * rstd * p.subln_g[2 * lane + 1] * (1.0f - LAM_INIT);
        *(unsigned*)(mix + (size_t)tok * DM + 128 * h + 2 * lane) = pk2(ya, yb);
    } else {
        const int hh = slot - 4;
        const bf16_t* qrow = qkv + (size_t)tok * NQKV + 512 + 64 * hh;
        q[lane] = bf2f(qrow[lane]);
        const int gr = s >> 6, jq = s & 63;
        const int start = min(max(gr - 4, 0), 24), cs = min(max(jq - 8, 0), 48);
        float m = NEGBIG, l = 0.f, o = 0.f;
        for (int t = 0; t < 6; ++t) {
            const bf16_t* krow; float bias = 0.f;
            if (t < 2) { const int idx = t * 64 + lane, kr = start + (idx >> 4), jk = cs + (idx & 15);
                krow = qkv + (size_t)(b * SEQ + kr * 64 + jk) * NQKV + 1536 + 64 * hh;
                bias = p.rpb[(hh * 15 + (kr - gr + 7)) * 31 + (jk - jq + 15)] * LOG2E; }
            else krow = kvc + (size_t)(b * CTX + (t - 2) * 64 + lane) * NKVC + 512 + 64 * hh;
            float sc = 0.f;
#pragma unroll
            for (int d = 0; d < 64; d += 8) {
                const u32x4 k0 = *(const u32x4*)(krow + d);
                const f32x4 qa = *(const f32x4*)(q + d), qb = *(const f32x4*)(q + d + 4);
                sc += qa.x * bf_lo(k0.x) + qa.y * bf_hi(k0.x) + qa.z * bf_lo(k0.y) + qa.w * bf_hi(k0.y) + qb.x * bf_lo(k0.z) + qb.y * bf_hi(k0.z) + qb.z * bf_lo(k0.w) + qb.w * bf_hi(k0.w);
            }
            sc += bias;
            const float n = fmaxf(m, wave_max(sc)), a = exp2f(m - n), pp = exp2f(sc - n);
            l = l * a + wave_sum(pp); m = n; o *= a;
            for (int j = 0; j < 64; ++j) {
                const float pj = __shfl(pp, j);
                const bf16_t* vrow;
                if (t < 2) { const int idx = t * 64 + j, kr = start + (idx >> 4), jk = cs + (idx & 15); vrow = qkv + (size_t)(b * SEQ + kr * 64 + jk) * NQKV + 2560 + 64 * hh; }
                else vrow = kvc + (size_t)(b * CTX + (t - 2) * 64 + j) * NKVC + 1536 + 64 * hh;
                o += pj * bf2f(vrow[lane]);
            }
        }
        const float y = o / l;
        const float yn = __shfl_down(y, 1);
        if ((lane & 1) == 0) *(unsigned*)(mix + (size_t)tok * DM + 512 + 64 * hh + lane) = pk2(y, yn);
    }
}

extern "C" void kernel_launch(void* const* d_in, const int* in_sizes, int n_in, void* d_out, int out_size, void* d_ws, size_t ws_size, hipStream_t stream) {
    if (n_in != 19 || in_sizes[0] != MLAT * DM || out_size != MLAT * DM || ws_size < WS_END) {
        fprintf(stderr, "kernel_launch: unexpected shapes: n_in %d in0 %d out %d ws %zu (need %zu)\n", n_in, n_in > 0 ? in_sizes[0] : -1, out_size, ws_size, (size_t)WS_END);
        return;
    }
    Params p{};
    const float** pf = (const float**)&p;
    for (int i = 0; i < 19; ++i) pf[i] = (const float*)d_in[i];
    p.out = (float*)d_out; p.ws = (unsigned char*)d_ws;
    unsigned char* ws = p.ws;
    hipMemsetAsync(ws, 0, WS_ZERO_BYTES, stream);
    hipLaunchKernelGGL(k_prep_a, dim3(256), dim3(512), 0, stream, p);
    hipLaunchKernelGGL(k_prep_b, dim3(256), dim3(512), 0, stream, p);
    {   E_QKV e{(bf16_t*)(ws + WS_QKV), (bf16_t*)(ws + WS_KVC), (const float*)(ws + WS_ROPE)};
        hipLaunchKernelGGL(k_gemm_slow<E_QKV>, dim3(NQKV / 256, MALL / 32), dim3(256), 0, stream, (const bf16_t*)(ws + WS_A1), (const bf16_t*)(ws + WS_WIN), MALL, NQKV, DM, 1024, e); }
    hipLaunchKernelGGL(k_attn_slow, dim3(MLAT * 12 / 8), dim3(512), 0, stream, p);
    {   E_OUT e{p.x, p.out, (bf16_t*)(ws + WS_A2), (const float*)(ws + WS_MOD), p.norm2_g};
        hipLaunchKernelGGL(k_gemm_slow<E_OUT>, dim3(DM / 256, MLAT / 32), dim3(256), 0, stream, (const bf16_t*)(ws + WS_MIX), (const bf16_t*)(ws + WS_WOUT), MLAT, DM, DM, 0, e); }
    hipLaunchKernelGGL(k_ssq_slow, dim3(MLAT / 8), dim3(512), 0, stream, (const float*)p.out, (float*)(ws + WS_SSQ1));
    {   E_FC1 e{(const float*)(ws + WS_SSQ1), (const float*)(ws + WS_BIAS1), (bf16_t*)(ws + WS_HID)};
        hipLaunchKernelGGL(k_gemm_slow<E_FC1>, dim3(FF / 256, MLAT / 32), dim3(256), 0, stream, (const bf16_t*)(ws + WS_A2), (const bf16_t*)(ws + WS_W1), MLAT, FF, DM, 0, e); }
    {   E_FC2 e{p.out, (const float*)(ws + WS_MOD)};
        hipLaunchKernelGGL(k_gemm_slow<E_FC2>, dim3(DM / 256, MLAT / 32), dim3(256), 0, stream, (const bf16_t*)(ws + WS_HID), (const bf16_t*)(ws + WS_W2), MLAT, DM, FF, 0, e); }
    hipLaunchKernelGGL(k_ssq_slow, dim3(MLAT / 8), dim3(512), 0, stream, (const float*)p.out, (float*)(ws + WS_SSQ2));
    hipLaunchKernelGGL(k_final, dim3(2048), dim3(512), 0, stream, p);
}
```

```cpp
#include <hip/hip_runtime.h>
#include <cstdio>
#include <cstdint>

typedef unsigned short bf16_t;
typedef float f32x4 __attribute__((ext_vector_type(4)));
typedef float f32x2 __attribute__((ext_vector_type(2)));
typedef unsigned u32x4 __attribute__((ext_vector_type(4)));
typedef unsigned u32x2 __attribute__((ext_vector_type(2)));
typedef __bf16 bf16x2_t __attribute__((ext_vector_type(2)));

constexpr int NB = 32, SEQ = 2048, DM = 1024, CTX = 256, FF = 4096, NQKV = 3072, NKVC = 2048;
constexpr int MLAT = NB * SEQ, MCTX = NB * CTX, MALL = MLAT + MCTX;
constexpr int MODN = 6 * DM;
constexpr float EPS = 1e-6f;
constexpr float LOG2E = 1.4426950408889634f;
constexpr float C2 = 0.125f * LOG2E;
constexpr float LAM_INIT = 0.2f;
constexpr float NEGBIG = -1e30f;

constexpr size_t MiB = 1u << 20;
constexpr size_t WS_CTL = 0;
constexpr size_t WS_MOD = 1 * MiB;
constexpr size_t WS_BIAS1 = 2 * MiB;
constexpr size_t WS_ROPE = 3 * MiB;
constexpr size_t WS_LAM = 3 * MiB + 65536;
constexpr size_t WS_ZERO_BYTES = 3 * MiB;
constexpr size_t WS_SSQ1 = 4 * MiB;
constexpr size_t WS_SSQ2 = 8 * MiB;
constexpr size_t WS_WIN = 12 * MiB;
constexpr size_t WS_WOUT = 18 * MiB;
constexpr size_t WS_W1 = 20 * MiB;
constexpr size_t WS_W2 = 28 * MiB;
constexpr size_t WS_KVC = 36 * MiB;
constexpr size_t WS_A2 = 84 * MiB;
constexpr size_t WS_MIX = 212 * MiB;
constexpr size_t WS_A1 = 340 * MiB;
constexpr size_t WS_QKV = 484 * MiB;
constexpr size_t WS_HID = 340 * MiB;
constexpr size_t WS_END = 868 * MiB;

struct Params {
    const float *x, *c, *ctx, *c_ctx, *w_mod, *b_mod, *norm1_g, *w_in, *lam_q1, *lam_k1, *lam_q2, *lam_k2, *subln_g, *rpb, *w_out, *norm2_g, *w_fc1, *w_fc2, *final_g;
    float* out; unsigned char* ws;
};

__device__ __forceinline__ unsigned pk2(float lo, float hi) { f32x2 v = {lo, hi}; bf16x2_t b = __builtin_convertvector(v, bf16x2_t); return __builtin_bit_cast(unsigned, b); }
__device__ __forceinline__ float bf_lo(unsigned w) { return __uint_as_float(w << 16); }
__device__ __forceinline__ float bf_hi(unsigned w) { return __uint_as_float(w & 0xffff0000u); }
__device__ __forceinline__ float bf2f(bf16_t v) { return __uint_as_float(((unsigned)v) << 16); }
__device__ __forceinline__ float wave_sum(float v) {
#pragma unroll
    for (int o = 1; o < 64; o <<= 1) v += __shfl_xor(v, o);
    return v;
}
__device__ __forceinline__ float wave_max(float v) {
#pragma unroll
    for (int o = 1; o < 64; o <<= 1) v = fmaxf(v, __shfl_xor(v, o));
    return v;
}
__host__ __device__ __forceinline__ int win_src_col(int n) {
    const bool perm = (n < 512) || (n >= 1024 && n < 1536);
    if (!perm) return n;
    const int nd = n & 63, base = n - nd, i = nd >> 1, par = nd & 1;
    const int old = (i < 16 ? i : 32 + (i - 16)) + 16 * par;
    return base + old;
}

template <bool PERMW>
__device__ __forceinline__ void transpose_item(const float* __restrict__ W, int K, int N, bf16_t* __restrict__ WT, float* scr, int item, int lane) {
    const int nblk = N / 32, kb = item / nblk, nb = item % nblk, k0 = 64 * kb, n0 = 32 * nb;
    const int nsrc = PERMW ? win_src_col(n0 + (lane & 31)) : (n0 + (lane & 31));
#pragma unroll 8
    for (int i = 0; i < 32; ++i) { const int kk = 2 * i + (lane >> 5); scr[kk * 33 + (lane & 31)] = W[(size_t)(k0 + kk) * N + nsrc]; }
    __builtin_amdgcn_s_waitcnt(0xC07F); asm volatile("" ::: "memory");
    const int c = lane & 7;
#pragma unroll
    for (int j = 0; j < 4; ++j) { const int n = (lane >> 3) + 8 * j; const float* s = scr + (8 * c) * 33 + n;
        u32x4 o; o.x = pk2(s[0 * 33], s[1 * 33]); o.y = pk2(s[2 * 33], s[3 * 33]); o.z = pk2(s[4 * 33], s[5 * 33]); o.w = pk2(s[6 * 33], s[7 * 33]);
        *(u32x4*)(WT + (size_t)(n0 + n) * K + k0 + 8 * c) = o; }
    __builtin_amdgcn_s_waitcnt(0xC07F); asm volatile("" ::: "memory");
}
template <int NR, bool SILU>
__device__ __forceinline__ void small_mm_task(const float* __restrict__ src, size_t src_stride, const float* __restrict__ last_row, const float* __restrict__ W, int N,
                                              int k0, int n0, float* out, size_t out_stride, const float* __restrict__ bias, float* scr, int lane) {
#pragma unroll
    for (int r = 0; r < NR; ++r) {
        const float* sr = (last_row && r == NR - 1) ? last_row : src + (size_t)r * src_stride;
        float v = sr[k0 + lane];
        if (SILU) v = v / (1.0f + __expf(-v));
        scr[r * 64 + lane] = v;
    }
    __builtin_amdgcn_s_waitcnt(0xC07F); asm volatile("" ::: "memory");
    float acc[NR];
#pragma unroll
    for (int r = 0; r < NR; ++r) acc[r] = 0.f;
#pragma unroll 1
    for (int kk = 0; kk < 64; kk += 4) {
        const float w0 = W[(size_t)(k0 + kk + 0) * N + n0 + lane], w1 = W[(size_t)(k0 + kk + 1) * N + n0 + lane];
        const float w2 = W[(size_t)(k0 + kk + 2) * N + n0 + lane], w3 = W[(size_t)(k0 + kk + 3) * N + n0 + lane];
#pragma unroll
        for (int r = 0; r < NR; ++r) { const f32x4 s = *(const f32x4*)(scr + r * 64 + kk); acc[r] += s.x * w0 + s.y * w1 + s.z * w2 + s.w * w3; }
    }
    const float bv = (bias && k0 == 0) ? bias[n0 + lane] : 0.f;
#pragma unroll
    for (int r = 0; r < NR; ++r) atomicAdd(out + (size_t)r * out_stride + n0 + lane, acc[r] + bv);
    __builtin_amdgcn_s_waitcnt(0xC07F); asm volatile("" ::: "memory");
}

__device__ __forceinline__ void phase_prep_a(const Params& p, float* scr  , int gw, int NGW, int lane) {
    unsigned char* ws = p.ws;
    constexpr int T_MOD = (MODN / 64) * (DM / 64);
    constexpr int I_IN = (DM / 64) * (NQKV / 32), I_OUT = (DM / 64) * (DM / 32), I_1 = (DM / 64) * (FF / 32), I_2 = (FF / 64) * (DM / 32);
    constexpr int T_ALL = T_MOD + I_IN + I_OUT + I_1 + I_2 + 17;
    for (int t = gw; t < T_ALL; t += NGW) {
        int r = t;
        if (r < T_MOD) { const int nb = r % (MODN / 64), kc = r / (MODN / 64);
            small_mm_task<33, true>(p.c, DM, p.c_ctx, p.w_mod, MODN, kc * 64, nb * 64, (float*)(ws + WS_MOD), MODN, p.b_mod, scr, lane); continue; }
        r -= T_MOD;
        if (r < I_IN) { transpose_item<true>(p.w_in, DM, NQKV, (bf16_t*)(ws + WS_WIN), scr, r, lane); continue; } r -= I_IN;
        if (r < I_OUT) { transpose_item<false>(p.w_out, DM, DM, (bf16_t*)(ws + WS_WOUT), scr, r, lane); continue; } r -= I_OUT;
        if (r < I_1) { transpose_item<false>(p.w_fc1, DM, FF, (bf16_t*)(ws + WS_W1), scr, r, lane); continue; } r -= I_1;
        if (r < I_2) { transpose_item<false>(p.w_fc2, FF, DM, (bf16_t*)(ws + WS_W2), scr, r, lane); continue; } r -= I_2;
        if (r < 16) {
            const int pos = 4 * r + (lane >> 4), f = lane & 15;
            const float inv = powf(10000.0f, -(float)f / 16.0f);
            const float ang = (float)pos * inv;
            float* T = (float*)(ws + WS_ROPE) + (pos * 16 + f) * 2;
            T[0] = cosf(ang); T[1] = sinf(ang);
        } else {
            const float a = wave_sum(p.lam_q1[lane] * p.lam_k1[lane]), b = wave_sum(p.lam_q2[lane] * p.lam_k2[lane]);
            if (lane == 0) *(float*)(ws + WS_LAM) = expf(a) - expf(b) + LAM_INIT;
        }
    }
}
__device__ __forceinline__ void phase_prep_b(const Params& p, float* scr, int gw, int NGW, int lane) {
    unsigned char* ws = p.ws;
    const float* mod = (const float*)(ws + WS_MOD);
    constexpr int T_B1 = (FF / 64) * (DM / 64);
    for (int t = gw; t < T_B1; t += NGW) { const int nb = t % (FF / 64), kc = t / (FF / 64);
        small_mm_task<32, false>(mod + 3 * DM, MODN, nullptr, p.w_fc1, FF, kc * 64, nb * 64, (float*)(ws + WS_BIAS1), FF, nullptr, scr, lane); }
    bf16_t* A1 = (bf16_t*)(ws + WS_A1);
    for (int row = gw; row < MALL; row += NGW) {
        const float* xr; const float* mrow;
        if (row < MLAT) { xr = p.x + (size_t)row * DM; mrow = mod + (size_t)(row >> 11) * MODN; }
        else { xr = p.ctx + (size_t)(row - MLAT) * DM; mrow = mod + (size_t)32 * MODN; }
        f32x4 v[4]; float ss = 0.f;
#pragma unroll
        for (int j = 0; j < 4; ++j) { v[j] = *((const f32x4*)xr + lane + 64 * j); ss += (v[j].x * v[j].x + v[j].y * v[j].y) + (v[j].z * v[j].z + v[j].w * v[j].w); }
        const float rstd = rsqrtf(wave_sum(ss) * (1.0f / DM) + EPS);
#pragma unroll
        for (int j = 0; j < 4; ++j) {
            const int col = 4 * lane + 256 * j;
            const f32x4 g = *(const f32x4*)(p.norm1_g + col), sh = *(const f32x4*)(mrow + col), sc = *(const f32x4*)(mrow + DM + col);
            const f32x4 h = (v[j] * rstd) * g * (sc + 1.0f) + sh;
            u32x2 o; o.x = pk2(h.x, h.y); o.y = pk2(h.z, h.w);
            *(u32x2*)(A1 + (size_t)row * DM + col) = o;
        }
    }
}
__global__ __launch_bounds__(512) void k_prep_a(Params p) {
    __shared__ __attribute__((aligned(16))) float scr[8][2112];
    const int wid = threadIdx.x >> 6, lane = threadIdx.x & 63;
    phase_prep_a(p, scr[wid], blockIdx.x * 8 + wid, gridDim.x * 8, lane);
}
__global__ __launch_bounds__(512) void k_prep_b(Params p) {
    __shared__ __attribute__((aligned(16))) float scr[8][2112];
    const int wid = threadIdx.x >> 6, lane = threadIdx.x & 63;
    phase_prep_b(p, scr[wid], blockIdx.x * 8 + wid, gridDim.x * 8, lane);
}

struct E_QKV {
    static constexpr bool SSQ = false;
    bf16_t* qkv; bf16_t* kvc; const float* rope;
    struct Col {};
    __device__ __forceinline__ float rowval(int) const { return 0.f; }
    __device__ __forceinline__ Col col_prep(int, int) const { return Col{}; }
    __device__ __forceinline__ float epi8(int row, int col0, const Col&, const float (&a)[8], float) const {
        float v[8];
#pragma unroll
        for (int j = 0; j < 8; ++j) v[j] = a[j];
        if (row < MLAT) {
            const bool rope_cols = (col0 < 512) || (col0 >= 1024 && col0 < 1536);
            if (rope_cols) {
                const int s = row & (SEQ - 1), gr = s >> 6, gc = s & 63;
                const int i0 = (col0 & 63) >> 1, pos = (i0 >= 16) ? gc : gr, f0 = i0 & 15;
                const f32x4* T = (const f32x4*)(rope + (pos * 16 + f0) * 2);
                const f32x4 t0 = T[0], t1 = T[1];
                const float cs[4] = {t0.x, t0.z, t1.x, t1.z}, sn[4] = {t0.y, t0.w, t1.y, t1.w};
#pragma unroll
                for (int q = 0; q < 4; ++q) { const float x1 = v[2 * q], x2 = v[2 * q + 1]; v[2 * q] = x1 * cs[q] - x2 * sn[q]; v[2 * q + 1] = x1 * sn[q] + x2 * cs[q]; }
            }
            if (col0 < 1024) {
#pragma unroll
                for (int j = 0; j < 8; ++j) v[j] *= C2;
            }
            u32x4 o; o.x = pk2(v[0], v[1]); o.y = pk2(v[2], v[3]); o.z = pk2(v[4], v[5]); o.w = pk2(v[6], v[7]);
            *(u32x4*)(qkv + (size_t)row * NQKV + col0) = o;
        } else if (col0 >= 1024) {
            u32x4 o; o.x = pk2(v[0], v[1]); o.y = pk2(v[2], v[3]); o.z = pk2(v[4], v[5]); o.w = pk2(v[6], v[7]);
            *(u32x4*)(kvc + (size_t)(row - MLAT) * NKVC + (col0 - 1024)) = o;
        }
        return 0.f;
    }
};
struct E_OUT {
    static constexpr bool SSQ = true;
    const float* x; float* x1; bf16_t* a2; const float* mod; const float* g2;
    struct Col { float ga[8], gm[8]; };
    __device__ __forceinline__ float rowval(int) const { return 0.f; }
    __device__ __forceinline__ Col col_prep(int b, int col0) const {
        Col c; const float* m = mod + (size_t)b * MODN;
#pragma unroll
        for (int j = 0; j < 8; ++j) { c.ga[j] = m[2 * DM + col0 + j]; c.gm[j] = g2[col0 + j] * (1.0f + m[4 * DM + col0 + j]); }
        return c;
    }
    __device__ __forceinline__ float epi8(int row, int col0, const Col& c, const float (&a)[8], float) const {
        const size_t off = (size_t)row * DM + col0;
        const f32x4 x0 = *(const f32x4*)(x + off), x4 = *(const f32x4*)(x + off + 4);
        float v[8] = {x0.x, x0.y, x0.z, x0.w, x4.x, x4.y, x4.z, x4.w}; float ss = 0.f;
#pragma unroll
        for (int j = 0; j < 8; ++j) { v[j] += c.ga[j] * a[j]; ss += v[j] * v[j]; }
        *(f32x4*)(x1 + off) = (f32x4){v[0], v[1], v[2], v[3]}; *(f32x4*)(x1 + off + 4) = (f32x4){v[4], v[5], v[6], v[7]};
        u32x4 o; o.x = pk2(v[0] * c.gm[0], v[1] * c.gm[1]); o.y = pk2(v[2] * c.gm[2], v[3] * c.gm[3]); o.z = pk2(v[4] * c.gm[4], v[5] * c.gm[5]); o.w = pk2(v[6] * c.gm[6], v[7] * c.gm[7]);
        *(u32x4*)(a2 + off) = o;
        return ss;
    }
};
struct E_FC1 {
    static constexpr bool SSQ = false;
    const float* ssq1; const float* bias1; bf16_t* hid;
    struct Col { float bs[8]; };
    __device__ __forceinline__ float rowval(int row) const {
        const f32x4* s = (const f32x4*)(ssq1 + (size_t)row * 16); const f32x4 a = s[0], b = s[1], c = s[2], d = s[3];
        const float t = ((a.x + a.y) + (a.z + a.w)) + ((b.x + b.y) + (b.z + b.w)) + ((c.x + c.y) + (c.z + c.w)) + ((d.x + d.y) + (d.z + d.w));
        return rsqrtf(t * (1.0f / DM) + EPS);
    }
    __device__ __forceinline__ Col col_prep(int b, int col0) const { Col c;
#pragma unroll
        for (int j = 0; j < 8; ++j) c.bs[j] = bias1[(size_t)b * FF + col0 + j];
        return c; }
    __device__ __forceinline__ float epi8(int row, int col0, const Col& c, const float (&a)[8], float rv) const {
        float v[8];
#pragma unroll
        for (int j = 0; j < 8; ++j) { const float z = fmaxf(rv * a[j] + c.bs[j], 0.f); v[j] = z * z; }
        u32x4 o; o.x = pk2(v[0], v[1]); o.y = pk2(v[2], v[3]); o.z = pk2(v[4], v[5]); o.w = pk2(v[6], v[7]);
        *(u32x4*)(hid + (size_t)row * FF + col0) = o;
        return 0.f;
    }
};
struct E_FC2 {
    static constexpr bool SSQ = true;
    float* xio; const float* mod;
    struct Col { float gm[8]; };
    __device__ __forceinline__ float rowval(int) const { return 0.f; }
    __device__ __forceinline__ Col col_prep(int b, int col0) const { Col c; const float* m = mod + (size_t)b * MODN + 5 * DM + col0;
#pragma unroll
        for (int j = 0; j < 8; ++j) c.gm[j] = m[j];
        return c; }
    __device__ __forceinline__ float epi8(int row, int col0, const Col& c, const float (&a)[8], float) const {
        const size_t off = (size_t)row * DM + col0;
        const f32x4 x0 = *(const f32x4*)(xio + off), x4 = *(const f32x4*)(xio + off + 4);
        float v[8] = {x0.x, x0.y, x0.z, x0.w, x4.x, x4.y, x4.z, x4.w}; float ss = 0.f;
#pragma unroll
        for (int j = 0; j < 8; ++j) { v[j] += c.gm[j] * a[j]; ss += v[j] * v[j]; }
        *(f32x4*)(xio + off) = (f32x4){v[0], v[1], v[2], v[3]}; *(f32x4*)(xio + off + 4) = (f32x4){v[4], v[5], v[6], v[7]};
        return ss;
    }
};

namespace pg8 {
#define PG8_LAS __attribute__((address_space(3)))
typedef unsigned short bf16_t;
typedef short bf16x8 __attribute__((ext_vector_type(8)));
typedef float f32x4 __attribute__((ext_vector_type(4)));
typedef unsigned u32x4 __attribute__((ext_vector_type(4)));
constexpr int BM = 256, BK = 64, HALF = 128, HTB = HALF * BK * 2  , STAGE_BYTES = 8 * HTB, NXCD = 8, WGM = 8;

__host__ __device__ __forceinline__ int lds_byte(int r, int c) { const int st = (r >> 4) * 2 + (c >> 5), rr = r & 15, cc = c & 31, ob = rr * 64 + cc * 2; return st * 1024 + (ob ^ (((ob >> 9) & 1) << 5)); }
__host__ __device__ __forceinline__ void stage_rc(int b, int& R, int& C) { const int st = b / 1024, sb = b % 1024, swz = sb ^ (((sb >> 9) & 1) << 5); R = (st >> 1) * 16 + swz / 64; C = (st & 1) * 32 + (swz % 64) / 2; }
__host__ __device__ __forceinline__ int perm32(int rho) { const int n = rho >> 4, i = rho & 15; return 8 * (i >> 2) + 4 * n + (i & 3); }

struct Unit { int pm, pn; };
struct Gemm { const bf16_t* A; const bf16_t* Bt; int M, N, K; };

struct StaticOrder {
    int nM, nN, nwg, G, c;
    __host__ __device__ void init(int M, int N, int G_, int c_) { nM = M / BM; nN = N / BM; nwg = nM * nN; G = G_; c = c_; }
    __host__ __device__ bool next(int i, Unit& u) const {
        const long L = (long)i * G + c; if (L >= nwg) return false;
        int wgid = (int)L; { const int q = nwg / NXCD, r = nwg % NXCD, xcd = wgid % NXCD, off = wgid / NXCD; wgid = (xcd < r ? xcd * (q + 1) : r * (q + 1) + (xcd - r) * q) + off; }
        const int nig = WGM * nN, gid = wgid / nig, fm = gid * WGM, gsz = (nM - fm) < WGM ? (nM - fm) : WGM;
        u.pm = fm + ((wgid % nig) % gsz); u.pn = (wgid % nig) / gsz; return true;
    }
    __device__ __forceinline__ void a_ready(const Unit&) const {}
    __device__ __forceinline__ void done(const Unit&) const {}
};


template <class Epi, class Sched, bool ALIGN_EPI = false, bool SP2 = false>
__device__ __forceinline__ void gemm_phase(PG8_LAS unsigned char* lds, const Gemm g, const Sched& S, const Epi& E) {
    const int tid = threadIdx.x, wid = __builtin_amdgcn_readfirstlane(tid >> 6), lane = tid & 63, wr = wid >> 2, wc = wid & 3, fr = lane & 15, fq = lane >> 4;
    const int K = g.K, nt = K / BK;
    unsigned voffA[2], voffB[2];
#pragma unroll
    for (int i = 0; i < 2; ++i) { int R, C; stage_rc(tid * 16 + i * 8192, R, C); const int Rb = Epi::PERM ? ((R & ~31) + perm32(R & 31)) : R;
        voffA[i] = (unsigned)(R * K + C) * 2u; voffB[i] = (unsigned)(Rb * K + C) * 2u; }
    const size_t kstep = (size_t)(BK * 2);
    const size_t hstep = (size_t)HALF * K * 2;
    const size_t tstep = 2 * hstep;
    const unsigned ldsw = (unsigned)wid * 1024u;
    const int aoff = lds_byte(wr * 64 + fr, fq * 8), boff = lds_byte(wc * 32 + fr, fq * 8);
#define PG8_SA(b, h) (((b) * 2 + (h)) * HTB)
#define PG8_SB(b, h) ((4 + (b) * 2 + (h)) * HTB)
#define PG8_STAGE(bufoff, gbase, voff) do { _Pragma("unroll") for (int _i = 0; _i < 2; ++_i) \
        __builtin_amdgcn_global_load_lds((const unsigned*)((const char*)(gbase) + (voff)[_i]), (PG8_LAS unsigned*)(lds + (bufoff) + ldsw + _i * 8192), 16, 0, 0); } while (0)
#define PG8_LDA(dst, b, h) do { _Pragma("unroll") for (int m = 0; m < 4; ++m) _Pragma("unroll") for (int k = 0; k < 2; ++k) dst[m][k] = *(const PG8_LAS bf16x8*)(lds + PG8_SA(b, h) + aoff + m * 2048 + k * 1024); } while (0)
#define PG8_LDB(dst, b, h) do { _Pragma("unroll") for (int n = 0; n < 2; ++n) _Pragma("unroll") for (int k = 0; k < 2; ++k) dst[n][k] = *(const PG8_LAS bf16x8*)(lds + PG8_SB(b, h) + boff + n * 2048 + k * 1024); } while (0)
#define PG8_MMA(ai, bj, At, Bt) do { __builtin_amdgcn_s_setprio(1); _Pragma("unroll") for (int m = 0; m < 4; ++m) _Pragma("unroll") for (int n = 0; n < 2; ++n) _Pragma("unroll") for (int k = 0; k < 2; ++k) \
        acc[ai][bj][m][n] = __builtin_amdgcn_mfma_f32_16x16x32_bf16(Bt[n][k], At[m][k], acc[ai][bj][m][n], 0, 0, 0); __builtin_amdgcn_s_setprio(0); } while (0)
#define PG8_WAIT_V(n) asm volatile("s_waitcnt vmcnt(" #n ")" ::: "memory")
#define PG8_WAIT_L(n) asm volatile("s_waitcnt lgkmcnt(" #n ")" ::: "memory")
#define PG8_BAR __builtin_amdgcn_s_barrier()
#define PG8_SCHED __builtin_amdgcn_sched_barrier(0)
    Unit cur, nxt; int ui = 0;
    if (!S.next(0, cur)) return;
    f32x4 acc[2][2][4][2];
#pragma unroll
    for (int a = 0; a < 2; ++a)
#pragma unroll
        for (int b = 0; b < 2; ++b)
#pragma unroll
            for (int m = 0; m < 4; ++m)
#pragma unroll
                for (int n = 0; n < 2; ++n) acc[a][b][m][n] = (f32x4){0.f, 0.f, 0.f, 0.f};
    bf16x8 At[4][2], B0[2][2], B1[2][2];
    const char* cA = (const char*)g.A + (size_t)cur.pm * tstep; const char* cB = (const char*)g.Bt + (size_t)cur.pn * tstep;
    S.a_ready(cur);
    if constexpr (SP2) {
        PG8_STAGE(PG8_SB(0, 0), cB, voffB); PG8_STAGE(PG8_SB(0, 1), cB + hstep, voffB); PG8_STAGE(PG8_SA(0, 0), cA, voffA); PG8_STAGE(PG8_SA(0, 1), cA + hstep, voffA);
        if (wr == 1) PG8_BAR;
        PG8_WAIT_V(2); PG8_BAR;
        PG8_STAGE(PG8_SB(1, 0), cB + kstep, voffB); PG8_STAGE(PG8_SA(1, 0), cA + kstep, voffA); PG8_STAGE(PG8_SB(1, 1), cB + hstep + kstep, voffB);
        PG8_WAIT_V(6); PG8_BAR;
    } else {
        PG8_STAGE(PG8_SB(0, 0), cB, voffB); PG8_STAGE(PG8_SA(0, 0), cA, voffA); PG8_STAGE(PG8_SB(0, 1), cB + hstep, voffB); PG8_STAGE(PG8_SA(0, 1), cA + hstep, voffA);
        if (wr == 1) PG8_BAR;
        PG8_WAIT_V(4); PG8_BAR;
        PG8_STAGE(PG8_SB(1, 0), cB + kstep, voffB); PG8_STAGE(PG8_SA(1, 0), cA + kstep, voffA); PG8_STAGE(PG8_SB(1, 1), cB + hstep + kstep, voffB);
        PG8_WAIT_V(6); PG8_BAR;
    }
    for (;;) {
        const bool has_next = S.next(ui + 1, nxt);
        const char* nA = has_next ? (const char*)g.A + (size_t)nxt.pm * tstep : cA; const char* nB = has_next ? (const char*)g.Bt + (size_t)nxt.pn * tstep : cB;
        for (int t = 0; t < nt; t += 2) {
            const bool last = (t == nt - 2);
            const char* a1 = cA + (size_t)(t + 1) * kstep;
            const char* a2 = last ? nA : cA + (size_t)(t + 2) * kstep; const char* b2 = last ? nB : cB + (size_t)(t + 2) * kstep;
            const char* a3 = a2 + kstep; const char* b3 = b2 + kstep;
            if (last && has_next) S.a_ready(nxt);
            if constexpr (SP2) {
            PG8_LDB(B0, 0, 0); PG8_LDB(B1, 0, 1); PG8_SCHED; PG8_LDA(At, 0, 0); PG8_STAGE(PG8_SA(1, 1), a1 + hstep, voffA);
            PG8_WAIT_V(8); PG8_WAIT_L(0); PG8_BAR; PG8_MMA(0, 0, At, B0); PG8_MMA(0, 1, At, B1); PG8_BAR; PG8_SCHED;
            PG8_LDA(At, 0, 1); PG8_STAGE(PG8_SB(0, 0), b2, voffB); PG8_STAGE(PG8_SB(0, 1), b2 + hstep, voffB); PG8_STAGE(PG8_SA(0, 0), a2, voffA);
            PG8_WAIT_V(8); PG8_WAIT_L(0); PG8_BAR; PG8_MMA(1, 0, At, B0); PG8_MMA(1, 1, At, B1); PG8_BAR; PG8_SCHED;
            PG8_LDB(B0, 1, 0); PG8_LDB(B1, 1, 1); PG8_SCHED; PG8_LDA(At, 1, 0); PG8_STAGE(PG8_SA(0, 1), a2 + hstep, voffA);
            PG8_WAIT_V(8); PG8_WAIT_L(0); PG8_BAR; PG8_MMA(0, 0, At, B0); PG8_MMA(0, 1, At, B1); PG8_BAR; PG8_SCHED;
            PG8_LDA(At, 1, 1); PG8_STAGE(PG8_SB(1, 0), b3, voffB); PG8_STAGE(PG8_SB(1, 1), b3 + hstep, voffB); PG8_STAGE(PG8_SA(1, 0), a3, voffA);
            PG8_WAIT_V(8); PG8_WAIT_L(0); PG8_BAR; PG8_MMA(1, 0, At, B0); PG8_MMA(1, 1, At, B1); PG8_BAR; PG8_SCHED;
            } else {
            PG8_LDB(B0, 0, 0); PG8_SCHED; PG8_LDA(At, 0, 0); PG8_STAGE(PG8_SA(1, 1), a1 + hstep, voffA);
            PG8_WAIT_L(8); PG8_BAR; PG8_WAIT_L(0); PG8_MMA(0, 0, At, B0); PG8_BAR; PG8_SCHED;
            PG8_LDB(B1, 0, 1); PG8_STAGE(PG8_SB(0, 0), b2, voffB);
            PG8_BAR; PG8_WAIT_L(0); PG8_MMA(0, 1, At, B1); PG8_BAR;
            PG8_LDA(At, 0, 1); PG8_STAGE(PG8_SA(0, 0), a2, voffA);
            PG8_BAR; PG8_WAIT_L(0); PG8_MMA(1, 0, At, B0); PG8_BAR; PG8_SCHED;
            PG8_STAGE(PG8_SB(0, 1), b2 + hstep, voffB);
            PG8_WAIT_V(6); PG8_BAR; PG8_MMA(1, 1, At, B1); PG8_BAR;
            PG8_LDB(B0, 1, 0); PG8_SCHED; PG8_LDA(At, 1, 0); PG8_STAGE(PG8_SA(0, 1), a2 + hstep, voffA);
            PG8_WAIT_L(8); PG8_BAR; PG8_WAIT_L(0); PG8_MMA(0, 0, At, B0); PG8_BAR; PG8_SCHED;
            PG8_LDB(B1, 1, 1); PG8_STAGE(PG8_SB(1, 0), b3, voffB);
            PG8_BAR; PG8_WAIT_L(0); PG8_MMA(0, 1, At, B1); PG8_BAR;
            PG8_LDA(At, 1, 1); PG8_STAGE(PG8_SA(1, 0), a3, voffA);
            PG8_BAR; PG8_WAIT_L(0); PG8_MMA(1, 0, At, B0); PG8_BAR; PG8_SCHED;
            PG8_STAGE(PG8_SB(1, 1), b3 + hstep, voffB);
            PG8_WAIT_V(6); PG8_BAR; PG8_MMA(1, 1, At, B1); PG8_BAR;
            }
        }
        if constexpr (ALIGN_EPI) { if (wr == 0) PG8_BAR; }
        if constexpr (!Epi::AFTER_DRAIN) { E(acc, cur, wr, wc, fr, fq); S.done(cur); }
        if (!has_next) break;
#pragma unroll
        for (int a = 0; a < 2; ++a)
#pragma unroll
            for (int b = 0; b < 2; ++b)
#pragma unroll
                for (int m = 0; m < 4; ++m)
#pragma unroll
                    for (int n = 0; n < 2; ++n) acc[a][b][m][n] = (f32x4){0.f, 0.f, 0.f, 0.f};
        cur = nxt; cA = nA; cB = nB; ++ui;
        if constexpr (ALIGN_EPI) { if (wr == 1) PG8_BAR; }
    }
    PG8_WAIT_V(0);
    if constexpr (!ALIGN_EPI) { if (wr == 0) PG8_BAR; }
    PG8_BAR;
    if constexpr (Epi::AFTER_DRAIN) { E.fused(acc, cur, wr, wc, fr, fq, lds, wid, lane); S.done(cur); }
#undef PG8_SA
#undef PG8_SB
#undef PG8_STAGE
#undef PG8_LDA
#undef PG8_LDB
#undef PG8_MMA
#undef PG8_WAIT_V
#undef PG8_WAIT_L
#undef PG8_BAR
#undef PG8_SCHED
}
}


#define LAS __attribute__((address_space(3)))
template <class E8> struct EpiWrap {
    static constexpr bool PERM = true, AFTER_DRAIN = false;
    E8 e; float* ssq;
    __device__ __forceinline__ void operator()(const pg8::f32x4 (&acc)[2][2][4][2], const pg8::Unit& u, int wr, int wc, int fr, int fq) const {
        const int rowb = u.pm * 256 + wr * 64 + fr;
        const int b = (u.pm < 256) ? (u.pm >> 3) : 0;
        float rv[2][4], ss[2][4];
#pragma unroll
        for (int ai = 0; ai < 2; ++ai)
#pragma unroll
            for (int m = 0; m < 4; ++m) { rv[ai][m] = e.rowval(rowb + ai * 128 + m * 16); ss[ai][m] = 0.f; }
#pragma unroll
        for (int bj = 0; bj < 2; ++bj) {
            const int col0 = u.pn * 256 + bj * 128 + wc * 32 + 8 * fq;
            const typename E8::Col cc = e.col_prep(b, col0);
#pragma unroll
            for (int ai = 0; ai < 2; ++ai)
#pragma unroll
                for (int m = 0; m < 4; ++m) {
                    const pg8::f32x4 v0 = acc[ai][bj][m][0], v1 = acc[ai][bj][m][1];
                    const float a[8] = {v0[0], v0[1], v0[2], v0[3], v1[0], v1[1], v1[2], v1[3]};
                    ss[ai][m] += e.epi8(rowb + ai * 128 + m * 16, col0, cc, a, rv[ai][m]);
                }
        }
        if (E8::SSQ) {
#pragma unroll
            for (int ai = 0; ai < 2; ++ai)
#pragma unroll
                for (int m = 0; m < 4; ++m) { float s = ss[ai][m]; s += __shfl_xor(s, 16); s += __shfl_xor(s, 32);
                    if (fq == 0) ssq[(size_t)(rowb + ai * 128 + m * 16) * 16 + u.pn * 4 + wc] = s; }
        }
    }
};
struct QkvOrder {
    pg8::StaticOrder base; int G, c;
    __device__ __forceinline__ void init(int G_, int c_) { base.init(MLAT, NQKV, G_, c_); G = G_; c = c_; }
    __device__ __forceinline__ bool next(int i, pg8::Unit& u) const {
        if (base.next(i, u)) return true;
        const long L = (long)i * G + c - base.nwg; if (L < 0 || L >= 256) return false;
        const int id = (int)L, w = (id & 7) * 32 + (id >> 3);
        u.pm = 256 + (w >> 3); u.pn = 4 + (w & 7); return true;
    }
    __device__ __forceinline__ void a_ready(const pg8::Unit&) const {}
    __device__ __forceinline__ void done(const pg8::Unit&) const {}
};
__device__ __forceinline__ void phase_qkv(const Params& p, LAS unsigned char* lds) {
    unsigned char* ws = p.ws;
    pg8::Gemm g{(const bf16_t*)(ws + WS_A1), (const bf16_t*)(ws + WS_WIN), MALL, NQKV, DM};
    QkvOrder S; S.init((int)gridDim.x, (int)blockIdx.x);
    EpiWrap<E_QKV> E{{(bf16_t*)(ws + WS_QKV), (bf16_t*)(ws + WS_KVC), (const float*)(ws + WS_ROPE)}, nullptr};
    pg8::gemm_phase<EpiWrap<E_QKV>, QkvOrder, true, true>(lds, g, S, E);
}
__device__ __forceinline__ void phase_outproj(const Params& p, LAS unsigned char* lds) {
    unsigned char* ws = p.ws;
    pg8::Gemm g{(const bf16_t*)(ws + WS_MIX), (const bf16_t*)(ws + WS_WOUT), MLAT, DM, DM};
    pg8::StaticOrder S; S.init(MLAT, DM, (int)gridDim.x, (int)blockIdx.x);
    EpiWrap<E_OUT> E{{p.x, p.out, (bf16_t*)(ws + WS_A2), (const float*)(ws + WS_MOD), p.norm2_g}, (float*)(ws + WS_SSQ1)};
    pg8::gemm_phase<EpiWrap<E_OUT>, pg8::StaticOrder, true, true>(lds, g, S, E);
}
__device__ __forceinline__ void phase_fc1(const Params& p, LAS unsigned char* lds) {
    unsigned char* ws = p.ws;
    pg8::Gemm g{(const bf16_t*)(ws + WS_A2), (const bf16_t*)(ws + WS_W1), MLAT, FF, DM};
    pg8::StaticOrder S; S.init(MLAT, FF, (int)gridDim.x, (int)blockIdx.x);
    EpiWrap<E_FC1> E{{(const float*)(ws + WS_SSQ1), (const float*)(ws + WS_BIAS1), (bf16_t*)(ws + WS_HID)}, nullptr};
    pg8::gemm_phase<EpiWrap<E_FC1>, pg8::StaticOrder, true, true>(lds, g, S, E);
}
__device__ __forceinline__ void phase_fc2(const Params& p, LAS unsigned char* lds) {
    unsigned char* ws = p.ws;
    pg8::Gemm g{(const bf16_t*)(ws + WS_HID), (const bf16_t*)(ws + WS_W2), MLAT, DM, FF};
    pg8::StaticOrder S; S.init(MLAT, DM, (int)gridDim.x, (int)blockIdx.x);
    EpiWrap<E_FC2> E{{p.out, (const float*)(ws + WS_MOD)}, (float*)(ws + WS_SSQ2)};
    pg8::gemm_phase<EpiWrap<E_FC2>, pg8::StaticOrder, true, true>(lds, g, S, E);
}
constexpr int LDS_BYTES = 147456;
template <int PH> __global__ __launch_bounds__(512, 2) void k_gemm_fast(Params p) {
    extern __shared__ __attribute__((aligned(16))) unsigned char lds[];
    LAS unsigned char* l3 = (LAS unsigned char*)lds;
    if (PH == 1) phase_qkv(p, l3);
    if (PH == 3) phase_outproj(p, l3);
    if (PH == 4) phase_fc1(p, l3);
    if (PH == 5) phase_fc2(p, l3);
}


namespace att {
typedef short bf16x8 __attribute__((ext_vector_type(8)));
typedef short s16x4 __attribute__((ext_vector_type(4)));
typedef short v4i16_t __attribute__((ext_vector_type(4)));
typedef float f32x16 __attribute__((ext_vector_type(16)));
constexpr int RING_BUF = 32768;
constexpr int OFF_STAGE = 0;
constexpr int OFF_WSF = 135168;
constexpr int OFF_RPB = 137216;
constexpr float THR = 8.0f;
__device__ __forceinline__ int crow(int r, int hi) { return (r & 3) + 8 * (r >> 2) + 4 * hi; }
__device__ __forceinline__ s16x4 vtr(LAS const unsigned char* p) { return __builtin_bit_cast(s16x4, __builtin_amdgcn_ds_read_tr16_b64_v4i16((LAS v4i16_t*)p)); }
struct TileSrc { const bf16_t* k; const bf16_t* v; int pitch; };
template <int NP> struct Stage { u32x4 kreg[NP], vreg[NP]; };
template <int NP> __device__ __forceinline__ void stage_load(Stage<NP>& s, const TileSrc& src, int tid) {
#pragma unroll
    for (int i = 0; i < NP; ++i) { const int p = tid + 512 * i, key = p & 63, c = p >> 6;
        s.kreg[i] = *(const u32x4*)(src.k + (size_t)key * src.pitch + c * 8);
        const int kv = (c & 3) * 16 + ((p & 63) >> 2);
        s.vreg[i] = *(const u32x4*)(src.v + (size_t)kv * src.pitch + (c >> 2) * 32 + (p & 3) * 8); }
}
template <int NP> __device__ __forceinline__ void stage_write(const Stage<NP>& s, LAS unsigned char* buf, int tid) {
#pragma unroll
    for (int i = 0; i < NP; ++i) { const int p = tid + 512 * i;
        *(LAS u32x4*)(buf + p * 16) = s.kreg[i];
        *(LAS u32x4*)(buf + NP * 8192 + p * 16) = s.vreg[i]; }
}
template <int NC> struct WaveState { f32x16 o[NC]; float m, l; bf16x8 qr[4]; };
__device__ __forceinline__ void qkt(f32x16& p0, f32x16& p1, LAS const unsigned char* kslot, const bf16x8 (&qr)[4], int r32, int hi) {
    LAS const unsigned char* kb = kslot + hi * 1024 + r32 * 16;
#pragma unroll
    for (int d0 = 0; d0 < 4; ++d0) {
        const bf16x8 b0 = *(LAS const bf16x8*)(kb + d0 * 2048), b1 = *(LAS const bf16x8*)(kb + d0 * 2048 + 512);
        p0 = __builtin_amdgcn_mfma_f32_32x32x16_bf16(b0, qr[d0], p0, 0, 0, 0);
        p1 = __builtin_amdgcn_mfma_f32_32x32x16_bf16(b1, qr[d0], p1, 0, 0, 0);
    }
}
template <int NC> __device__ __forceinline__ void softmax_pv(f32x16& p0, f32x16& p1, WaveState<NC>& st, LAS const unsigned char* vl, LAS float* wsf, int r32, int hi) {
    float mx = fmaxf(p0[0], p1[0]);
#pragma unroll
    for (int r = 1; r < 16; ++r) mx = fmaxf(mx, fmaxf(p0[r], p1[r]));
    mx = fmaxf(mx, __shfl_xor(mx, 32));
    if (__any(mx > st.m + THR)) {
        const float mn = fmaxf(st.m, mx), alpha = __builtin_amdgcn_exp2f(st.m - mn);
        st.m = mn; st.l *= alpha;
        if (hi == 0) wsf[r32] = alpha;
#pragma unroll
        for (int r = 0; r < 16; ++r) { const float a = wsf[crow(r, hi)];
#pragma unroll
            for (int c = 0; c < NC; ++c) st.o[c][r] *= a; }
    }
    float rs = 0.f;
#pragma unroll
    for (int r = 0; r < 16; ++r) { p0[r] = __builtin_amdgcn_exp2f(p0[r] - st.m); p1[r] = __builtin_amdgcn_exp2f(p1[r] - st.m); rs += p0[r] + p1[r]; }
    st.l += rs;
    u32x4 pw[4];
#pragma unroll
    for (int i = 0; i < 4; ++i) { pw[0][i] = pk2(p0[2 * i], p0[2 * i + 1]); pw[1][i] = pk2(p0[8 + 2 * i], p0[9 + 2 * i]); pw[2][i] = pk2(p1[2 * i], p1[2 * i + 1]); pw[3][i] = pk2(p1[8 + 2 * i], p1[9 + 2 * i]); }
#pragma unroll
    for (int c = 0; c < NC; ++c)
#pragma unroll
        for (int s = 0; s < 4; ++s) {
            const s16x4 lo = vtr(vl + c * 4096 + s * 1024), hv = vtr(vl + c * 4096 + s * 1024 + 512);
            const bf16x8 vf = {lo[0], lo[1], lo[2], lo[3], hv[0], hv[1], hv[2], hv[3]};
            st.o[c] = __builtin_amdgcn_mfma_f32_32x32x16_bf16(__builtin_bit_cast(bf16x8, pw[s]), vf, st.o[c], 0, 0, 0);
        }
}
template <int NC> __device__ __forceinline__ void state_init(WaveState<NC>& st, const bf16_t* qrow) {
#pragma unroll
    for (int d0 = 0; d0 < 4; ++d0) st.qr[d0] = *(const bf16x8*)(qrow + 16 * d0);
#pragma unroll
    for (int c = 0; c < NC; ++c)
#pragma unroll
        for (int r = 0; r < 16; ++r) st.o[c][r] = 0.f;
    st.m = NEGBIG; st.l = 0.f;
}

__device__ __forceinline__ void diff_unit(const Params& p, LAS unsigned char* lds, int b, int h, int qb, float lam) {
    const int tid = threadIdx.x, lane = tid & 63, r32 = lane & 31, hi = lane >> 5, wid = __builtin_amdgcn_readfirstlane(tid >> 6), rg = wid & 3, map = wid >> 2;
    const bf16_t* qkv = (const bf16_t*)(p.ws + WS_QKV); const bf16_t* kvc = (const bf16_t*)(p.ws + WS_KVC); bf16_t* mix = (bf16_t*)(p.ws + WS_MIX);
    LAS float* wsf = (LAS float*)(lds + OFF_WSF) + wid * 64;
    const int lanebase = (4 * hi + ((lane & 15) >> 2)) * 64 + ((lane >> 4) & 1) * 32 + (lane & 3) * 8;
    WaveState<4> st;
    state_init<4>(st, qkv + (size_t)(b * SEQ + qb * 128 + rg * 32 + r32) * NQKV + 128 * h + 64 * map + 8 * hi);
    auto tile_src = [&](int t) -> TileSrc {
        if (t < 32) { const bf16_t* base = qkv + (size_t)(b * SEQ + t * 64) * NQKV; return TileSrc{base + 1024 + 128 * h, base + 2048 + 128 * h, NQKV}; }
        const bf16_t* base = kvc + (size_t)(b * CTX + (t - 32) * 64) * NKVC; return TileSrc{base + 128 * h, base + 1024 + 128 * h, NKVC}; };
    Stage<2> sg;
    stage_load<2>(sg, tile_src(0), tid); stage_write<2>(sg, lds, tid);
    __syncthreads();
    for (int t = 0; t < 36; ++t) {
        LAS unsigned char* cur = lds + (t & 1) * RING_BUF;
        if (t + 1 < 36) stage_load<2>(sg, tile_src(t + 1), tid);
        f32x16 p0, p1;
#pragma unroll
        for (int r = 0; r < 16; ++r) { p0[r] = 0.f; p1[r] = 0.f; }
        qkt(p0, p1, cur + map * 8192, st.qr, r32, hi);
        softmax_pv<4>(p0, p1, st, cur + 16384 + lanebase, wsf, r32, hi);
        if (t + 1 < 36) stage_write<2>(sg, lds + ((t + 1) & 1) * RING_BUF, tid);
        __syncthreads();
    }
    {   float lt = st.l + __shfl_xor(st.l, 32);
        if (hi == 0) wsf[r32] = 1.0f / lt;
        LAS float* stg = (LAS float*)(lds + OFF_STAGE);
#pragma unroll
        for (int r = 0; r < 16; ++r) { const float inv = wsf[crow(r, hi)]; const int R = map * 128 + rg * 32 + crow(r, hi);
#pragma unroll
            for (int c = 0; c < 4; ++c) stg[R * 132 + 32 * c + r32] = st.o[c][r] * inv; }
        __syncthreads();
        const int row = tid >> 2, part = tid & 3;
        float o[32]; float ss = 0.f;
#pragma unroll
        for (int i = 0; i < 8; ++i) { const f32x4 a = *(LAS const f32x4*)(stg + row * 132 + part * 32 + 4 * i), bb = *(LAS const f32x4*)(stg + (128 + row) * 132 + part * 32 + 4 * i);
#pragma unroll
            for (int e = 0; e < 4; ++e) { const float v = a[e] - lam * bb[e]; o[4 * i + e] = v; ss += v * v; } }
        ss += __shfl_xor(ss, 1); ss += __shfl_xor(ss, 2);
        const float rstd = rsqrtf(ss * (1.0f / 128.0f) + EPS) * (1.0f - LAM_INIT);
        bf16_t* dst = mix + (size_t)(b * SEQ + qb * 128 + row) * DM + 128 * h + part * 32;
#pragma unroll
        for (int i = 0; i < 4; ++i) { const f32x4 g0 = *(const f32x4*)(p.subln_g + part * 32 + 8 * i), g1 = *(const f32x4*)(p.subln_g + part * 32 + 8 * i + 4);
            u32x4 w; w.x = pk2(o[8 * i] * rstd * g0.x, o[8 * i + 1] * rstd * g0.y); w.y = pk2(o[8 * i + 2] * rstd * g0.z, o[8 * i + 3] * rstd * g0.w);
            w.z = pk2(o[8 * i + 4] * rstd * g1.x, o[8 * i + 5] * rstd * g1.y); w.w = pk2(o[8 * i + 6] * rstd * g1.z, o[8 * i + 7] * rstd * g1.w);
            *(u32x4*)(dst + 8 * i) = w; }
        __syncthreads();
    }
}
__device__ __forceinline__ void na_unit(const Params& p, LAS unsigned char* lds, int b, int hh, int rg4) {
    const int tid = threadIdx.x, lane = tid & 63, r32 = lane & 31, hi = lane >> 5, wid = __builtin_amdgcn_readfirstlane(tid >> 6);
    const bf16_t* qkv = (const bf16_t*)(p.ws + WS_QKV); const bf16_t* kvc = (const bf16_t*)(p.ws + WS_KVC); bf16_t* mix = (bf16_t*)(p.ws + WS_MIX);
    LAS float* wsf = (LAS float*)(lds + OFF_WSF) + wid * 64;
    LAS float* rpbL = (LAS float*)(lds + OFF_RPB);
    const int lanebase = (4 * hi + ((lane & 15) >> 2)) * 64 + ((lane >> 4) & 1) * 32 + (lane & 3) * 8;
    const int gr = 4 * rg4 + (wid >> 1), chh = wid & 1, jq = 32 * chh + r32;
    const int start = min(max(gr - 4, 0), 24), cs = min(max(jq - 8, 0), 48);
    const int kr_lo = min(max(4 * rg4 - 4, 0), 24), kr_hi = min(max(4 * rg4 - 1, 0), 24) + 7, nlat = kr_hi - kr_lo + 1, nt = nlat + 4;
    if (tid < 465) rpbL[tid] = p.rpb[hh * 465 + tid] * LOG2E;
    WaveState<2> st;
    state_init<2>(st, qkv + (size_t)(b * SEQ + gr * 64 + jq) * NQKV + 512 + 64 * hh + 8 * hi);
    auto tile_src = [&](int t) -> TileSrc {
        if (t < nlat) { const bf16_t* base = qkv + (size_t)(b * SEQ + (kr_lo + t) * 64) * NQKV; return TileSrc{base + 1536 + 64 * hh, base + 2560 + 64 * hh, NQKV}; }
        const bf16_t* base = kvc + (size_t)(b * CTX + (t - nlat) * 64) * NKVC; return TileSrc{base + 512 + 64 * hh, base + 1536 + 64 * hh, NKVC}; };
    Stage<1> sg;
    stage_load<1>(sg, tile_src(0), tid); stage_write<1>(sg, lds, tid);
    __syncthreads();
    for (int t = 0; t < nt; ++t) {
        LAS unsigned char* cur = lds + (t & 1) * RING_BUF;
        if (t + 1 < nt) stage_load<1>(sg, tile_src(t + 1), tid);
        const int kr = kr_lo + t;
        const bool lat = t < nlat;
        const bool active = !lat || (kr >= start && kr < start + 8);
        if (active) {
            f32x16 p0, p1;
#pragma unroll
            for (int r = 0; r < 16; ++r) { p0[r] = 0.f; p1[r] = 0.f; }
            qkt(p0, p1, cur, st.qr, r32, hi);
            if (lat) {
                const int dbase = (kr - gr + 7) * 31 + 15 - jq;
#pragma unroll
                for (int r = 0; r < 16; ++r) {
                    const int jk0 = crow(r, hi), jk1 = jk0 + 32;
                    const bool v0 = (jk0 >= cs) && (jk0 < cs + 16), v1 = (jk1 >= cs) && (jk1 < cs + 16);
                    const float b0 = rpbL[v0 ? dbase + jk0 : 0], b1 = rpbL[v1 ? dbase + jk1 : 0];
                    p0[r] = v0 ? p0[r] + b0 : NEGBIG; p1[r] = v1 ? p1[r] + b1 : NEGBIG;
                }
            }
            softmax_pv<2>(p0, p1, st, cur + 8192 + lanebase, wsf, r32, hi);
        }
        if (t + 1 < nt) stage_write<1>(sg, lds + ((t + 1) & 1) * RING_BUF, tid);
        __syncthreads();
    }
    {   float lt = st.l + __shfl_xor(st.l, 32);
        if (hi == 0) wsf[r32] = 1.0f / lt;
        LAS float* stg = (LAS float*)(lds + OFF_STAGE) + wid * (32 * 68);
#pragma unroll
        for (int r = 0; r < 16; ++r) { const float inv = wsf[crow(r, hi)];
#pragma unroll
            for (int c = 0; c < 2; ++c) stg[crow(r, hi) * 68 + 32 * c + r32] = st.o[c][r] * inv; }
        const int row = lane >> 1, half = lane & 1;
        bf16_t* dst = mix + (size_t)(b * SEQ + gr * 64 + 32 * chh + row) * DM + 512 + 64 * hh + half * 32;
#pragma unroll
        for (int i = 0; i < 4; ++i) { const f32x4 a = *(LAS const f32x4*)(stg + row * 68 + half * 32 + 8 * i), c4 = *(LAS const f32x4*)(stg + row * 68 + half * 32 + 8 * i + 4);
            u32x4 w; w.x = pk2(a.x, a.y); w.y = pk2(a.z, a.w); w.z = pk2(c4.x, c4.y); w.w = pk2(c4.z, c4.w);
            *(u32x4*)(dst + 8 * i) = w; }
        __syncthreads();
    }
}
}
__device__ __forceinline__ void phase_attn(const Params& p, LAS unsigned char* lds) {
    const int G = (int)gridDim.x, bx = (int)blockIdx.x, vcu = (G % 8 == 0) ? (bx % 8) * (G / 8) + bx / 8 : bx;
    const float lam = *(const float*)(p.ws + WS_LAM);
    for (int u = vcu; u < 2048; u += G) att::diff_unit(p, lds, u >> 6, (u >> 4) & 3, u & 15, lam);
    for (int u = vcu; u < 2048; u += G) att::na_unit(p, lds, u >> 6, (u >> 3) & 7, u & 7);
}
__global__ __launch_bounds__(512, 2) void k_attn_fast(Params p) {
    extern __shared__ __attribute__((aligned(16))) unsigned char lds[];
    phase_attn(p, (LAS unsigned char*)lds);
}

template <class E8>
__global__ __launch_bounds__(256) void k_gemm_slow(const bf16_t* __restrict__ A, const bf16_t* __restrict__ Bt, int M, int N, int K, int ctx_skip_cols, E8 e) {
    const int col0 = (blockIdx.x * 32 + (threadIdx.x & 31)) * 8;
    const int row0 = (blockIdx.y * 8 + (threadIdx.x >> 5)) * 4;
    if (row0 >= M || col0 >= N) return;
    if (row0 >= MLAT && col0 < ctx_skip_cols) return;
    float acc[4][8];
#pragma unroll
    for (int r = 0; r < 4; ++r)
#pragma unroll
        for (int j = 0; j < 8; ++j) acc[r][j] = 0.f;
    for (int k = 0; k < K; k += 8) {
        u32x4 av[4], bv[8];
#pragma unroll
        for (int r = 0; r < 4; ++r) av[r] = *(const u32x4*)(A + (size_t)(row0 + r) * K + k);
#pragma unroll
        for (int j = 0; j < 8; ++j) bv[j] = *(const u32x4*)(Bt + (size_t)(col0 + j) * K + k);
#pragma unroll
        for (int r = 0; r < 4; ++r)
#pragma unroll
            for (int j = 0; j < 8; ++j) {
                acc[r][j] += bf_lo(av[r].x) * bf_lo(bv[j].x) + bf_hi(av[r].x) * bf_hi(bv[j].x) + bf_lo(av[r].y) * bf_lo(bv[j].y) + bf_hi(av[r].y) * bf_hi(bv[j].y)
                           + bf_lo(av[r].z) * bf_lo(bv[j].z) + bf_hi(av[r].z) * bf_hi(bv[j].z) + bf_lo(av[r].w) * bf_lo(bv[j].w) + bf_hi(av[r].w) * bf_hi(bv[j].w);
            }
    }
    const int b = (row0 < MLAT) ? (row0 >> 11) : 0;
    const typename E8::Col cc = e.col_prep(b, col0);
#pragma unroll
    for (int r = 0; r < 4; ++r) { const float rv = e.rowval(row0 + r); (void)e.epi8(row0 + r, col0, cc, acc[r], rv); }
}
__global__ __launch_bounds__(512) void k_ssq_slow(const float* __restrict__ xin, float* __restrict__ ssq) {
    const int lane = threadIdx.x & 63, row = blockIdx.x * 8 + (threadIdx.x >> 6);
    float ss = 0.f;
#pragma unroll
    for (int j = 0; j < 4; ++j) { const f32x4 v = *((const f32x4*)(xin + (size_t)row * DM) + lane + 64 * j); ss += (v.x * v.x + v.y * v.y) + (v.z * v.z + v.w * v.w); }
    ss = wave_sum(ss);
    if (lane < 16) ssq[(size_t)row * 16 + lane] = (lane == 0) ? ss : 0.f;
}
__device__ __forceinline__ void phase_final(const Params& p, int gw, int NGW, int lane) {
    const float* ssq2 = (const float*)(p.ws + WS_SSQ2);
    for (int row = gw; row < MLAT; row += NGW) {
        const float sv = (lane < 16) ? ssq2[(size_t)row * 16 + lane] : 0.f;
        const float rstd = rsqrtf(wave_sum(sv) * (1.0f / DM) + EPS);
        float* o = p.out + (size_t)row * DM;
#pragma unroll
        for (int j = 0; j < 4; ++j) { const int col = 4 * lane + 256 * j; const f32x4 v = *(const f32x4*)(o + col), g = *(const f32x4*)(p.final_g + col); *(f32x4*)(o + col) = v * rstd * g; }
    }
}
__global__ __launch_bounds__(512) void k_final(Params p) { phase_final(p, blockIdx.x * 8 + (threadIdx.x >> 6), gridDim.x * 8, threadIdx.x & 63); }

__global__ __launch_bounds__(512) void k_attn_slow(Params p) {
    __shared__ float sq[8][128];
    const int wid = threadIdx.x >> 6, lane = threadIdx.x & 63;
    const long gwl = (long)blockIdx.x * 8 + wid;
    const int slot = (int)(gwl % 12), tok = (int)(gwl / 12), b = tok >> 11, s = tok & (SEQ - 1);
    const bf16_t* qkv = (const bf16_t*)(p.ws + WS_QKV); const bf16_t* kvc = (const bf16_t*)(p.ws + WS_KVC); bf16_t* mix = (bf16_t*)(p.ws + WS_MIX);
    float* q = sq[wid];
    if (slot < 4) {
        const int h = slot;
        const bf16_t* qrow = qkv + (size_t)tok * NQKV + 128 * h;
        q[lane] = bf2f(qrow[lane]); q[64 + lane] = bf2f(qrow[64 + lane]);
        float m0 = NEGBIG, m1 = NEGBIG, l0 = 0.f, l1 = 0.f, o0a = 0.f, o0b = 0.f, o1a = 0.f, o1b = 0.f;
        for (int t = 0; t < 36; ++t) {
            const bf16_t* krow; const bf16_t* vbase; int vpitch;
            if (t < 32) { krow = qkv + (size_t)(b * SEQ + t * 64 + lane) * NQKV + 1024 + 128 * h; vbase = qkv + (size_t)(b * SEQ + t * 64) * NQKV + 2048 + 128 * h; vpitch = NQKV; }
            else { krow = kvc + (size_t)(b * CTX + (t - 32) * 64 + lane) * NKVC + 128 * h; vbase = kvc + (size_t)(b * CTX + (t - 32) * 64) * NKVC + 1024 + 128 * h; vpitch = NKVC; }
            float s0 = 0.f, s1 = 0.f;
#pragma unroll
            for (int d = 0; d < 64; d += 8) {
                const u32x4 k0 = *(const u32x4*)(krow + d), k1 = *(const u32x4*)(krow + 64 + d);
                const f32x4 qa = *(const f32x4*)(q + d), qb = *(const f32x4*)(q + d + 4), qc = *(const f32x4*)(q + 64 + d), qd = *(const f32x4*)(q + 64 + d + 4);
                s0 += qa.x * bf_lo(k0.x) + qa.y * bf_hi(k0.x) + qa.z * bf_lo(k0.y) + qa.w * bf_hi(k0.y) + qb.x * bf_lo(k0.z) + qb.y * bf_hi(k0.z) + qb.z * bf_lo(k0.w) + qb.w * bf_hi(k0.w);
                s1 += qc.x * bf_lo(k1.x) + qc.y * bf_hi(k1.x) + qc.z * bf_lo(k1.y) + qc.w * bf_hi(k1.y) + qd.x * bf_lo(k1.z) + qd.y * bf_hi(k1.z) + qd.z * bf_lo(k1.w) + qd.w * bf_hi(k1.w);
            }
            const float n0 = fmaxf(m0, wave_max(s0)), n1 = fmaxf(m1, wave_max(s1));
            const float a0 = exp2f(m0 - n0), a1 = exp2f(m1 - n1), p0 = exp2f(s0 - n0), p1 = exp2f(s1 - n1);
            l0 = l0 * a0 + wave_sum(p0); l1 = l1 * a1 + wave_sum(p1); m0 = n0; m1 = n1;
            o0a *= a0; o0b *= a0; o1a *= a1; o1b *= a1;
            for (int j = 0; j < 64; ++j) {
                const float pj0 = __shfl(p0, j), pj1 = __shfl(p1, j);
                const unsigned vv = *(const unsigned*)(vbase + (size_t)j * vpitch + 2 * lane);
                const float va = bf_lo(vv), vb = bf_hi(vv);
                o0a += pj0 * va; o0b += pj0 * vb; o1a += pj1 * va; o1b += pj1 * vb;
            }
        }
        const float lam = *(const float*)(p.ws + WS_LAM);
        const float oa = o0a / l0 - lam * (o1a / l1), ob = o0b / l0 - lam * (o1b / l1);
        const float rstd = rsqrtf(wave_sum(oa * oa + ob * ob) * (1.0f / 128.0f) + EPS);
        const float ya = oa * rstd * p.subln_g[2 * lane] * (1.0f - LAM_INIT), yb = ob * rstd * p.subln_g[2 * lane + 1] * (1.0f - LAM_INIT);
        *(unsigned*)(mix + (size_t)tok * DM + 128 * h + 2 * lane) = pk2(ya, yb);
    } else {
        const int hh = slot - 4;
        const bf16_t* qrow = qkv + (size_t)tok * NQKV + 512 + 64 * hh;
        q[lane] = bf2f(qrow[lane]);
        const int gr = s >> 6, jq = s & 63;
        const int start = min(max(gr - 4, 0), 24), cs = min(max(jq - 8, 0), 48);
        float m = NEGBIG, l = 0.f, o = 0.f;
        for (int t = 0; t < 6; ++t) {
            const bf16_t* krow; float bias = 0.f;
            if (t < 2) { const int idx = t * 64 + lane, kr = start + (idx >> 4), jk = cs + (idx & 15);
                krow = qkv + (size_t)(b * SEQ + kr * 64 + jk) * NQKV + 1536 + 64 * hh;
                bias = p.rpb[(hh * 15 + (kr - gr + 7)) * 31 + (jk - jq + 15)] * LOG2E; }
            else krow = kvc + (size_t)(b * CTX + (t - 2) * 64 + lane) * NKVC + 512 + 64 * hh;
            float sc = 0.f;
#pragma unroll
            for (int d = 0; d < 64; d += 8) {
                const u32x4 k0 = *(const u32x4*)(krow + d);
                const f32x4 qa = *(const f32x4*)(q + d), qb = *(const f32x4*)(q + d + 4);
                sc += qa.x * bf_lo(k0.x) + qa.y * bf_hi(k0.x) + qa.z * bf_lo(k0.y) + qa.w * bf_hi(k0.y) + qb.x * bf_lo(k0.z) + qb.y * bf_hi(k0.z) + qb.z * bf_lo(k0.w) + qb.w * bf_hi(k0.w);
            }
            sc += bias;
            const float n = fmaxf(m, wave_max(sc)), a = exp2f(m - n), pp = exp2f(sc - n);
            l = l * a + wave_sum(pp); m = n; o *= a;
            for (int j = 0; j < 64; ++j) {
                const float pj = __shfl(pp, j);
                const bf16_t* vrow;
                if (t < 2) { const int idx = t * 64 + j, kr = start + (idx >> 4), jk = cs + (idx & 15); vrow = qkv + (size_t)(b * SEQ + kr * 64 + jk) * NQKV + 2560 + 64 * hh; }
                else vrow = kvc + (size_t)(b * CTX + (t - 2) * 64 + j) * NKVC + 1536 + 64 * hh;
                o += pj * bf2f(vrow[lane]);
            }
        }
        const float y = o / l;
        const float yn = __shfl_down(y, 1);
        if ((lane & 1) == 0) *(unsigned*)(mix + (size_t)tok * DM + 512 + 64 * hh + lane) = pk2(y, yn);
    }
}

extern "C" void kernel_launch(void* const* d_in, const int* in_sizes, int n_in, void* d_out, int out_size, void* d_ws, size_t ws_size, hipStream_t stream) {
    if (n_in != 19 || in_sizes[0] != MLAT * DM || out_size != MLAT * DM || ws_size < WS_END) {
        fprintf(stderr, "kernel_launch: unexpected shapes: n_in %d in0 %d out %d ws %zu (need %zu)\n", n_in, n_in > 0 ? in_sizes[0] : -1, out_size, ws_size, (size_t)WS_END);
        return;
    }
    Params p{};
    const float** pf = (const float**)&p;
    for (int i = 0; i < 19; ++i) pf[i] = (const float*)d_in[i];
    p.out = (float*)d_out; p.ws = (unsigned char*)d_ws;
    unsigned char* ws = p.ws;
    (void)hipMemsetAsync(ws, 0, WS_ZERO_BYTES, stream);
    hipLaunchKernelGGL(k_prep_a, dim3(256), dim3(512), 0, stream, p);
    hipLaunchKernelGGL(k_prep_b, dim3(256), dim3(512), 0, stream, p);
    static bool attr_done = false;
    if (!attr_done) {
        (void)hipFuncSetAttribute((const void*)k_gemm_fast<1>, hipFuncAttributeMaxDynamicSharedMemorySize, LDS_BYTES);
        (void)hipFuncSetAttribute((const void*)k_gemm_fast<3>, hipFuncAttributeMaxDynamicSharedMemorySize, LDS_BYTES);
        (void)hipFuncSetAttribute((const void*)k_gemm_fast<4>, hipFuncAttributeMaxDynamicSharedMemorySize, LDS_BYTES);
        (void)hipFuncSetAttribute((const void*)k_gemm_fast<5>, hipFuncAttributeMaxDynamicSharedMemorySize, LDS_BYTES);
        (void)hipFuncSetAttribute((const void*)k_attn_fast, hipFuncAttributeMaxDynamicSharedMemorySize, LDS_BYTES);
        attr_done = true;
    }
    hipLaunchKernelGGL(k_gemm_fast<1>, dim3(256), dim3(512), LDS_BYTES, stream, p);
    hipLaunchKernelGGL(k_attn_fast, dim3(256), dim3(512), LDS_BYTES, stream, p);
    hipLaunchKernelGGL(k_gemm_fast<3>, dim3(256), dim3(512), LDS_BYTES, stream, p);
    hipLaunchKernelGGL(k_gemm_fast<4>, dim3(256), dim3(512), LDS_BYTES, stream, p);
    hipLaunchKernelGGL(k_gemm_fast<5>, dim3(256), dim3(512), LDS_BYTES, stream, p);
    hipLaunchKernelGGL(k_final, dim3(2048), dim3(512), 0, stream, p);
}
```

```cpp
#include <hip/hip_runtime.h>
#include <hip/hip_cooperative_groups.h>
#include <cstdio>
#include <cstdint>

namespace cg = cooperative_groups;
typedef unsigned short bf16_t;
typedef float f32x4 __attribute__((ext_vector_type(4)));
typedef float f32x2 __attribute__((ext_vector_type(2)));
typedef unsigned u32x4 __attribute__((ext_vector_type(4)));
typedef unsigned u32x2 __attribute__((ext_vector_type(2)));
typedef __bf16 bf16x2_t __attribute__((ext_vector_type(2)));

constexpr int NB = 32, SEQ = 2048, DM = 1024, CTX = 256, FF = 4096, NQKV = 3072, NKVC = 2048;
constexpr int MLAT = NB * SEQ, MCTX = NB * CTX, MALL = MLAT + MCTX;
constexpr int MODN = 6 * DM;
constexpr float EPS = 1e-6f;
constexpr float LOG2E = 1.4426950408889634f;
constexpr float C2 = 0.125f * LOG2E;
constexpr float LAM_INIT = 0.2f;
constexpr float NEGBIG = -1e30f;

constexpr size_t MiB = 1u << 20;
constexpr size_t WS_CTL = 0;
constexpr size_t WS_MOD = 1 * MiB;
constexpr size_t WS_BIAS1 = 2 * MiB;
constexpr size_t WS_ROPE = 3 * MiB;
constexpr size_t WS_LAM = 3 * MiB + 65536;
constexpr size_t WS_ZERO_BYTES = 3 * MiB;
constexpr size_t WS_SSQ1 = 4 * MiB;
constexpr size_t WS_SSQ2 = 8 * MiB;
constexpr size_t WS_WIN = 12 * MiB;
constexpr size_t WS_WOUT = 18 * MiB;
constexpr size_t WS_W1 = 20 * MiB;
constexpr size_t WS_W2 = 28 * MiB;
constexpr size_t WS_KVC = 36 * MiB;
constexpr size_t WS_A2 = 84 * MiB;
constexpr size_t WS_MIX = 212 * MiB;
constexpr size_t WS_A1 = 340 * MiB;
constexpr size_t WS_QKV = 484 * MiB;
constexpr size_t WS_HID = 340 * MiB;
constexpr size_t WS_END = 868 * MiB;

struct Params {
    const float *x, *c, *ctx, *c_ctx, *w_mod, *b_mod, *norm1_g, *w_in, *lam_q1, *lam_k1, *lam_q2, *lam_k2, *subln_g, *rpb, *w_out, *norm2_g, *w_fc1, *w_fc2, *final_g;
    float* out; unsigned char* ws;
};

__device__ __forceinline__ unsigned pk2(float lo, float hi) { f32x2 v = {lo, hi}; bf16x2_t b = __builtin_convertvector(v, bf16x2_t); return __builtin_bit_cast(unsigned, b); }
__device__ __forceinline__ float bf_lo(unsigned w) { return __uint_as_float(w << 16); }
__device__ __forceinline__ float bf_hi(unsigned w) { return __uint_as_float(w & 0xffff0000u); }
__device__ __forceinline__ float bf2f(bf16_t v) { return __uint_as_float(((unsigned)v) << 16); }
__device__ __forceinline__ float wave_sum(float v) {
#pragma unroll
    for (int o = 1; o < 64; o <<= 1) v += __shfl_xor(v, o);
    return v;
}
__device__ __forceinline__ float wave_max(float v) {
#pragma unroll
    for (int o = 1; o < 64; o <<= 1) v = fmaxf(v, __shfl_xor(v, o));
    return v;
}
__host__ __device__ __forceinline__ int win_src_col(int n) {
    const bool perm = (n < 512) || (n >= 1024 && n < 1536);
    if (!perm) return n;
    const int nd = n & 63, base = n - nd, i = nd >> 1, par = nd & 1;
    const int old = (i < 16 ? i : 32 + (i - 16)) + 16 * par;
    return base + old;
}

template <bool PERMW>
__device__ __forceinline__ void transpose_item(const float* __restrict__ W, int K, int N, bf16_t* __restrict__ WT, float* scr, int item, int lane) {
    const int nblk = N / 32, kb = item / nblk, nb = item % nblk, k0 = 64 * kb, n0 = 32 * nb;
    const int nsrc = PERMW ? win_src_col(n0 + (lane & 31)) : (n0 + (lane & 31));
#pragma unroll 8
    for (int i = 0; i < 32; ++i) { const int kk = 2 * i + (lane >> 5); scr[kk * 33 + (lane & 31)] = W[(size_t)(k0 + kk) * N + nsrc]; }
    __builtin_amdgcn_s_waitcnt(0xC07F); asm volatile("" ::: "memory");
    const int c = lane & 7;
#pragma unroll
    for (int j = 0; j < 4; ++j) { const int n = (lane >> 3) + 8 * j; const float* s = scr + (8 * c) * 33 + n;
        u32x4 o; o.x = pk2(s[0 * 33], s[1 * 33]); o.y = pk2(s[2 * 33], s[3 * 33]); o.z = pk2(s[4 * 33], s[5 * 33]); o.w = pk2(s[6 * 33], s[7 * 33]);
        *(u32x4*)(WT + (size_t)(n0 + n) * K + k0 + 8 * c) = o; }
    __builtin_amdgcn_s_waitcnt(0xC07F); asm volatile("" ::: "memory");
}
template <int NR, bool SILU>
__device__ __forceinline__ void small_mm_task(const float* __restrict__ src, size_t src_stride, const float* __restrict__ last_row, const float* __restrict__ W, int N,
                                              int k0, int n0, float* out, size_t out_stride, const float* __restrict__ bias, float* scr, int lane) {
#pragma unroll
    for (int r = 0; r < NR; ++r) {
        const float* sr = (last_row && r == NR - 1) ? last_row : src + (size_t)r * src_stride;
        float v = sr[k0 + lane];
        if (SILU) v = v / (1.0f + __expf(-v));
        scr[r * 64 + lane] = v;
    }
    __builtin_amdgcn_s_waitcnt(0xC07F); asm volatile("" ::: "memory");
    float acc[NR];
#pragma unroll
    for (int r = 0; r < NR; ++r) acc[r] = 0.f;
#pragma unroll 1
    for (int kk = 0; kk < 64; kk += 4) {
        const float w0 = W[(size_t)(k0 + kk + 0) * N + n0 + lane], w1 = W[(size_t)(k0 + kk + 1) * N + n0 + lane];
        const float w2 = W[(size_t)(k0 + kk + 2) * N + n0 + lane], w3 = W[(size_t)(k0 + kk + 3) * N + n0 + lane];
#pragma unroll
        for (int r = 0; r < NR; ++r) { const f32x4 s = *(const f32x4*)(scr + r * 64 + kk); acc[r] += s.x * w0 + s.y * w1 + s.z * w2 + s.w * w3; }
    }
    const float bv = (bias && k0 == 0) ? bias[n0 + lane] : 0.f;
#pragma unroll
    for (int r = 0; r < NR; ++r) atomicAdd(out + (size_t)r * out_stride + n0 + lane, acc[r] + bv);
    __builtin_amdgcn_s_waitcnt(0xC07F); asm volatile("" ::: "memory");
}

__device__ __forceinline__ void phase_prep_a(const Params& p, float* scr  , int gw, int NGW, int lane) {
    unsigned char* ws = p.ws;
    constexpr int T_MOD = (MODN / 64) * (DM / 64);
    constexpr int I_IN = (DM / 64) * (NQKV / 32), I_OUT = (DM / 64) * (DM / 32), I_1 = (DM / 64) * (FF / 32), I_2 = (FF / 64) * (DM / 32);
    constexpr int T_ALL = T_MOD + I_IN + I_OUT + I_1 + I_2 + 17;
    for (int t = gw; t < T_ALL; t += NGW) {
        int r = t;
        if (r < T_MOD) { const int nb = r % (MODN / 64), kc = r / (MODN / 64);
            small_mm_task<33, true>(p.c, DM, p.c_ctx, p.w_mod, MODN, kc * 64, nb * 64, (float*)(ws + WS_MOD), MODN, p.b_mod, scr, lane); continue; }
        r -= T_MOD;
        if (r < I_IN) { transpose_item<true>(p.w_in, DM, NQKV, (bf16_t*)(ws + WS_WIN), scr, r, lane); continue; } r -= I_IN;
        if (r < I_OUT) { transpose_item<false>(p.w_out, DM, DM, (bf16_t*)(ws + WS_WOUT), scr, r, lane); continue; } r -= I_OUT;
        if (r < I_1) { transpose_item<false>(p.w_fc1, DM, FF, (bf16_t*)(ws + WS_W1), scr, r, lane); continue; } r -= I_1;
        if (r < I_2) { transpose_item<false>(p.w_fc2, FF, DM, (bf16_t*)(ws + WS_W2), scr, r, lane); continue; } r -= I_2;
        if (r < 16) {
            const int pos = 4 * r + (lane >> 4), f = lane & 15;
            const float inv = powf(10000.0f, -(float)f / 16.0f);
            const float ang = (float)pos * inv;
            float* T = (float*)(ws + WS_ROPE) + (pos * 16 + f) * 2;
            T[0] = cosf(ang); T[1] = sinf(ang);
        } else {
            const float a = wave_sum(p.lam_q1[lane] * p.lam_k1[lane]), b = wave_sum(p.lam_q2[lane] * p.lam_k2[lane]);
            if (lane == 0) *(float*)(ws + WS_LAM) = expf(a) - expf(b) + LAM_INIT;
        }
    }
}
__device__ __forceinline__ void phase_prep_b(const Params& p, float* scr, int gw, int NGW, int lane) {
    unsigned char* ws = p.ws;
    const float* mod = (const float*)(ws + WS_MOD);
    constexpr int T_B1 = (FF / 64) * (DM / 64);
    for (int t = gw; t < T_B1; t += NGW) { const int nb = t % (FF / 64), kc = t / (FF / 64);
        small_mm_task<32, false>(mod + 3 * DM, MODN, nullptr, p.w_fc1, FF, kc * 64, nb * 64, (float*)(ws + WS_BIAS1), FF, nullptr, scr, lane); }
    bf16_t* A1 = (bf16_t*)(ws + WS_A1);
    for (int row = gw; row < MALL; row += NGW) {
        const float* xr; const float* mrow;
        if (row < MLAT) { xr = p.x + (size_t)row * DM; mrow = mod + (size_t)(row >> 11) * MODN; }
        else { xr = p.ctx + (size_t)(row - MLAT) * DM; mrow = mod + (size_t)32 * MODN; }
        f32x4 v[4]; float ss = 0.f;
#pragma unroll
        for (int j = 0; j < 4; ++j) { v[j] = *((const f32x4*)xr + lane + 64 * j); ss += (v[j].x * v[j].x + v[j].y * v[j].y) + (v[j].z * v[j].z + v[j].w * v[j].w); }
        const float rstd = rsqrtf(wave_sum(ss) * (1.0f / DM) + EPS);
#pragma unroll
        for (int j = 0; j < 4; ++j) {
            const int col = 4 * lane + 256 * j;
            const f32x4 g = *(const f32x4*)(p.norm1_g + col), sh = *(const f32x4*)(mrow + col), sc = *(const f32x4*)(mrow + DM + col);
            const f32x4 h = (v[j] * rstd) * g * (sc + 1.0f) + sh;
            u32x2 o; o.x = pk2(h.x, h.y); o.y = pk2(h.z, h.w);
            *(u32x2*)(A1 + (size_t)row * DM + col) = o;
        }
    }
}
struct E_QKV {
    static constexpr bool SSQ = false;
    bf16_t* qkv; bf16_t* kvc; const float* rope;
    struct Col {};
    __device__ __forceinline__ float rowval(int) const { return 0.f; }
    __device__ __forceinline__ Col col_prep(int, int) const { return Col{}; }
    __device__ __forceinline__ float epi8(int row, int col0, const Col&, const float (&a)[8], float) const {
        float v[8];
#pragma unroll
        for (int j = 0; j < 8; ++j) v[j] = a[j];
        if (row < MLAT) {
            const bool rope_cols = (col0 < 512) || (col0 >= 1024 && col0 < 1536);
            if (rope_cols) {
                const int s = row & (SEQ - 1), gr = s >> 6, gc = s & 63;
                const int i0 = (col0 & 63) >> 1, pos = (i0 >= 16) ? gc : gr, f0 = i0 & 15;
                const f32x4* T = (const f32x4*)(rope + (pos * 16 + f0) * 2);
                const f32x4 t0 = T[0], t1 = T[1];
                const float cs[4] = {t0.x, t0.z, t1.x, t1.z}, sn[4] = {t0.y, t0.w, t1.y, t1.w};
#pragma unroll
                for (int q = 0; q < 4; ++q) { const float x1 = v[2 * q], x2 = v[2 * q + 1]; v[2 * q] = x1 * cs[q] - x2 * sn[q]; v[2 * q + 1] = x1 * sn[q] + x2 * cs[q]; }
            }
            if (col0 < 1024) {
#pragma unroll
                for (int j = 0; j < 8; ++j) v[j] *= C2;
            }
            u32x4 o; o.x = pk2(v[0], v[1]); o.y = pk2(v[2], v[3]); o.z = pk2(v[4], v[5]); o.w = pk2(v[6], v[7]);
            *(u32x4*)(qkv + (size_t)row * NQKV + col0) = o;
        } else if (col0 >= 1024) {
            u32x4 o; o.x = pk2(v[0], v[1]); o.y = pk2(v[2], v[3]); o.z = pk2(v[4], v[5]); o.w = pk2(v[6], v[7]);
            *(u32x4*)(kvc + (size_t)(row - MLAT) * NKVC + (col0 - 1024)) = o;
        }
        return 0.f;
    }
};
struct E_OUT {
    static constexpr bool SSQ = true;
    const float* x; float* x1; bf16_t* a2; const float* mod; const float* g2;
    struct Col { float ga[8], gm[8]; };
    __device__ __forceinline__ float rowval(int) const { return 0.f; }
    __device__ __forceinline__ Col col_prep(int b, int col0) const {
        Col c; const float* m = mod + (size_t)b * MODN;
#pragma unroll
        for (int j = 0; j < 8; ++j) { c.ga[j] = m[2 * DM + col0 + j]; c.gm[j] = g2[col0 + j] * (1.0f + m[4 * DM + col0 + j]); }
        return c;
    }
    __device__ __forceinline__ float epi8(int row, int col0, const Col& c, const float (&a)[8], float) const {
        const size_t off = (size_t)row * DM + col0;
        const f32x4 x0 = *(const f32x4*)(x + off), x4 = *(const f32x4*)(x + off + 4);
        float v[8] = {x0.x, x0.y, x0.z, x0.w, x4.x, x4.y, x4.z, x4.w}; float ss = 0.f;
#pragma unroll
        for (int j = 0; j < 8; ++j) { v[j] += c.ga[j] * a[j]; ss += v[j] * v[j]; }
        *(f32x4*)(x1 + off) = (f32x4){v[0], v[1], v[2], v[3]}; *(f32x4*)(x1 + off + 4) = (f32x4){v[4], v[5], v[6], v[7]};
        u32x4 o; o.x = pk2(v[0] * c.gm[0], v[1] * c.gm[1]); o.y = pk2(v[2] * c.gm[2], v[3] * c.gm[3]); o.z = pk2(v[4] * c.gm[4], v[5] * c.gm[5]); o.w = pk2(v[6] * c.gm[6], v[7] * c.gm[7]);
        *(u32x4*)(a2 + off) = o;
        return ss;
    }
};
struct E_FC1 {
    static constexpr bool SSQ = false;
    const float* ssq1; const float* bias1; bf16_t* hid;
    struct Col { float bs[8]; };
    __device__ __forceinline__ float rowval(int row) const {
        const f32x4* s = (const f32x4*)(ssq1 + (size_t)row * 16); const f32x4 a = s[0], b = s[1], c = s[2], d = s[3];
        const float t = ((a.x + a.y) + (a.z + a.w)) + ((b.x + b.y) + (b.z + b.w)) + ((c.x + c.y) + (c.z + c.w)) + ((d.x + d.y) + (d.z + d.w));
        return rsqrtf(t * (1.0f / DM) + EPS);
    }
    __device__ __forceinline__ Col col_prep(int b, int col0) const { Col c;
#pragma unroll
        for (int j = 0; j < 8; ++j) c.bs[j] = bias1[(size_t)b * FF + col0 + j];
        return c; }
    __device__ __forceinline__ float epi8(int row, int col0, const Col& c, const float (&a)[8], float rv) const {
        float v[8];
#pragma unroll
        for (int j = 0; j < 8; ++j) { const float z = fmaxf(rv * a[j] + c.bs[j], 0.f); v[j] = z * z; }
        u32x4 o; o.x = pk2(v[0], v[1]); o.y = pk2(v[2], v[3]); o.z = pk2(v[4], v[5]); o.w = pk2(v[6], v[7]);
        *(u32x4*)(hid + (size_t)row * FF + col0) = o;
        return 0.f;
    }
};
struct E_FC2 {
    static constexpr bool SSQ = true;
    float* xio; const float* mod;
    struct Col { float gm[8]; };
    __device__ __forceinline__ float rowval(int) const { return 0.f; }
    __device__ __forceinline__ Col col_prep(int b, int col0) const { Col c; const float* m = mod + (size_t)b * MODN + 5 * DM + col0;
#pragma unroll
        for (int j = 0; j < 8; ++j) c.gm[j] = m[j];
        return c; }
    __device__ __forceinline__ float epi8(int row, int col0, const Col& c, const float (&a)[8], float) const {
        const size_t off = (size_t)row * DM + col0;
        const f32x4 x0 = *(const f32x4*)(xio + off), x4 = *(const f32x4*)(xio + off + 4);
        float v[8] = {x0.x, x0.y, x0.z, x0.w, x4.x, x4.y, x4.z, x4.w}; float ss = 0.f;
#pragma unroll
        for (int j = 0; j < 8; ++j) { v[j] += c.gm[j] * a[j]; ss += v[j] * v[j]; }
        *(f32x4*)(xio + off) = (f32x4){v[0], v[1], v[2], v[3]}; *(f32x4*)(xio + off + 4) = (f32x4){v[4], v[5], v[6], v[7]};
        return ss;
    }
};

__device__ __forceinline__ int opaque_tid() { int t = threadIdx.x; asm volatile("" : "+v"(t)); return t; }
namespace pg8 {
#define PG8_LAS __attribute__((address_space(3)))
typedef unsigned short bf16_t;
typedef short bf16x8 __attribute__((ext_vector_type(8)));
typedef float f32x4 __attribute__((ext_vector_type(4)));
typedef unsigned u32x4 __attribute__((ext_vector_type(4)));
constexpr int BM = 256, BK = 64, HALF = 128, HTB = HALF * BK * 2  , STAGE_BYTES = 8 * HTB, NXCD = 8, WGM = 8;

__host__ __device__ __forceinline__ int lds_byte(int r, int c) { const int st = (r >> 4) * 2 + (c >> 5), rr = r & 15, cc = c & 31, ob = rr * 64 + cc * 2; return st * 1024 + (ob ^ (((ob >> 9) & 1) << 5)); }
__host__ __device__ __forceinline__ void stage_rc(int b, int& R, int& C) { const int st = b / 1024, sb = b % 1024, swz = sb ^ (((sb >> 9) & 1) << 5); R = (st >> 1) * 16 + swz / 64; C = (st & 1) * 32 + (swz % 64) / 2; }
__host__ __device__ __forceinline__ int perm32(int rho) { const int n = rho >> 4, i = rho & 15; return 8 * (i >> 2) + 4 * n + (i & 3); }

struct Unit { int pm, pn; };
struct Gemm { const bf16_t* A; const bf16_t* Bt; int M, N, K; };

struct StaticOrder {
    int nM, nN, nwg, G, c;
    __host__ __device__ void init(int M, int N, int G_, int c_) { nM = M / BM; nN = N / BM; nwg = nM * nN; G = G_; c = c_; }
    __host__ __device__ bool next(int i, Unit& u) const {
        const long L = (long)i * G + c; if (L >= nwg) return false;
        int wgid = (int)L; { const int q = nwg / NXCD, r = nwg % NXCD, xcd = wgid % NXCD, off = wgid / NXCD; wgid = (xcd < r ? xcd * (q + 1) : r * (q + 1) + (xcd - r) * q) + off; }
        const int nig = WGM * nN, gid = wgid / nig, fm = gid * WGM, gsz = (nM - fm) < WGM ? (nM - fm) : WGM;
        u.pm = fm + ((wgid % nig) % gsz); u.pn = (wgid % nig) / gsz; return true;
    }
    __device__ __forceinline__ void a_ready(const Unit&) const {}
    __device__ __forceinline__ void done(const Unit&) const {}
};


template <class Epi, class Sched, bool ALIGN_EPI = false, bool SP2 = false>
__device__ __forceinline__ void gemm_phase(PG8_LAS unsigned char* lds, const Gemm g, const Sched& S, const Epi& E) {
    const int tid = opaque_tid(), wid = __builtin_amdgcn_readfirstlane(tid >> 6), lane = tid & 63, wr = wid >> 2, wc = wid & 3, fr = lane & 15, fq = lane >> 4;
    const int K = g.K, nt = K / BK;
    unsigned voffA[2], voffB[2];
#pragma unroll
    for (int i = 0; i < 2; ++i) { int R, C; stage_rc(tid * 16 + i * 8192, R, C); const int Rb = Epi::PERM ? ((R & ~31) + perm32(R & 31)) : R;
        voffA[i] = (unsigned)(R * K + C) * 2u; voffB[i] = (unsigned)(Rb * K + C) * 2u; }
    const size_t kstep = (size_t)(BK * 2);
    const size_t hstep = (size_t)HALF * K * 2;
    const size_t tstep = 2 * hstep;
    const unsigned ldsw = (unsigned)wid * 1024u;
    const int aoff = lds_byte(wr * 64 + fr, fq * 8), boff = lds_byte(wc * 32 + fr, fq * 8);
#define PG8_SA(b, h) (((b) * 2 + (h)) * HTB)
#define PG8_SB(b, h) ((4 + (b) * 2 + (h)) * HTB)
#define PG8_STAGE(bufoff, gbase, voff) do { _Pragma("unroll") for (int _i = 0; _i < 2; ++_i) \
        __builtin_amdgcn_global_load_lds((const unsigned*)((const char*)(gbase) + (voff)[_i]), (PG8_LAS unsigned*)(lds + (bufoff) + ldsw + _i * 8192), 16, 0, 0); } while (0)
#define PG8_LDA(dst, b, h) do { _Pragma("unroll") for (int m = 0; m < 4; ++m) _Pragma("unroll") for (int k = 0; k < 2; ++k) dst[m][k] = *(const PG8_LAS bf16x8*)(lds + PG8_SA(b, h) + aoff + m * 2048 + k * 1024); } while (0)
#define PG8_LDB(dst, b, h) do { _Pragma("unroll") for (int n = 0; n < 2; ++n) _Pragma("unroll") for (int k = 0; k < 2; ++k) dst[n][k] = *(const PG8_LAS bf16x8*)(lds + PG8_SB(b, h) + boff + n * 2048 + k * 1024); } while (0)
#define PG8_MMA(ai, bj, At, Bt) do { __builtin_amdgcn_s_setprio(1); _Pragma("unroll") for (int m = 0; m < 4; ++m) _Pragma("unroll") for (int n = 0; n < 2; ++n) _Pragma("unroll") for (int k = 0; k < 2; ++k) \
        acc[ai][bj][m][n] = __builtin_amdgcn_mfma_f32_16x16x32_bf16(Bt[n][k], At[m][k], acc[ai][bj][m][n], 0, 0, 0); __builtin_amdgcn_s_setprio(0); } while (0)
#define PG8_WAIT_V(n) asm volatile("s_waitcnt vmcnt(" #n ")" ::: "memory")
#define PG8_WAIT_L(n) asm volatile("s_waitcnt lgkmcnt(" #n ")" ::: "memory")
#define PG8_BAR __builtin_amdgcn_s_barrier()
#define PG8_SCHED __builtin_amdgcn_sched_barrier(0)
    Unit cur, nxt; int ui = 0;
    if (!S.next(0, cur)) return;
    f32x4 acc[2][2][4][2];
#pragma unroll
    for (int a = 0; a < 2; ++a)
#pragma unroll
        for (int b = 0; b < 2; ++b)
#pragma unroll
            for (int m = 0; m < 4; ++m)
#pragma unroll
                for (int n = 0; n < 2; ++n) acc[a][b][m][n] = (f32x4){0.f, 0.f, 0.f, 0.f};
    bf16x8 At[4][2], B0[2][2], B1[2][2];
    const char* cA = (const char*)g.A + (size_t)cur.pm * tstep; const char* cB = (const char*)g.Bt + (size_t)cur.pn * tstep;
    S.a_ready(cur);
    if constexpr (SP2) {
        PG8_STAGE(PG8_SB(0, 0), cB, voffB); PG8_STAGE(PG8_SB(0, 1), cB + hstep, voffB); PG8_STAGE(PG8_SA(0, 0), cA, voffA); PG8_STAGE(PG8_SA(0, 1), cA + hstep, voffA);
        if (wr == 1) PG8_BAR;
        PG8_WAIT_V(2); PG8_BAR;
        PG8_STAGE(PG8_SB(1, 0), cB + kstep, voffB); PG8_STAGE(PG8_SA(1, 0), cA + kstep, voffA); PG8_STAGE(PG8_SB(1, 1), cB + hstep + kstep, voffB);
        PG8_WAIT_V(6); PG8_BAR;
    } else {
        PG8_STAGE(PG8_SB(0, 0), cB, voffB); PG8_STAGE(PG8_SA(0, 0), cA, voffA); PG8_STAGE(PG8_SB(0, 1), cB + hstep, voffB); PG8_STAGE(PG8_SA(0, 1), cA + hstep, voffA);
        if (wr == 1) PG8_BAR;
        PG8_WAIT_V(4); PG8_BAR;
        PG8_STAGE(PG8_SB(1, 0), cB + kstep, voffB); PG8_STAGE(PG8_SA(1, 0), cA + kstep, voffA); PG8_STAGE(PG8_SB(1, 1), cB + hstep + kstep, voffB);
        PG8_WAIT_V(6); PG8_BAR;
    }
    for (;;) {
        const bool has_next = S.next(ui + 1, nxt);
        const char* nA = has_next ? (const char*)g.A + (size_t)nxt.pm * tstep : cA; const char* nB = has_next ? (const char*)g.Bt + (size_t)nxt.pn * tstep : cB;
        for (int t = 0; t < nt; t += 2) {
            const bool last = (t == nt - 2);
            const char* a1 = cA + (size_t)(t + 1) * kstep;
            const char* a2 = last ? nA : cA + (size_t)(t + 2) * kstep; const char* b2 = last ? nB : cB + (size_t)(t + 2) * kstep;
            const char* a3 = a2 + kstep; const char* b3 = b2 + kstep;
            if (last && has_next) S.a_ready(nxt);
            if constexpr (SP2) {
            PG8_LDB(B0, 0, 0); PG8_LDB(B1, 0, 1); PG8_SCHED; PG8_LDA(At, 0, 0); PG8_STAGE(PG8_SA(1, 1), a1 + hstep, voffA);
            PG8_WAIT_V(8); PG8_WAIT_L(0); PG8_BAR; PG8_MMA(0, 0, At, B0); PG8_MMA(0, 1, At, B1); PG8_BAR; PG8_SCHED;
            PG8_LDA(At, 0, 1); PG8_STAGE(PG8_SB(0, 0), b2, voffB); PG8_STAGE(PG8_SB(0, 1), b2 + hstep, voffB); PG8_STAGE(PG8_SA(0, 0), a2, voffA);
            PG8_WAIT_V(8); PG8_WAIT_L(0); PG8_BAR; PG8_MMA(1, 0, At, B0); PG8_MMA(1, 1, At, B1); PG8_BAR; PG8_SCHED;
            PG8_LDB(B0, 1, 0); PG8_LDB(B1, 1, 1); PG8_SCHED; PG8_LDA(At, 1, 0); PG8_STAGE(PG8_SA(0, 1), a2 + hstep, voffA);
            PG8_WAIT_V(8); PG8_WAIT_L(0); PG8_BAR; PG8_MMA(0, 0, At, B0); PG8_MMA(0, 1, At, B1); PG8_BAR; PG8_SCHED;
            PG8_LDA(At, 1, 1); PG8_STAGE(PG8_SB(1, 0), b3, voffB); PG8_STAGE(PG8_SB(1, 1), b3 + hstep, voffB); PG8_STAGE(PG8_SA(1, 0), a3, voffA);
            PG8_WAIT_V(8); PG8_WAIT_L(0); PG8_BAR; PG8_MMA(1, 0, At, B0); PG8_MMA(1, 1, At, B1); PG8_BAR; PG8_SCHED;
            } else {
            PG8_LDB(B0, 0, 0); PG8_SCHED; PG8_LDA(At, 0, 0); PG8_STAGE(PG8_SA(1, 1), a1 + hstep, voffA);
            PG8_WAIT_L(8); PG8_BAR; PG8_WAIT_L(0); PG8_MMA(0, 0, At, B0); PG8_BAR; PG8_SCHED;
            PG8_LDB(B1, 0, 1); PG8_STAGE(PG8_SB(0, 0), b2, voffB);
            PG8_BAR; PG8_WAIT_L(0); PG8_MMA(0, 1, At, B1); PG8_BAR;
            PG8_LDA(At, 0, 1); PG8_STAGE(PG8_SA(0, 0), a2, voffA);
            PG8_BAR; PG8_WAIT_L(0); PG8_MMA(1, 0, At, B0); PG8_BAR; PG8_SCHED;
            PG8_STAGE(PG8_SB(0, 1), b2 + hstep, voffB);
            PG8_WAIT_V(6); PG8_BAR; PG8_MMA(1, 1, At, B1); PG8_BAR;
            PG8_LDB(B0, 1, 0); PG8_SCHED; PG8_LDA(At, 1, 0); PG8_STAGE(PG8_SA(0, 1), a2 + hstep, voffA);
            PG8_WAIT_L(8); PG8_BAR; PG8_WAIT_L(0); PG8_MMA(0, 0, At, B0); PG8_BAR; PG8_SCHED;
            PG8_LDB(B1, 1, 1); PG8_STAGE(PG8_SB(1, 0), b3, voffB);
            PG8_BAR; PG8_WAIT_L(0); PG8_MMA(0, 1, At, B1); PG8_BAR;
            PG8_LDA(At, 1, 1); PG8_STAGE(PG8_SA(1, 0), a3, voffA);
            PG8_BAR; PG8_WAIT_L(0); PG8_MMA(1, 0, At, B0); PG8_BAR; PG8_SCHED;
            PG8_STAGE(PG8_SB(1, 1), b3 + hstep, voffB);
            PG8_WAIT_V(6); PG8_BAR; PG8_MMA(1, 1, At, B1); PG8_BAR;
            }
        }
        if constexpr (ALIGN_EPI) { if (wr == 0) PG8_BAR; }
        if constexpr (!Epi::AFTER_DRAIN) { E(acc, cur, wr, wc, fr, fq); S.done(cur); }
        if (!has_next) break;
#pragma unroll
        for (int a = 0; a < 2; ++a)
#pragma unroll
            for (int b = 0; b < 2; ++b)
#pragma unroll
                for (int m = 0; m < 4; ++m)
#pragma unroll
                    for (int n = 0; n < 2; ++n) acc[a][b][m][n] = (f32x4){0.f, 0.f, 0.f, 0.f};
        cur = nxt; cA = nA; cB = nB; ++ui;
        if constexpr (ALIGN_EPI) { if (wr == 1) PG8_BAR; }
    }
    PG8_WAIT_V(0);
    if constexpr (!ALIGN_EPI) { if (wr == 0) PG8_BAR; }
    PG8_BAR;
    if constexpr (Epi::AFTER_DRAIN) { E.fused(acc, cur, wr, wc, fr, fq, lds, wid, lane); S.done(cur); }
#undef PG8_SA
#undef PG8_SB
#undef PG8_STAGE
#undef PG8_LDA
#undef PG8_LDB
#undef PG8_MMA
#undef PG8_WAIT_V
#undef PG8_WAIT_L
#undef PG8_BAR
#undef PG8_SCHED
}
}


#define LAS __attribute__((address_space(3)))
template <class E8> struct EpiWrap {
    static constexpr bool PERM = true, AFTER_DRAIN = false;
    E8 e; float* ssq;
    __device__ __forceinline__ void operator()(const pg8::f32x4 (&acc)[2][2][4][2], const pg8::Unit& u, int wr, int wc, int fr, int fq) const {
        const int rowb = u.pm * 256 + wr * 64 + fr;
        const int b = (u.pm < 256) ? (u.pm >> 3) : 0;
        float rv[2][4], ss[2][4];
#pragma unroll
        for (int ai = 0; ai < 2; ++ai)
#pragma unroll
            for (int m = 0; m < 4; ++m) { rv[ai][m] = e.rowval(rowb + ai * 128 + m * 16); ss[ai][m] = 0.f; }
#pragma unroll
        for (int bj = 0; bj < 2; ++bj) {
            const int col0 = u.pn * 256 + bj * 128 + wc * 32 + 8 * fq;
            const typename E8::Col cc = e.col_prep(b, col0);
#pragma unroll
            for (int ai = 0; ai < 2; ++ai)
#pragma unroll
                for (int m = 0; m < 4; ++m) {
                    const pg8::f32x4 v0 = acc[ai][bj][m][0], v1 = acc[ai][bj][m][1];
                    const float a[8] = {v0[0], v0[1], v0[2], v0[3], v1[0], v1[1], v1[2], v1[3]};
                    ss[ai][m] += e.epi8(rowb + ai * 128 + m * 16, col0, cc, a, rv[ai][m]);
                    if (m & 1) asm volatile("" ::: "memory");
                }
        }
        if (E8::SSQ) {
#pragma unroll
            for (int ai = 0; ai < 2; ++ai)
#pragma unroll
                for (int m = 0; m < 4; ++m) { float s = ss[ai][m]; s += __shfl_xor(s, 16); s += __shfl_xor(s, 32);
                    if (fq == 0) ssq[(size_t)(rowb + ai * 128 + m * 16) * 16 + u.pn * 4 + wc] = s; }
        }
    }
};
struct QkvOrder {
    pg8::StaticOrder base; int G, c;
    __device__ __forceinline__ void init(int G_, int c_) { base.init(MLAT, NQKV, G_, c_); G = G_; c = c_; }
    __device__ __forceinline__ bool next(int i, pg8::Unit& u) const {
        if (base.next(i, u)) return true;
        const long L = (long)i * G + c - base.nwg; if (L < 0 || L >= 256) return false;
        const int id = (int)L, w = (id & 7) * 32 + (id >> 3);
        u.pm = 256 + (w >> 3); u.pn = 4 + (w & 7); return true;
    }
    __device__ __forceinline__ void a_ready(const pg8::Unit&) const {}
    __device__ __forceinline__ void done(const pg8::Unit&) const {}
};
__device__ __forceinline__ void phase_qkv(const Params& p, LAS unsigned char* lds) {
    unsigned char* ws = p.ws;
    pg8::Gemm g{(const bf16_t*)(ws + WS_A1), (const bf16_t*)(ws + WS_WIN), MALL, NQKV, DM};
    QkvOrder S; S.init((int)gridDim.x, (int)blockIdx.x);
    EpiWrap<E_QKV> E{{(bf16_t*)(ws + WS_QKV), (bf16_t*)(ws + WS_KVC), (const float*)(ws + WS_ROPE)}, nullptr};
    pg8::gemm_phase<EpiWrap<E_QKV>, QkvOrder, true, true>(lds, g, S, E);
}
__device__ __forceinline__ void phase_outproj(const Params& p, LAS unsigned char* lds) {
    unsigned char* ws = p.ws;
    pg8::Gemm g{(const bf16_t*)(ws + WS_MIX), (const bf16_t*)(ws + WS_WOUT), MLAT, DM, DM};
    pg8::StaticOrder S; S.init(MLAT, DM, (int)gridDim.x, (int)blockIdx.x);
    EpiWrap<E_OUT> E{{p.x, p.out, (bf16_t*)(ws + WS_A2), (const float*)(ws + WS_MOD), p.norm2_g}, (float*)(ws + WS_SSQ1)};
    pg8::gemm_phase<EpiWrap<E_OUT>, pg8::StaticOrder, true, true>(lds, g, S, E);
}
__device__ __forceinline__ void phase_fc1(const Params& p, LAS unsigned char* lds) {
    unsigned char* ws = p.ws;
    pg8::Gemm g{(const bf16_t*)(ws + WS_A2), (const bf16_t*)(ws + WS_W1), MLAT, FF, DM};
    pg8::StaticOrder S; S.init(MLAT, FF, (int)gridDim.x, (int)blockIdx.x);
    EpiWrap<E_FC1> E{{(const float*)(ws + WS_SSQ1), (const float*)(ws + WS_BIAS1), (bf16_t*)(ws + WS_HID)}, nullptr};
    pg8::gemm_phase<EpiWrap<E_FC1>, pg8::StaticOrder, true, true>(lds, g, S, E);
}
__device__ __forceinline__ void phase_fc2(const Params& p, LAS unsigned char* lds) {
    unsigned char* ws = p.ws;
    pg8::Gemm g{(const bf16_t*)(ws + WS_HID), (const bf16_t*)(ws + WS_W2), MLAT, DM, FF};
    pg8::StaticOrder S; S.init(MLAT, DM, (int)gridDim.x, (int)blockIdx.x);
    EpiWrap<E_FC2> E{{p.out, (const float*)(ws + WS_MOD)}, (float*)(ws + WS_SSQ2)};
    pg8::gemm_phase<EpiWrap<E_FC2>, pg8::StaticOrder, true, true>(lds, g, S, E);
}
constexpr int LDS_BYTES = 147456;

namespace att {
typedef short bf16x8 __attribute__((ext_vector_type(8)));
typedef short s16x4 __attribute__((ext_vector_type(4)));
typedef short v4i16_t __attribute__((ext_vector_type(4)));
typedef float f32x16 __attribute__((ext_vector_type(16)));
constexpr int RING_BUF = 32768;
constexpr int OFF_STAGE = 0;
constexpr int OFF_WSF = 135168;
constexpr int OFF_RPB = 137216;
constexpr float THR = 8.0f;
__device__ __forceinline__ int crow(int r, int hi) { return (r & 3) + 8 * (r >> 2) + 4 * hi; }
__device__ __forceinline__ s16x4 vtr(LAS const unsigned char* p) { return __builtin_bit_cast(s16x4, __builtin_amdgcn_ds_read_tr16_b64_v4i16((LAS v4i16_t*)p)); }
struct TileSrc { const bf16_t* k; const bf16_t* v; int pitch; };
template <int NP> struct Stage { u32x4 kreg[NP], vreg[NP]; };
template <int NP> __device__ __forceinline__ void stage_load(Stage<NP>& s, const TileSrc& src, int tid) {
#pragma unroll
    for (int i = 0; i < NP; ++i) { const int p = tid + 512 * i, key = p & 63, c = p >> 6;
        s.kreg[i] = *(const u32x4*)(src.k + (size_t)key * src.pitch + c * 8);
        const int kv = (c & 3) * 16 + ((p & 63) >> 2);
        s.vreg[i] = *(const u32x4*)(src.v + (size_t)kv * src.pitch + (c >> 2) * 32 + (p & 3) * 8); }
}
template <int NP> __device__ __forceinline__ void stage_write(const Stage<NP>& s, LAS unsigned char* buf, int tid) {
#pragma unroll
    for (int i = 0; i < NP; ++i) { const int p = tid + 512 * i;
        *(LAS u32x4*)(buf + p * 16) = s.kreg[i];
        *(LAS u32x4*)(buf + NP * 8192 + p * 16) = s.vreg[i]; }
}
template <int NC> struct WaveState { f32x16 o[NC]; float m, l; bf16x8 qr[4]; };
__device__ __forceinline__ void qkt(f32x16& p0, f32x16& p1, LAS const unsigned char* kslot, const bf16x8 (&qr)[4], int r32, int hi) {
    LAS const unsigned char* kb = kslot + hi * 1024 + r32 * 16;
#pragma unroll
    for (int d0 = 0; d0 < 4; ++d0) {
        const bf16x8 b0 = *(LAS const bf16x8*)(kb + d0 * 2048), b1 = *(LAS const bf16x8*)(kb + d0 * 2048 + 512);
        p0 = __builtin_amdgcn_mfma_f32_32x32x16_bf16(b0, qr[d0], p0, 0, 0, 0);
        p1 = __builtin_amdgcn_mfma_f32_32x32x16_bf16(b1, qr[d0], p1, 0, 0, 0);
    }
}
template <int NC> __device__ __forceinline__ void softmax_pv(f32x16& p0, f32x16& p1, WaveState<NC>& st, LAS const unsigned char* vl, LAS float* wsf, int r32, int hi) {
    float mx = fmaxf(p0[0], p1[0]);
#pragma unroll
    for (int r = 1; r < 16; ++r) mx = fmaxf(mx, fmaxf(p0[r], p1[r]));
    mx = fmaxf(mx, __shfl_xor(mx, 32));
    if (__any(mx > st.m + THR)) {
        const float mn = fmaxf(st.m, mx), alpha = __builtin_amdgcn_exp2f(st.m - mn);
        st.m = mn; st.l *= alpha;
        if (hi == 0) wsf[r32] = alpha;
#pragma unroll
        for (int r = 0; r < 16; ++r) { const float a = wsf[crow(r, hi)];
#pragma unroll
            for (int c = 0; c < NC; ++c) st.o[c][r] *= a; }
    }
    float rs = 0.f;
#pragma unroll
    for (int r = 0; r < 16; ++r) { p0[r] = __builtin_amdgcn_exp2f(p0[r] - st.m); p1[r] = __builtin_amdgcn_exp2f(p1[r] - st.m); rs += p0[r] + p1[r]; }
    st.l += rs;
    u32x4 pw[4];
#pragma unroll
    for (int i = 0; i < 4; ++i) { pw[0][i] = pk2(p0[2 * i], p0[2 * i + 1]); pw[1][i] = pk2(p0[8 + 2 * i], p0[9 + 2 * i]); pw[2][i] = pk2(p1[2 * i], p1[2 * i + 1]); pw[3][i] = pk2(p1[8 + 2 * i], p1[9 + 2 * i]); }
#pragma unroll
    for (int c = 0; c < NC; ++c)
#pragma unroll
        for (int s = 0; s < 4; ++s) {
            const s16x4 lo = vtr(vl + c * 4096 + s * 1024), hv = vtr(vl + c * 4096 + s * 1024 + 512);
            const bf16x8 vf = {lo[0], lo[1], lo[2], lo[3], hv[0], hv[1], hv[2], hv[3]};
            st.o[c] = __builtin_amdgcn_mfma_f32_32x32x16_bf16(__builtin_bit_cast(bf16x8, pw[s]), vf, st.o[c], 0, 0, 0);
        }
}
template <int NC> __device__ __forceinline__ void state_init(WaveState<NC>& st, const bf16_t* qrow) {
#pragma unroll
    for (int d0 = 0; d0 < 4; ++d0) st.qr[d0] = *(const bf16x8*)(qrow + 16 * d0);
#pragma unroll
    for (int c = 0; c < NC; ++c)
#pragma unroll
        for (int r = 0; r < 16; ++r) st.o[c][r] = 0.f;
    st.m = NEGBIG; st.l = 0.f;
}

__device__ __forceinline__ void diff_unit(const Params& p, LAS unsigned char* lds, const int tid, int b, int h, int qb, float lam) {
    const int lane = tid & 63, r32 = lane & 31, hi = lane >> 5, wid = __builtin_amdgcn_readfirstlane(tid >> 6), rg = wid & 3, map = wid >> 2;
    const bf16_t* qkv = (const bf16_t*)(p.ws + WS_QKV); const bf16_t* kvc = (const bf16_t*)(p.ws + WS_KVC); bf16_t* mix = (bf16_t*)(p.ws + WS_MIX);
    LAS float* wsf = (LAS float*)(lds + OFF_WSF) + wid * 64;
    const int lanebase = (4 * hi + ((lane & 15) >> 2)) * 64 + ((lane >> 4) & 1) * 32 + (lane & 3) * 8;
    WaveState<4> st;
    state_init<4>(st, qkv + (size_t)(b * SEQ + qb * 128 + rg * 32 + r32) * NQKV + 128 * h + 64 * map + 8 * hi);
    auto tile_src = [&](int t) -> TileSrc {
        if (t < 32) { const bf16_t* base = qkv + (size_t)(b * SEQ + t * 64) * NQKV; return TileSrc{base + 1024 + 128 * h, base + 2048 + 128 * h, NQKV}; }
        const bf16_t* base = kvc + (size_t)(b * CTX + (t - 32) * 64) * NKVC; return TileSrc{base + 128 * h, base + 1024 + 128 * h, NKVC}; };
    Stage<2> sg;
    stage_load<2>(sg, tile_src(0), tid); stage_write<2>(sg, lds, tid);
    __syncthreads();
    for (int t = 0; t < 36; ++t) {
        LAS unsigned char* cur = lds + (t & 1) * RING_BUF;
        if (t + 1 < 36) stage_load<2>(sg, tile_src(t + 1), tid);
        f32x16 p0, p1;
#pragma unroll
        for (int r = 0; r < 16; ++r) { p0[r] = 0.f; p1[r] = 0.f; }
        qkt(p0, p1, cur + map * 8192, st.qr, r32, hi);
        softmax_pv<4>(p0, p1, st, cur + 16384 + lanebase, wsf, r32, hi);
        if (t + 1 < 36) stage_write<2>(sg, lds + ((t + 1) & 1) * RING_BUF, tid);
        __syncthreads();
    }
    {   float lt = st.l + __shfl_xor(st.l, 32);
        if (hi == 0) wsf[r32] = 1.0f / lt;
        LAS float* stg = (LAS float*)(lds + OFF_STAGE);
#pragma unroll
        for (int r = 0; r < 16; ++r) { const float inv = wsf[crow(r, hi)]; const int R = map * 128 + rg * 32 + crow(r, hi);
#pragma unroll
            for (int c = 0; c < 4; ++c) stg[R * 132 + 32 * c + r32] = st.o[c][r] * inv; }
        __syncthreads();
        const int row = tid >> 2, part = tid & 3;
        float o[32]; float ss = 0.f;
#pragma unroll
        for (int i = 0; i < 8; ++i) { const f32x4 a = *(LAS const f32x4*)(stg + row * 132 + part * 32 + 4 * i), bb = *(LAS const f32x4*)(stg + (128 + row) * 132 + part * 32 + 4 * i);
#pragma unroll
            for (int e = 0; e < 4; ++e) { const float v = a[e] - lam * bb[e]; o[4 * i + e] = v; ss += v * v; } }
        ss += __shfl_xor(ss, 1); ss += __shfl_xor(ss, 2);
        const float rstd = rsqrtf(ss * (1.0f / 128.0f) + EPS) * (1.0f - LAM_INIT);
        bf16_t* dst = mix + (size_t)(b * SEQ + qb * 128 + row) * DM + 128 * h + part * 32;
#pragma unroll
        for (int i = 0; i < 4; ++i) { const f32x4 g0 = *(const f32x4*)(p.subln_g + part * 32 + 8 * i), g1 = *(const f32x4*)(p.subln_g + part * 32 + 8 * i + 4);
            u32x4 w; w.x = pk2(o[8 * i] * rstd * g0.x, o[8 * i + 1] * rstd * g0.y); w.y = pk2(o[8 * i + 2] * rstd * g0.z, o[8 * i + 3] * rstd * g0.w);
            w.z = pk2(o[8 * i + 4] * rstd * g1.x, o[8 * i + 5] * rstd * g1.y); w.w = pk2(o[8 * i + 6] * rstd * g1.z, o[8 * i + 7] * rstd * g1.w);
            *(u32x4*)(dst + 8 * i) = w; }
        __syncthreads();
    }
}
__device__ __forceinline__ void na_unit(const Params& p, LAS unsigned char* lds, const int tid, int b, int hh, int rg4) {
    const int lane = tid & 63, r32 = lane & 31, hi = lane >> 5, wid = __builtin_amdgcn_readfirstlane(tid >> 6);
    const bf16_t* qkv = (const bf16_t*)(p.ws + WS_QKV); const bf16_t* kvc = (const bf16_t*)(p.ws + WS_KVC); bf16_t* mix = (bf16_t*)(p.ws + WS_MIX);
    LAS float* wsf = (LAS float*)(lds + OFF_WSF) + wid * 64;
    LAS float* rpbL = (LAS float*)(lds + OFF_RPB);
    const int lanebase = (4 * hi + ((lane & 15) >> 2)) * 64 + ((lane >> 4) & 1) * 32 + (lane & 3) * 8;
    const int gr = 4 * rg4 + (wid >> 1), chh = wid & 1, jq = 32 * chh + r32;
    const int start = min(max(gr - 4, 0), 24), cs = min(max(jq - 8, 0), 48);
    const int kr_lo = min(max(4 * rg4 - 4, 0), 24), kr_hi = min(max(4 * rg4 - 1, 0), 24) + 7, nlat = kr_hi - kr_lo + 1, nt = nlat + 4;
    if (tid < 465) rpbL[tid] = p.rpb[hh * 465 + tid] * LOG2E;
    WaveState<2> st;
    state_init<2>(st, qkv + (size_t)(b * SEQ + gr * 64 + jq) * NQKV + 512 + 64 * hh + 8 * hi);
    auto tile_src = [&](int t) -> TileSrc {
        if (t < nlat) { const bf16_t* base = qkv + (size_t)(b * SEQ + (kr_lo + t) * 64) * NQKV; return TileSrc{base + 1536 + 64 * hh, base + 2560 + 64 * hh, NQKV}; }
        const bf16_t* base = kvc + (size_t)(b * CTX + (t - nlat) * 64) * NKVC; return TileSrc{base + 512 + 64 * hh, base + 1536 + 64 * hh, NKVC}; };
    Stage<1> sg;
    stage_load<1>(sg, tile_src(0), tid); stage_write<1>(sg, lds, tid);
    __syncthreads();
    for (int t = 0; t < nt; ++t) {
        LAS unsigned char* cur = lds + (t & 1) * RING_BUF;
        if (t + 1 < nt) stage_load<1>(sg, tile_src(t + 1), tid);
        const int kr = kr_lo + t;
        const bool lat = t < nlat;
        const bool active = !lat || (kr >= start && kr < start + 8);
        if (active) {
            f32x16 p0, p1;
#pragma unroll
            for (int r = 0; r < 16; ++r) { p0[r] = 0.f; p1[r] = 0.f; }
            qkt(p0, p1, cur, st.qr, r32, hi);
            if (lat) {
                const int dbase = (kr - gr + 7) * 31 + 15 - jq;
#pragma unroll
                for (int r = 0; r < 16; ++r) {
                    const int jk0 = crow(r, hi), jk1 = jk0 + 32;
                    const bool v0 = (jk0 >= cs) && (jk0 < cs + 16), v1 = (jk1 >= cs) && (jk1 < cs + 16);
                    const float b0 = rpbL[v0 ? dbase + jk0 : 0], b1 = rpbL[v1 ? dbase + jk1 : 0];
                    p0[r] = v0 ? p0[r] + b0 : NEGBIG; p1[r] = v1 ? p1[r] + b1 : NEGBIG;
                }
            }
            softmax_pv<2>(p0, p1, st, cur + 8192 + lanebase, wsf, r32, hi);
        }
        if (t + 1 < nt) stage_write<1>(sg, lds + ((t + 1) & 1) * RING_BUF, tid);
        __syncthreads();
    }
    {   float lt = st.l + __shfl_xor(st.l, 32);
        if (hi == 0) wsf[r32] = 1.0f / lt;
        LAS float* stg = (LAS float*)(lds + OFF_STAGE) + wid * (32 * 68);
#pragma unroll
        for (int r = 0; r < 16; ++r) { const float inv = wsf[crow(r, hi)];
#pragma unroll
            for (int c = 0; c < 2; ++c) stg[crow(r, hi) * 68 + 32 * c + r32] = st.o[c][r] * inv; }
        const int row = lane >> 1, half = lane & 1;
        bf16_t* dst = mix + (size_t)(b * SEQ + gr * 64 + 32 * chh + row) * DM + 512 + 64 * hh + half * 32;
#pragma unroll
        for (int i = 0; i < 4; ++i) { const f32x4 a = *(LAS const f32x4*)(stg + row * 68 + half * 32 + 8 * i), c4 = *(LAS const f32x4*)(stg + row * 68 + half * 32 + 8 * i + 4);
            u32x4 w; w.x = pk2(a.x, a.y); w.y = pk2(a.z, a.w); w.z = pk2(c4.x, c4.y); w.w = pk2(c4.z, c4.w);
            *(u32x4*)(dst + 8 * i) = w; }
        __syncthreads();
    }
}
}
__device__ __forceinline__ void phase_attn(const Params& p, LAS unsigned char* lds) {
    const int G = (int)gridDim.x, bx = (int)blockIdx.x, vcu = (G % 8 == 0) ? (bx % 8) * (G / 8) + bx / 8 : bx;
    const float lam = *(const float*)(p.ws + WS_LAM);
    const int tid = opaque_tid();
    for (int u = vcu; u < 2048; u += G) att::diff_unit(p, lds, tid, u >> 6, (u >> 4) & 3, u & 15, lam);
    for (int u = vcu; u < 2048; u += G) att::na_unit(p, lds, tid, u >> 6, (u >> 3) & 7, u & 7);
}

__device__ __forceinline__ void phase_final(const Params& p, int gw, int NGW, int lane) {
    const float* ssq2 = (const float*)(p.ws + WS_SSQ2);
    for (int row = gw; row < MLAT; row += NGW) {
        const float sv = (lane < 16) ? ssq2[(size_t)row * 16 + lane] : 0.f;
        const float rstd = rsqrtf(wave_sum(sv) * (1.0f / DM) + EPS);
        float* o = p.out + (size_t)row * DM;
#pragma unroll
        for (int j = 0; j < 4; ++j) { const int col = 4 * lane + 256 * j; const f32x4 v = *(const f32x4*)(o + col), g = *(const f32x4*)(p.final_g + col); *(f32x4*)(o + col) = v * rstd * g; }
    }
}

#ifndef PHASE_MASK
#define PHASE_MASK 255
#endif
typedef const Params __attribute__((address_space(4))) CParams;
__device__ __forceinline__ Params kparams() {
#if defined(__HIP_DEVICE_COMPILE__)
    CParams* k = (CParams*)__builtin_amdgcn_kernarg_segment_ptr(); asm volatile("" : "+s"(k)); return *k;
#else
    return Params{};
#endif
}
#define PH_IDS const int tid_ = opaque_tid(), wid = tid_ >> 6, lane = tid_ & 63, gw = blockIdx.x * 8 + wid, NGW = gridDim.x * 8
__global__ __launch_bounds__(512, 2) void k_mega(Params p_unused) {
    extern __shared__ __attribute__((aligned(16))) unsigned char lds[];
    cg::grid_group grid = cg::this_grid();
    if (PHASE_MASK & 1) { const Params p = kparams(); PH_IDS; phase_prep_a(p, (float*)lds + wid * 2112, gw, NGW, lane); }
    grid.sync();
    if (PHASE_MASK & 2) { const Params p = kparams(); PH_IDS; phase_prep_b(p, (float*)lds + wid * 2112, gw, NGW, lane); }
    grid.sync();
    if (PHASE_MASK & 4) { const Params p = kparams(); phase_qkv(p, (LAS unsigned char*)lds); }
    grid.sync();
    if (PHASE_MASK & 8) { const Params p = kparams(); phase_attn(p, (LAS unsigned char*)lds); }
    grid.sync();
    if (PHASE_MASK & 16) { const Params p = kparams(); phase_outproj(p, (LAS unsigned char*)lds); }
    grid.sync();
    if (PHASE_MASK & 32) { const Params p = kparams(); phase_fc1(p, (LAS unsigned char*)lds); }
    grid.sync();
    if (PHASE_MASK & 64) { const Params p = kparams(); phase_fc2(p, (LAS unsigned char*)lds); }
    grid.sync();
    if (PHASE_MASK & 128) { const Params p = kparams(); PH_IDS; phase_final(p, gw, NGW, lane); }
}

extern "C" void kernel_launch(void* const* d_in, const int* in_sizes, int n_in, void* d_out, int out_size, void* d_ws, size_t ws_size, hipStream_t stream) {
    if (n_in != 19 || in_sizes[0] != MLAT * DM || out_size != MLAT * DM || ws_size < WS_END) {
        fprintf(stderr, "kernel_launch: unexpected shapes: n_in %d in0 %d out %d ws %zu (need %zu)\n", n_in, n_in > 0 ? in_sizes[0] : -1, out_size, ws_size, (size_t)WS_END);
        return;
    }
    Params p{};
    const float** pf = (const float**)&p;
    for (int i = 0; i < 19; ++i) pf[i] = (const float*)d_in[i];
    p.out = (float*)d_out; p.ws = (unsigned char*)d_ws;
    unsigned char* ws = p.ws;
    static int grid_blocks = 0;
    if (grid_blocks == 0) {
        int dev = 0, cus = 0, per_cu = 0;
        (void)hipGetDevice(&dev);
        (void)hipDeviceGetAttribute(&cus, hipDeviceAttributeMultiprocessorCount, dev);
        (void)hipFuncSetAttribute((const void*)k_mega, hipFuncAttributeMaxDynamicSharedMemorySize, LDS_BYTES);
        (void)hipOccupancyMaxActiveBlocksPerMultiprocessor(&per_cu, (const void*)k_mega, 512, LDS_BYTES);
        if (per_cu < 1) { fprintf(stderr, "kernel_launch: occupancy query reports %d blocks per CU\n", per_cu); per_cu = 1; }
        grid_blocks = cus;
        (void)hipGetLastError();
    }
    (void)hipMemsetAsync(ws, 0, WS_ZERO_BYTES, stream);
    void* args[] = {&p};
    hipError_t e = hipLaunchCooperativeKernel((const void*)k_mega, dim3(grid_blocks), dim3(512), args, LDS_BYTES, stream);
    if (e != hipSuccess) fprintf(stderr, "kernel_launch: cooperative launch failed: %s (grid %d)\n", hipGetErrorString(e), grid_blocks);
}
```

```cpp
#include <hip/hip_runtime.h>
#include <hip/hip_cooperative_groups.h>
#include <cstdio>
#include <cstdint>

namespace cg = cooperative_groups;
typedef unsigned short bf16_t;
typedef float f32x4 __attribute__((ext_vector_type(4)));
typedef float f32x2 __attribute__((ext_vector_type(2)));
typedef unsigned u32x4 __attribute__((ext_vector_type(4)));
typedef unsigned u32x2 __attribute__((ext_vector_type(2)));
typedef __bf16 bf16x2_t __attribute__((ext_vector_type(2)));

constexpr int NB = 32, SEQ = 2048, DM = 1024, CTX = 256, FF = 4096, NQKV = 3072, NKVC = 2048;
constexpr int MLAT = NB * SEQ, MCTX = NB * CTX, MALL = MLAT + MCTX;
constexpr int MODN = 6 * DM;
constexpr float EPS = 1e-6f;
constexpr float LOG2E = 1.4426950408889634f;
constexpr float C2 = 0.125f * LOG2E;
constexpr float LAM_INIT = 0.2f;
constexpr float NEGBIG = -1e30f;

constexpr size_t MiB = 1u << 20;
constexpr size_t WS_CTL = 0;
constexpr size_t WS_MOD = 1 * MiB;
constexpr size_t WS_BIAS1 = 2 * MiB;
constexpr size_t WS_ROPE = 3 * MiB;
constexpr size_t WS_LAM = 3 * MiB + 65536;
constexpr size_t WS_ZERO_BYTES = 3 * MiB;
constexpr size_t WS_SSQ1 = 4 * MiB;
constexpr size_t WS_SSQ2 = 8 * MiB;
constexpr size_t WS_RSTD1 = 3 * MiB + 131072;
constexpr size_t WS_WIN = 12 * MiB;
constexpr size_t WS_WOUT = 18 * MiB;
constexpr size_t WS_W1 = 20 * MiB;
constexpr size_t WS_W2 = 28 * MiB;
constexpr size_t WS_KVC = 36 * MiB;
constexpr size_t WS_A2 = 84 * MiB;
constexpr size_t WS_MIX = 212 * MiB;
constexpr size_t WS_A1 = 340 * MiB;
constexpr size_t WS_QKV = 484 * MiB;
constexpr size_t WS_HID = 340 * MiB;
constexpr size_t WS_END = 868 * MiB;

struct Params {
    const float *x, *c, *ctx, *c_ctx, *w_mod, *b_mod, *norm1_g, *w_in, *lam_q1, *lam_k1, *lam_q2, *lam_k2, *subln_g, *rpb, *w_out, *norm2_g, *w_fc1, *w_fc2, *final_g;
    float* out; unsigned char* ws;
};

__device__ __forceinline__ unsigned pk2(float lo, float hi) { f32x2 v = {lo, hi}; bf16x2_t b = __builtin_convertvector(v, bf16x2_t); return __builtin_bit_cast(unsigned, b); }
__device__ __forceinline__ float bf_lo(unsigned w) { return __uint_as_float(w << 16); }
__device__ __forceinline__ float bf_hi(unsigned w) { return __uint_as_float(w & 0xffff0000u); }
__device__ __forceinline__ float bf2f(bf16_t v) { return __uint_as_float(((unsigned)v) << 16); }
__device__ __forceinline__ float wave_sum(float v) {
#pragma unroll
    for (int o = 1; o < 64; o <<= 1) v += __shfl_xor(v, o);
    return v;
}
__device__ __forceinline__ float wave_max(float v) {
#pragma unroll
    for (int o = 1; o < 64; o <<= 1) v = fmaxf(v, __shfl_xor(v, o));
    return v;
}
__host__ __device__ __forceinline__ int win_src_col(int n) {
    const bool perm = (n < 512) || (n >= 1024 && n < 1536);
    if (!perm) return n;
    const int nd = n & 63, base = n - nd, i = nd >> 1, par = nd & 1;
    const int old = (i < 16 ? i : 32 + (i - 16)) + 16 * par;
    return base + old;
}

template <bool PERMW>
__device__ __forceinline__ void transpose_item(const float* __restrict__ W, int K, int N, bf16_t* __restrict__ WT, float* scr, int item, int lane) {
    const int nblk = N / 32, kb = item / nblk, nb = item % nblk, k0 = 64 * kb, n0 = 32 * nb;
    const int nsrc = PERMW ? win_src_col(n0 + (lane & 31)) : (n0 + (lane & 31));
#pragma unroll 8
    for (int i = 0; i < 32; ++i) { const int kk = 2 * i + (lane >> 5); scr[kk * 33 + (lane & 31)] = W[(size_t)(k0 + kk) * N + nsrc]; }
    __builtin_amdgcn_s_waitcnt(0xC07F); asm volatile("" ::: "memory");
    const int c = lane & 7;
#pragma unroll
    for (int j = 0; j < 4; ++j) { const int n = (lane >> 3) + 8 * j; const float* s = scr + (8 * c) * 33 + n;
        u32x4 o; o.x = pk2(s[0 * 33], s[1 * 33]); o.y = pk2(s[2 * 33], s[3 * 33]); o.z = pk2(s[4 * 33], s[5 * 33]); o.w = pk2(s[6 * 33], s[7 * 33]);
        *(u32x4*)(WT + (size_t)(n0 + n) * K + k0 + 8 * c) = o; }
    __builtin_amdgcn_s_waitcnt(0xC07F); asm volatile("" ::: "memory");
}
template <int NR, bool SILU>
__device__ __forceinline__ void small_mm_task(const float* __restrict__ src, size_t src_stride, const float* __restrict__ last_row, const float* __restrict__ W, int N,
                                              int k0, int n0, float* out, size_t out_stride, const float* __restrict__ bias, float* scr, int lane) {
#pragma unroll
    for (int r = 0; r < NR; ++r) {
        const float* sr = (last_row && r == NR - 1) ? last_row : src + (size_t)r * src_stride;
        float v = sr[k0 + lane];
        if (SILU) v = v / (1.0f + __expf(-v));
        scr[r * 64 + lane] = v;
    }
    __builtin_amdgcn_s_waitcnt(0xC07F); asm volatile("" ::: "memory");
    float acc[NR];
#pragma unroll
    for (int r = 0; r < NR; ++r) acc[r] = 0.f;
#pragma unroll 1
    for (int kk = 0; kk < 64; kk += 4) {
        const float w0 = W[(size_t)(k0 + kk + 0) * N + n0 + lane], w1 = W[(size_t)(k0 + kk + 1) * N + n0 + lane];
        const float w2 = W[(size_t)(k0 + kk + 2) * N + n0 + lane], w3 = W[(size_t)(k0 + kk + 3) * N + n0 + lane];
#pragma unroll
        for (int r = 0; r < NR; ++r) { const f32x4 s = *(const f32x4*)(scr + r * 64 + kk); acc[r] += s.x * w0 + s.y * w1 + s.z * w2 + s.w * w3; }
    }
    const float bv = (bias && k0 == 0) ? bias[n0 + lane] : 0.f;
#pragma unroll
    for (int r = 0; r < NR; ++r) atomicAdd(out + (size_t)r * out_stride + n0 + lane, acc[r] + bv);
    __builtin_amdgcn_s_waitcnt(0xC07F); asm volatile("" ::: "memory");
}

__device__ __forceinline__ void phase_prep_a(const Params& p, float* scr  , int gw, int NGW, int lane) {
    unsigned char* ws = p.ws;
    constexpr int T_MOD = (MODN / 64) * (DM / 64);
    constexpr int I_IN = (DM / 64) * (NQKV / 32), I_OUT = (DM / 64) * (DM / 32), I_1 = (DM / 64) * (FF / 32), I_2 = (FF / 64) * (DM / 32);
    constexpr int T_ALL = T_MOD + I_IN + I_OUT + I_1 + I_2 + 17;
    for (int t = gw; t < T_ALL; t += NGW) {
        int r = t;
        if (r < T_MOD) { const int nb = r % (MODN / 64), kc = r / (MODN / 64);
            small_mm_task<33, true>(p.c, DM, p.c_ctx, p.w_mod, MODN, kc * 64, nb * 64, (float*)(ws + WS_MOD), MODN, p.b_mod, scr, lane); continue; }
        r -= T_MOD;
        if (r < I_IN) { transpose_item<true>(p.w_in, DM, NQKV, (bf16_t*)(ws + WS_WIN), scr, r, lane); continue; } r -= I_IN;
        if (r < I_OUT) { transpose_item<false>(p.w_out, DM, DM, (bf16_t*)(ws + WS_WOUT), scr, r, lane); continue; } r -= I_OUT;
        if (r < I_1) { transpose_item<false>(p.w_fc1, DM, FF, (bf16_t*)(ws + WS_W1), scr, r, lane); continue; } r -= I_1;
        if (r < I_2) { transpose_item<false>(p.w_fc2, FF, DM, (bf16_t*)(ws + WS_W2), scr, r, lane); continue; } r -= I_2;
        if (r < 16) {
            const int pos = 4 * r + (lane >> 4), f = lane & 15;
            const float inv = powf(10000.0f, -(float)f / 16.0f);
            const float ang = (float)pos * inv;
            float* T = (float*)(ws + WS_ROPE) + (pos * 16 + f) * 2;
            T[0] = cosf(ang); T[1] = sinf(ang);
        } else {
            const float a = wave_sum(p.lam_q1[lane] * p.lam_k1[lane]), b = wave_sum(p.lam_q2[lane] * p.lam_k2[lane]);
            if (lane == 0) *(float*)(ws + WS_LAM) = expf(a) - expf(b) + LAM_INIT;
        }
    }
}
__device__ __forceinline__ void phase_prep_b(const Params& p, float* scr, int gw, int NGW, int lane) {
    unsigned char* ws = p.ws;
    const float* mod = (const float*)(ws + WS_MOD);
    constexpr int T_B1 = (FF / 64) * (DM / 64);
    for (int t = gw; t < T_B1; t += NGW) { const int nb = t % (FF / 64), kc = t / (FF / 64);
        small_mm_task<32, false>(mod + 3 * DM, MODN, nullptr, p.w_fc1, FF, kc * 64, nb * 64, (float*)(ws + WS_BIAS1), FF, nullptr, scr, lane); }
    bf16_t* A1 = (bf16_t*)(ws + WS_A1);
    for (int row = gw; row < MALL; row += NGW) {
        const float* xr; const float* mrow;
        if (row < MLAT) { xr = p.x + (size_t)row * DM; mrow = mod + (size_t)(row >> 11) * MODN; }
        else { xr = p.ctx + (size_t)(row - MLAT) * DM; mrow = mod + (size_t)32 * MODN; }
        f32x4 v[4]; float ss = 0.f;
#pragma unroll
        for (int j = 0; j < 4; ++j) { v[j] = *((const f32x4*)xr + lane + 64 * j); ss += (v[j].x * v[j].x + v[j].y * v[j].y) + (v[j].z * v[j].z + v[j].w * v[j].w); }
        const float rstd = rsqrtf(wave_sum(ss) * (1.0f / DM) + EPS);
#pragma unroll
        for (int j = 0; j < 4; ++j) {
            const int col = 4 * lane + 256 * j;
            const f32x4 g = *(const f32x4*)(p.norm1_g + col), sh = *(const f32x4*)(mrow + col), sc = *(const f32x4*)(mrow + DM + col);
            const f32x4 h = (v[j] * rstd) * g * (sc + 1.0f) + sh;
            u32x2 o; o.x = pk2(h.x, h.y); o.y = pk2(h.z, h.w);
            *(u32x2*)(A1 + (size_t)row * DM + col) = o;
        }
    }
}
#define LAS __attribute__((address_space(3)))
constexpr int LDS_SPARE = 131072;
struct E_QKV {
    static constexpr bool SSQ = false; static constexpr int PB = 4;
    bf16_t* qkv; bf16_t* kvc; LAS const float* rope;
    struct Col {};
    struct Pre { f32x4 t0, t1; };
    template <class U> __device__ __forceinline__ float rowval(const U&, int) const { return 0.f; }
    template <class U> __device__ __forceinline__ Col col_prep(const U&, int, int) const { return Col{}; }
    __device__ __forceinline__ static bool rope_cols(int col0) { return (col0 < 512) || (col0 >= 1024 && col0 < 1536); }
    __device__ __forceinline__ Pre preload(int row, int col0) const {
        Pre pr; pr.t0 = (f32x4){1.f, 0.f, 1.f, 0.f}; pr.t1 = pr.t0;
        if (row < MLAT && rope_cols(col0)) {
            const int s = row & (SEQ - 1), gr = s >> 6, gc = s & 63;
            const int i0 = (col0 & 63) >> 1, pos = (i0 >= 16) ? gc : gr, f0 = i0 & 15;
            LAS const f32x4* T = (LAS const f32x4*)(rope + (pos * 16 + f0) * 2);
            pr.t0 = T[0]; pr.t1 = T[1];
        }
        return pr;
    }
    __device__ __forceinline__ float epi8(int row, int col0, const Col&, const float (&a)[8], float, const Pre& pr) const {
        float v[8];
#pragma unroll
        for (int j = 0; j < 8; ++j) v[j] = a[j];
        if (row < MLAT) {
            if (rope_cols(col0)) {
                const float cs[4] = {pr.t0.x, pr.t0.z, pr.t1.x, pr.t1.z}, sn[4] = {pr.t0.y, pr.t0.w, pr.t1.y, pr.t1.w};
#pragma unroll
                for (int q = 0; q < 4; ++q) { const float x1 = v[2 * q], x2 = v[2 * q + 1]; v[2 * q] = x1 * cs[q] - x2 * sn[q]; v[2 * q + 1] = x1 * sn[q] + x2 * cs[q]; }
            }
            if (col0 < 1024) {
#pragma unroll
                for (int j = 0; j < 8; ++j) v[j] *= C2;
            }
            u32x4 o; o.x = pk2(v[0], v[1]); o.y = pk2(v[2], v[3]); o.z = pk2(v[4], v[5]); o.w = pk2(v[6], v[7]);
            *(u32x4*)(qkv + (size_t)row * NQKV + col0) = o;
        } else if (col0 >= 1024) {
            u32x4 o; o.x = pk2(v[0], v[1]); o.y = pk2(v[2], v[3]); o.z = pk2(v[4], v[5]); o.w = pk2(v[6], v[7]);
            *(u32x4*)(kvc + (size_t)(row - MLAT) * NKVC + (col0 - 1024)) = o;
        }
        return 0.f;
    }
};
struct E_OUT {
    static constexpr bool SSQ = true; static constexpr int PB = 2;
    const float* x; float* x1; bf16_t* a2; const float* mod; const float* g2;
    struct Col { f32x4 ga0, ga1, gm0, gm1; };
    struct Pre { f32x4 x0, x4; };
    template <class U> __device__ __forceinline__ float rowval(const U&, int) const { return 0.f; }
    template <class U> __device__ __forceinline__ Col col_prep(const U&, int b, int col0) const {
        Col c; const float* m = mod + (size_t)b * MODN + col0;
        c.ga0 = *(const f32x4*)(m + 2 * DM); c.ga1 = *(const f32x4*)(m + 2 * DM + 4);
        c.gm0 = *(const f32x4*)(g2 + col0) * (*(const f32x4*)(m + 4 * DM) + 1.0f); c.gm1 = *(const f32x4*)(g2 + col0 + 4) * (*(const f32x4*)(m + 4 * DM + 4) + 1.0f);
        return c;
    }
    __device__ __forceinline__ Pre preload(int row, int col0) const { const size_t off = (size_t)row * DM + col0; Pre pr; pr.x0 = *(const f32x4*)(x + off); pr.x4 = *(const f32x4*)(x + off + 4); return pr; }
    __device__ __forceinline__ float epi8(int row, int col0, const Col& c, const float (&a)[8], float, const Pre& pr) const {
        const size_t off = (size_t)row * DM + col0;
        const f32x4 v0 = pr.x0 + c.ga0 * (f32x4){a[0], a[1], a[2], a[3]}, v1 = pr.x4 + c.ga1 * (f32x4){a[4], a[5], a[6], a[7]};
        *(f32x4*)(x1 + off) = v0; *(f32x4*)(x1 + off + 4) = v1;
        const f32x4 h0 = v0 * c.gm0, h1 = v1 * c.gm1;
        u32x4 o; o.x = pk2(h0.x, h0.y); o.y = pk2(h0.z, h0.w); o.z = pk2(h1.x, h1.y); o.w = pk2(h1.z, h1.w);
        *(u32x4*)(a2 + off) = o;
        const f32x4 q = v0 * v0 + v1 * v1;
        return (q.x + q.y) + (q.z + q.w);
    }
};
struct E_FC1 {
    static constexpr bool SSQ = false; static constexpr int PB = 4;
    LAS const float* tab; bf16_t* hid;
    struct Col { f32x4 b0, b1; };
    struct Pre {};
    __device__ __forceinline__ Pre preload(int, int) const { return Pre{}; }
    template <class U> __device__ __forceinline__ float rowval(const U& u, int row) const { return tab[u.aux * 512 + (row - u.pm * 256)]; }
    template <class U> __device__ __forceinline__ Col col_prep(const U& u, int, int col0) const { Col c; LAS const f32x4* t = (LAS const f32x4*)(tab + u.aux * 512 + 256 + (col0 - u.pn * 256)); c.b0 = t[0]; c.b1 = t[1]; return c; }
    __device__ __forceinline__ float epi8(int row, int col0, const Col& c, const float (&a)[8], float rv, const Pre&) const {
        const float bs[8] = {c.b0.x, c.b0.y, c.b0.z, c.b0.w, c.b1.x, c.b1.y, c.b1.z, c.b1.w};
        float v[8];
#pragma unroll
        for (int j = 0; j < 8; ++j) { const float z = fmaxf(rv * a[j] + bs[j], 0.f); v[j] = z * z; }
        u32x4 o; o.x = pk2(v[0], v[1]); o.y = pk2(v[2], v[3]); o.z = pk2(v[4], v[5]); o.w = pk2(v[6], v[7]);
        *(u32x4*)(hid + (size_t)row * FF + col0) = o;
        return 0.f;
    }
};
struct E_FC2 {
    static constexpr bool SSQ = true; static constexpr int PB = 4;
    float* xio; const float* mod;
    struct Col { f32x4 gm0, gm1; };
    struct Pre { f32x4 x0, x4; };
    template <class U> __device__ __forceinline__ float rowval(const U&, int) const { return 0.f; }
    template <class U> __device__ __forceinline__ Col col_prep(const U&, int b, int col0) const { Col c; const float* m = mod + (size_t)b * MODN + 5 * DM + col0; c.gm0 = *(const f32x4*)m; c.gm1 = *(const f32x4*)(m + 4); return c; }
    __device__ __forceinline__ Pre preload(int row, int col0) const { const size_t off = (size_t)row * DM + col0; Pre pr; pr.x0 = *(const f32x4*)(xio + off); pr.x4 = *(const f32x4*)(xio + off + 4); return pr; }
    __device__ __forceinline__ float epi8(int row, int col0, const Col& c, const float (&a)[8], float, const Pre& pr) const {
        const size_t off = (size_t)row * DM + col0;
        const f32x4 v0 = pr.x0 + c.gm0 * (f32x4){a[0], a[1], a[2], a[3]}, v1 = pr.x4 + c.gm1 * (f32x4){a[4], a[5], a[6], a[7]};
        *(f32x4*)(xio + off) = v0; *(f32x4*)(xio + off + 4) = v1;
        const f32x4 q = v0 * v0 + v1 * v1;
        return (q.x + q.y) + (q.z + q.w);
    }
};

__device__ __forceinline__ int opaque_tid() { int t = threadIdx.x; asm volatile("" : "+v"(t)); return t; }
namespace pg8 {
#define PG8_LAS __attribute__((address_space(3)))
typedef unsigned short bf16_t;
typedef short bf16x8 __attribute__((ext_vector_type(8)));
typedef float f32x4 __attribute__((ext_vector_type(4)));
typedef unsigned u32x4 __attribute__((ext_vector_type(4)));
constexpr int BM = 256, BK = 64, HALF = 128, HTB = HALF * BK * 2  , STAGE_BYTES = 8 * HTB, NXCD = 8, WGM = 8;

__host__ __device__ __forceinline__ int lds_byte(int r, int c) { const int st = (r >> 4) * 2 + (c >> 5), rr = r & 15, cc = c & 31, ob = rr * 64 + cc * 2; return st * 1024 + (ob ^ (((ob >> 9) & 1) << 5)); }
__host__ __device__ __forceinline__ void stage_rc(int b, int& R, int& C) { const int st = b / 1024, sb = b % 1024, swz = sb ^ (((sb >> 9) & 1) << 5); R = (st >> 1) * 16 + swz / 64; C = (st & 1) * 32 + (swz % 64) / 2; }
__host__ __device__ __forceinline__ int perm32(int rho) { const int n = rho >> 4, i = rho & 15; return 8 * (i >> 2) + 4 * n + (i & 3); }

struct Unit { int pm, pn, aux; };
struct Gemm { const bf16_t* A; const bf16_t* Bt; int M, N, K; };

struct StaticOrder {
    int nM, nN, nwg, G, c;
    __host__ __device__ void init(int M, int N, int G_, int c_) { nM = M / BM; nN = N / BM; nwg = nM * nN; G = G_; c = c_; }
    __host__ __device__ bool next(int i, Unit& u) const {
        const long L = (long)i * G + c; if (L >= nwg) return false;
        int wgid = (int)L; { const int q = nwg / NXCD, r = nwg % NXCD, xcd = wgid % NXCD, off = wgid / NXCD; wgid = (xcd < r ? xcd * (q + 1) : r * (q + 1) + (xcd - r) * q) + off; }
        const int nig = WGM * nN, gid = wgid / nig, fm = gid * WGM, gsz = (nM - fm) < WGM ? (nM - fm) : WGM;
        u.pm = fm + ((wgid % nig) % gsz); u.pn = (wgid % nig) / gsz; return true;
    }
    __device__ __forceinline__ void a_ready(const Unit&) const {}
    __device__ __forceinline__ void done(const Unit&) const {}
};


template <class Epi, class Sched, bool ALIGN_EPI = false, bool SP2 = false>
__device__ __forceinline__ void gemm_phase(PG8_LAS unsigned char* lds, const Gemm g, const Sched& S, const Epi& E) {
    const int tid = opaque_tid(), wid = __builtin_amdgcn_readfirstlane(tid >> 6), lane = tid & 63, wr = wid >> 2, wc = wid & 3, fr = lane & 15, fq = lane >> 4;
    const int K = g.K, nt = K / BK;
    unsigned voffA[2], voffB[2];
#pragma unroll
    for (int i = 0; i < 2; ++i) { int R, C; stage_rc(tid * 16 + i * 8192, R, C); const int Rb = Epi::PERM ? ((R & ~31) + perm32(R & 31)) : R;
        voffA[i] = (unsigned)(R * K + C) * 2u; voffB[i] = (unsigned)(Rb * K + C) * 2u; }
    const size_t kstep = (size_t)(BK * 2);
    const size_t hstep = (size_t)HALF * K * 2;
    const size_t tstep = 2 * hstep;
    const unsigned ldsw = (unsigned)wid * 1024u;
    const int aoff = lds_byte(wr * 64 + fr, fq * 8), boff = lds_byte(wc * 32 + fr, fq * 8);
#define PG8_SA(b, h) (((b) * 2 + (h)) * HTB)
#define PG8_SB(b, h) ((4 + (b) * 2 + (h)) * HTB)
#define PG8_STAGE(bufoff, gbase, voff) do { _Pragma("unroll") for (int _i = 0; _i < 2; ++_i) \
        __builtin_amdgcn_global_load_lds((const unsigned*)((const char*)(gbase) + (voff)[_i]), (PG8_LAS unsigned*)(lds + (bufoff) + ldsw + _i * 8192), 16, 0, 0); } while (0)
#define PG8_LDA(dst, b, h) do { _Pragma("unroll") for (int m = 0; m < 4; ++m) _Pragma("unroll") for (int k = 0; k < 2; ++k) dst[m][k] = *(const PG8_LAS bf16x8*)(lds + PG8_SA(b, h) + aoff + m * 2048 + k * 1024); } while (0)
#define PG8_LDB(dst, b, h) do { _Pragma("unroll") for (int n = 0; n < 2; ++n) _Pragma("unroll") for (int k = 0; k < 2; ++k) dst[n][k] = *(const PG8_LAS bf16x8*)(lds + PG8_SB(b, h) + boff + n * 2048 + k * 1024); } while (0)
#define PG8_MMA(ai, bj, At, Bt) do { __builtin_amdgcn_s_setprio(1); _Pragma("unroll") for (int m = 0; m < 4; ++m) _Pragma("unroll") for (int n = 0; n < 2; ++n) _Pragma("unroll") for (int k = 0; k < 2; ++k) \
        acc[ai][bj][m][n] = __builtin_amdgcn_mfma_f32_16x16x32_bf16(Bt[n][k], At[m][k], acc[ai][bj][m][n], 0, 0, 0); __builtin_amdgcn_s_setprio(0); } while (0)
#define PG8_WAIT_V(n) asm volatile("s_waitcnt vmcnt(" #n ")" ::: "memory")
#define PG8_WAIT_L(n) asm volatile("s_waitcnt lgkmcnt(" #n ")" ::: "memory")
#define PG8_BAR __builtin_amdgcn_s_barrier()
#define PG8_SCHED __builtin_amdgcn_sched_barrier(0)
    Unit cur, nxt; int ui = 0;
    if (!S.next(0, cur)) return;
    f32x4 acc[2][2][4][2];
#pragma unroll
    for (int a = 0; a < 2; ++a)
#pragma unroll
        for (int b = 0; b < 2; ++b)
#pragma unroll
            for (int m = 0; m < 4; ++m)
#pragma unroll
                for (int n = 0; n < 2; ++n) acc[a][b][m][n] = (f32x4){0.f, 0.f, 0.f, 0.f};
    bf16x8 At[4][2], B0[2][2], B1[2][2];
    const char* cA = (const char*)g.A + (size_t)cur.pm * tstep; const char* cB = (const char*)g.Bt + (size_t)cur.pn * tstep;
    S.a_ready(cur);
    if constexpr (SP2) {
        PG8_STAGE(PG8_SB(0, 0), cB, voffB); PG8_STAGE(PG8_SB(0, 1), cB + hstep, voffB); PG8_STAGE(PG8_SA(0, 0), cA, voffA); PG8_STAGE(PG8_SA(0, 1), cA + hstep, voffA);
        if (wr == 1) PG8_BAR;
        PG8_WAIT_V(2); PG8_BAR;
        PG8_STAGE(PG8_SB(1, 0), cB + kstep, voffB); PG8_STAGE(PG8_SA(1, 0), cA + kstep, voffA); PG8_STAGE(PG8_SB(1, 1), cB + hstep + kstep, voffB);
        PG8_WAIT_V(6); PG8_BAR;
    } else {
        PG8_STAGE(PG8_SB(0, 0), cB, voffB); PG8_STAGE(PG8_SA(0, 0), cA, voffA); PG8_STAGE(PG8_SB(0, 1), cB + hstep, voffB); PG8_STAGE(PG8_SA(0, 1), cA + hstep, voffA);
        if (wr == 1) PG8_BAR;
        PG8_WAIT_V(4); PG8_BAR;
        PG8_STAGE(PG8_SB(1, 0), cB + kstep, voffB); PG8_STAGE(PG8_SA(1, 0), cA + kstep, voffA); PG8_STAGE(PG8_SB(1, 1), cB + hstep + kstep, voffB);
        PG8_WAIT_V(6); PG8_BAR;
    }
    for (;;) {
        const bool has_next = S.next(ui + 1, nxt);
        const char* nA = has_next ? (const char*)g.A + (size_t)nxt.pm * tstep : cA; const char* nB = has_next ? (const char*)g.Bt + (size_t)nxt.pn * tstep : cB;
        for (int t = 0; t < nt; t += 2) {
            const bool last = (t == nt - 2);
            const char* a1 = cA + (size_t)(t + 1) * kstep;
            const char* a2 = last ? nA : cA + (size_t)(t + 2) * kstep; const char* b2 = last ? nB : cB + (size_t)(t + 2) * kstep;
            const char* a3 = a2 + kstep; const char* b3 = b2 + kstep;
            if (last && has_next) S.a_ready(nxt);
            if constexpr (SP2) {
            PG8_LDB(B0, 0, 0); PG8_LDB(B1, 0, 1); PG8_SCHED; PG8_LDA(At, 0, 0); PG8_STAGE(PG8_SA(1, 1), a1 + hstep, voffA);
            PG8_WAIT_V(8); PG8_WAIT_L(0); PG8_BAR; PG8_MMA(0, 0, At, B0); PG8_MMA(0, 1, At, B1); PG8_BAR; PG8_SCHED;
            PG8_LDA(At, 0, 1); PG8_STAGE(PG8_SB(0, 0), b2, voffB); PG8_STAGE(PG8_SB(0, 1), b2 + hstep, voffB); PG8_STAGE(PG8_SA(0, 0), a2, voffA);
            PG8_WAIT_V(8); PG8_WAIT_L(0); PG8_BAR; PG8_MMA(1, 0, At, B0); PG8_MMA(1, 1, At, B1); PG8_BAR; PG8_SCHED;
            PG8_LDB(B0, 1, 0); PG8_LDB(B1, 1, 1); PG8_SCHED; PG8_LDA(At, 1, 0); PG8_STAGE(PG8_SA(0, 1), a2 + hstep, voffA);
            PG8_WAIT_V(8); PG8_WAIT_L(0); PG8_BAR; PG8_MMA(0, 0, At, B0); PG8_MMA(0, 1, At, B1); PG8_BAR; PG8_SCHED;
            PG8_LDA(At, 1, 1); PG8_STAGE(PG8_SB(1, 0), b3, voffB); PG8_STAGE(PG8_SB(1, 1), b3 + hstep, voffB); PG8_STAGE(PG8_SA(1, 0), a3, voffA);
            PG8_WAIT_V(8); PG8_WAIT_L(0); PG8_BAR; PG8_MMA(1, 0, At, B0); PG8_MMA(1, 1, At, B1); PG8_BAR; PG8_SCHED;
            } else {
            PG8_LDB(B0, 0, 0); PG8_SCHED; PG8_LDA(At, 0, 0); PG8_STAGE(PG8_SA(1, 1), a1 + hstep, voffA);
            PG8_WAIT_L(8); PG8_BAR; PG8_WAIT_L(0); PG8_MMA(0, 0, At, B0); PG8_BAR; PG8_SCHED;
            PG8_LDB(B1, 0, 1); PG8_STAGE(PG8_SB(0, 0), b2, voffB);
            PG8_BAR; PG8_WAIT_L(0); PG8_MMA(0, 1, At, B1); PG8_BAR;
            PG8_LDA(At, 0, 1); PG8_STAGE(PG8_SA(0, 0), a2, voffA);
            PG8_BAR; PG8_WAIT_L(0); PG8_MMA(1, 0, At, B0); PG8_BAR; PG8_SCHED;
            PG8_STAGE(PG8_SB(0, 1), b2 + hstep, voffB);
            PG8_WAIT_V(6); PG8_BAR; PG8_MMA(1, 1, At, B1); PG8_BAR;
            PG8_LDB(B0, 1, 0); PG8_SCHED; PG8_LDA(At, 1, 0); PG8_STAGE(PG8_SA(0, 1), a2 + hstep, voffA);
            PG8_WAIT_L(8); PG8_BAR; PG8_WAIT_L(0); PG8_MMA(0, 0, At, B0); PG8_BAR; PG8_SCHED;
            PG8_LDB(B1, 1, 1); PG8_STAGE(PG8_SB(1, 0), b3, voffB);
            PG8_BAR; PG8_WAIT_L(0); PG8_MMA(0, 1, At, B1); PG8_BAR;
            PG8_LDA(At, 1, 1); PG8_STAGE(PG8_SA(1, 0), a3, voffA);
            PG8_BAR; PG8_WAIT_L(0); PG8_MMA(1, 0, At, B0); PG8_BAR; PG8_SCHED;
            PG8_STAGE(PG8_SB(1, 1), b3 + hstep, voffB);
            PG8_WAIT_V(6); PG8_BAR; PG8_MMA(1, 1, At, B1); PG8_BAR;
            }
        }
        if constexpr (ALIGN_EPI) { if (wr == 0) PG8_BAR; }
        if constexpr (!Epi::AFTER_DRAIN) { E(acc, cur, wr, wc, fr, fq); S.done(cur); }
        if (!has_next) break;
#pragma unroll
        for (int a = 0; a < 2; ++a)
#pragma unroll
            for (int b = 0; b < 2; ++b)
#pragma unroll
                for (int m = 0; m < 4; ++m)
#pragma unroll
                    for (int n = 0; n < 2; ++n) acc[a][b][m][n] = (f32x4){0.f, 0.f, 0.f, 0.f};
        cur = nxt; cA = nA; cB = nB; ++ui;
        if constexpr (ALIGN_EPI) { if (wr == 1) PG8_BAR; }
    }
    PG8_WAIT_V(0);
    if constexpr (!ALIGN_EPI) { if (wr == 0) PG8_BAR; }
    PG8_BAR;
    if constexpr (Epi::AFTER_DRAIN) { E.fused(acc, cur, wr, wc, fr, fq, lds, wid, lane); S.done(cur); }
#undef PG8_SA
#undef PG8_SB
#undef PG8_STAGE
#undef PG8_LDA
#undef PG8_LDB
#undef PG8_MMA
#undef PG8_WAIT_V
#undef PG8_WAIT_L
#undef PG8_BAR
#undef PG8_SCHED
}
}


template <class E8> struct EpiWrap {
    static constexpr bool PERM = true, AFTER_DRAIN = false;
    E8 e; float* ssq;
    __device__ __forceinline__ void operator()(const pg8::f32x4 (&acc)[2][2][4][2], const pg8::Unit& u, int wr, int wc, int fr, int fq) const {
        const int rowb = u.pm * 256 + wr * 64 + fr;
        const int b = (u.pm < 256) ? (u.pm >> 3) : 0;
        float rv[2][4], ss[2][4];
#pragma unroll
        for (int ai = 0; ai < 2; ++ai)
#pragma unroll
            for (int m = 0; m < 4; ++m) { rv[ai][m] = e.rowval(u, rowb + ai * 128 + m * 16); ss[ai][m] = 0.f; }
#pragma unroll
        for (int bj = 0; bj < 2; ++bj) {
            const int col0 = u.pn * 256 + bj * 128 + wc * 32 + 8 * fq;
            const typename E8::Col cc = e.col_prep(u, b, col0);
#pragma unroll
            for (int ai = 0; ai < 2; ++ai)
#pragma unroll
                for (int mb = 0; mb < 4; mb += E8::PB) {
                    typename E8::Pre pre[E8::PB];
#pragma unroll
                    for (int m = 0; m < E8::PB; ++m) pre[m] = e.preload(rowb + ai * 128 + (mb + m) * 16, col0);
#pragma unroll
                    for (int m = 0; m < E8::PB; ++m) {
                        const pg8::f32x4 v0 = acc[ai][bj][mb + m][0], v1 = acc[ai][bj][mb + m][1];
                        const float a[8] = {v0[0], v0[1], v0[2], v0[3], v1[0], v1[1], v1[2], v1[3]};
                        ss[ai][mb + m] += e.epi8(rowb + ai * 128 + (mb + m) * 16, col0, cc, a, rv[ai][mb + m], pre[m]);
                    }
                    asm volatile("" ::: "memory");
                }
        }
        if (E8::SSQ) {
#pragma unroll
            for (int ai = 0; ai < 2; ++ai)
#pragma unroll
                for (int m = 0; m < 4; ++m) { float s = ss[ai][m]; s += __shfl_xor(s, 16); s += __shfl_xor(s, 32);
                    if (fq == 0) ssq[(size_t)(rowb + ai * 128 + m * 16) * 16 + u.pn * 4 + wc] = s; }
        }
    }
};
__device__ __forceinline__ void glds16(const void* gsrc, unsigned lds_dst) { unsigned keep;
    asm volatile("s_mov_b32 %0, m0\n\ts_mov_b32 m0, %2\n\ts_nop 0\n\tglobal_load_lds_dwordx4 %1, off\n\ts_mov_b32 m0, %0" : "=&s"(keep) : "v"(gsrc), "s"(lds_dst) : "memory"); }
struct QkvOrder {
    pg8::StaticOrder base; int G, c;
    __device__ __forceinline__ void init(int G_, int c_) { base.init(MLAT, NQKV, G_, c_); G = G_; c = c_; }
    __device__ __forceinline__ bool next(int i, pg8::Unit& u) const {
        u.aux = 0;
        if (base.next(i, u)) return true;
        const long L = (long)i * G + c - base.nwg; if (L < 0 || L >= 256) return false;
        const int id = (int)L, w = (id & 7) * 32 + (id >> 3);
        u.pm = 256 + (w >> 3); u.pn = 4 + (w & 7); return true;
    }
    __device__ __forceinline__ void a_ready(const pg8::Unit&) const {}
    __device__ __forceinline__ void done(const pg8::Unit&) const {}
};
__device__ __forceinline__ void phase_qkv(const Params& p, LAS unsigned char* lds) {
    unsigned char* ws = p.ws;
    pg8::Gemm g{(const bf16_t*)(ws + WS_A1), (const bf16_t*)(ws + WS_WIN), MALL, NQKV, DM};
    QkvOrder S; S.init((int)gridDim.x, (int)blockIdx.x);
    {   const int t = opaque_tid();
        *(LAS f32x4*)(lds + LDS_SPARE + t * 16) = *(const f32x4*)(ws + WS_ROPE + t * 16);
        __syncthreads(); }
    EpiWrap<E_QKV> E{{(bf16_t*)(ws + WS_QKV), (bf16_t*)(ws + WS_KVC), (LAS const float*)(lds + LDS_SPARE)}, nullptr};
    pg8::gemm_phase<EpiWrap<E_QKV>, QkvOrder, true, true>(lds, g, S, E);
}
__device__ __forceinline__ void phase_outproj(const Params& p, LAS unsigned char* lds) {
    unsigned char* ws = p.ws;
    pg8::Gemm g{(const bf16_t*)(ws + WS_MIX), (const bf16_t*)(ws + WS_WOUT), MLAT, DM, DM};
    pg8::StaticOrder S; S.init(MLAT, DM, (int)gridDim.x, (int)blockIdx.x);
    EpiWrap<E_OUT> E{{p.x, p.out, (bf16_t*)(ws + WS_A2), (const float*)(ws + WS_MOD), p.norm2_g}, (float*)(ws + WS_SSQ1)};
    pg8::gemm_phase<EpiWrap<E_OUT>, pg8::StaticOrder, true, true>(lds, g, S, E);
}
struct Fc1Order {
    pg8::StaticOrder base; const float* rstd; const float* bias1; unsigned tab_lds;
    __device__ __forceinline__ bool next(int i, pg8::Unit& u) const { u.aux = i & 1; return base.next(i, u); }
    __device__ __forceinline__ void a_ready(const pg8::Unit& u) const {
        const int wid = __builtin_amdgcn_readfirstlane(threadIdx.x >> 6), lane = threadIdx.x & 63;
        if (wid == 0) glds16(rstd + (size_t)u.pm * 256 + lane * 4, (unsigned)__builtin_amdgcn_readfirstlane(tab_lds + u.aux * 2048));
        else if (wid == 1) glds16(bias1 + (size_t)(u.pm >> 3) * FF + u.pn * 256 + lane * 4, (unsigned)__builtin_amdgcn_readfirstlane(tab_lds + u.aux * 2048 + 1024));
    }
    __device__ __forceinline__ void done(const pg8::Unit&) const {}
};
__device__ __forceinline__ void phase_rstd1(const Params& p) {
    const float* ssq = (const float*)(p.ws + WS_SSQ1); float* rs = (float*)(p.ws + WS_RSTD1);
    for (int row = blockIdx.x * 512 + opaque_tid(); row < MLAT; row += gridDim.x * 512) {
        const f32x4* s = (const f32x4*)(ssq + (size_t)row * 16); const f32x4 a = s[0], b = s[1], c = s[2], d = s[3];
        const float t = ((a.x + a.y) + (a.z + a.w)) + ((b.x + b.y) + (b.z + b.w)) + ((c.x + c.y) + (c.z + c.w)) + ((d.x + d.y) + (d.z + d.w));
        rs[row] = rsqrtf(t * (1.0f / DM) + EPS);
    }
}
__device__ __forceinline__ void phase_fc1(const Params& p, LAS unsigned char* lds) {
    unsigned char* ws = p.ws;
    pg8::Gemm g{(const bf16_t*)(ws + WS_A2), (const bf16_t*)(ws + WS_W1), MLAT, FF, DM};
    Fc1Order S; S.base.init(MLAT, FF, (int)gridDim.x, (int)blockIdx.x); S.rstd = (const float*)(ws + WS_RSTD1); S.bias1 = (const float*)(ws + WS_BIAS1); S.tab_lds = (unsigned)(uintptr_t)(lds + LDS_SPARE);
    EpiWrap<E_FC1> E{{(LAS const float*)(lds + LDS_SPARE), (bf16_t*)(ws + WS_HID)}, nullptr};
    pg8::gemm_phase<EpiWrap<E_FC1>, Fc1Order, true, true>(lds, g, S, E);
}
__device__ __forceinline__ void phase_fc2(const Params& p, LAS unsigned char* lds) {
    unsigned char* ws = p.ws;
    pg8::Gemm g{(const bf16_t*)(ws + WS_HID), (const bf16_t*)(ws + WS_W2), MLAT, DM, FF};
    pg8::StaticOrder S; S.init(MLAT, DM, (int)gridDim.x, (int)blockIdx.x);
    EpiWrap<E_FC2> E{{p.out, (const float*)(ws + WS_MOD)}, (float*)(ws + WS_SSQ2)};
    pg8::gemm_phase<EpiWrap<E_FC2>, pg8::StaticOrder, true, true>(lds, g, S, E);
}
struct EpiNone {
    static constexpr bool PERM = true, AFTER_DRAIN = false;
    __device__ __forceinline__ void operator()(const pg8::f32x4 (&acc)[2][2][4][2], const pg8::Unit&, int, int, int, int) const {
#pragma unroll
        for (int ai = 0; ai < 2; ++ai)
#pragma unroll
            for (int bj = 0; bj < 2; ++bj)
#pragma unroll
                for (int m = 0; m < 4; ++m)
#pragma unroll
                    for (int n = 0; n < 2; ++n) asm volatile("" :: "v"(acc[ai][bj][m][n]));
    }
};
__device__ __forceinline__ void phase_fc1_noepi(const Params& p, LAS unsigned char* lds) {
    unsigned char* ws = p.ws;
    pg8::Gemm g{(const bf16_t*)(ws + WS_A2), (const bf16_t*)(ws + WS_W1), MLAT, FF, DM};
    pg8::StaticOrder S; S.init(MLAT, FF, (int)gridDim.x, (int)blockIdx.x);
    EpiNone E{};
    pg8::gemm_phase<EpiNone, pg8::StaticOrder, true, true>(lds, g, S, E);
}
constexpr int LDS_BYTES = 163840;

namespace att {
typedef short bf16x8 __attribute__((ext_vector_type(8)));
typedef short s16x4 __attribute__((ext_vector_type(4)));
typedef short v4i16_t __attribute__((ext_vector_type(4)));
typedef float f32x16 __attribute__((ext_vector_type(16)));
constexpr int NBUF = 4, RING_BUF = 32768;
constexpr int OFF_STAGE = 0;
constexpr int OFF_WSF = 135168;
constexpr int OFF_RPB = 137216;
constexpr float THR = 8.0f;
__device__ __forceinline__ int crow(int r, int hi) { return (r & 3) + 8 * (r >> 2) + 4 * hi; }
__device__ __forceinline__ s16x4 vtr(LAS const unsigned char* p) { return __builtin_bit_cast(s16x4, __builtin_amdgcn_ds_read_tr16_b64_v4i16((LAS v4i16_t*)p)); }
struct TileSrc { const bf16_t* k; const bf16_t* v; int pitch; };
template <bool DIFF> __device__ __forceinline__ void tile_dma(const TileSrc& s, unsigned ldsbuf, int wid, int lane) {
    if (DIFF) {
#pragma unroll
        for (int i = 0; i < 2; ++i) { const int pc = wid * 2 + i, key = pc * 4 + (lane >> 4), u = lane & 15;
            glds16(s.k + (size_t)key * s.pitch + ((u ^ (key & 15)) << 3), (unsigned)__builtin_amdgcn_readfirstlane(ldsbuf + pc * 1024));
            glds16(s.v + (size_t)key * s.pitch + (((u >> 2) ^ (key & 3)) << 5) + ((u & 3) << 3), (unsigned)__builtin_amdgcn_readfirstlane(ldsbuf + 16384 + pc * 1024)); }
    } else {
        const int key = wid * 8 + (lane >> 3), u = lane & 7;
        glds16(s.k + (size_t)key * s.pitch + ((u ^ ((key >> 1) & 7)) << 3), (unsigned)__builtin_amdgcn_readfirstlane(ldsbuf + wid * 1024));
        glds16(s.v + (size_t)key * s.pitch + (((u >> 2) ^ ((key >> 1) & 1)) << 5) + ((u & 3) << 3), (unsigned)__builtin_amdgcn_readfirstlane(ldsbuf + 8192 + wid * 1024));
    }
}
template <bool DIFF> struct Lay { int koff[4]; int vb[DIFF ? 4 : 2]; };
template <bool DIFF> __device__ __forceinline__ void lay_init(Lay<DIFF>& L, int lane, int map) {
    const int r32 = lane & 31, hi = lane >> 5, q = (lane & 15) >> 2, g1 = (lane >> 4) & 1, pp = lane & 3;
#pragma unroll
    for (int d0 = 0; d0 < 4; ++d0) L.koff[d0] = DIFF ? r32 * 256 + (((8 * map + 2 * d0 + hi) ^ (r32 & 15)) << 4) : r32 * 128 + (((2 * d0 + hi) ^ ((r32 >> 1) & 7)) << 4);
#pragma unroll
    for (int c = 0; c < (DIFF ? 4 : 2); ++c) L.vb[c] = DIFF ? (4 * hi + q) * 256 + ((c ^ q) << 6) + g1 * 32 + pp * 8 : (4 * hi + q) * 128 + ((c ^ ((q >> 1) & 1)) << 6) + g1 * 32 + pp * 8;
}
#define ATT_BAR() asm volatile("s_waitcnt lgkmcnt(0)\n\ts_barrier" ::: "memory")
#define ATT_WAIT_BAR(N) asm volatile("s_waitcnt vmcnt(" #N ") lgkmcnt(0)\n\ts_barrier" ::: "memory")
template <int NC> struct WaveState { f32x16 o[NC]; f32x16 p0, p1; u32x4 pw[4]; float m, l; bf16x8 qr[4]; };
template <bool DIFF> __device__ __forceinline__ void qkt(f32x16& p0, f32x16& p1, LAS const unsigned char* kimg, const Lay<DIFF>& L, const bf16x8 (&qr)[4]) {
#pragma unroll
    for (int r = 0; r < 16; ++r) { p0[r] = 0.f; p1[r] = 0.f; }
#pragma unroll
    for (int d0 = 0; d0 < 4; ++d0) {
        const bf16x8 b0 = *(LAS const bf16x8*)(kimg + L.koff[d0]), b1 = *(LAS const bf16x8*)(kimg + L.koff[d0] + (DIFF ? 8192 : 4096));
        p0 = __builtin_amdgcn_mfma_f32_32x32x16_bf16(b0, qr[d0], p0, 0, 0, 0);
        p1 = __builtin_amdgcn_mfma_f32_32x32x16_bf16(b1, qr[d0], p1, 0, 0, 0);
    }
}
template <bool DIFF, int NC> __device__ __forceinline__ void pv(WaveState<NC>& st, LAS const unsigned char* vimg, const Lay<DIFF>& L) {
    constexpr int SS = DIFF ? 4096 : 2048;
#pragma unroll
    for (int c = 0; c < NC; ++c)
#pragma unroll
        for (int s = 0; s < 4; ++s) {
            const s16x4 lo = vtr(vimg + L.vb[c] + s * SS), hv = vtr(vimg + L.vb[c] + s * SS + SS / 2);
            const bf16x8 vf = {lo[0], lo[1], lo[2], lo[3], hv[0], hv[1], hv[2], hv[3]};
            st.o[c] = __builtin_amdgcn_mfma_f32_32x32x16_bf16(__builtin_bit_cast(bf16x8, st.pw[s]), vf, st.o[c], 0, 0, 0);
        }
}
template <bool DIFF, int NC, bool DO_PV, bool DO_QK> __device__ __forceinline__ void mblock(WaveState<NC>& st, LAS const unsigned char* vimg, LAS const unsigned char* kimg, const Lay<DIFF>& L) {
    if (DO_PV) pv<DIFF, NC>(st, vimg, L);
    if (DO_QK) qkt<DIFF>(st.p0, st.p1, kimg, L, st.qr);
    constexpr int NM = (DO_PV ? NC * 4 : 0) + (DO_QK ? 8 : 0);
    __builtin_amdgcn_sched_group_barrier(0x100, 6, 0);
#pragma unroll
    for (int i = 0; i < NM; ++i) { __builtin_amdgcn_sched_group_barrier(0x008, 1, 0); __builtin_amdgcn_sched_group_barrier(0x100, 2, 0); }
}
template <int NC> __device__ __forceinline__ void softmax_block(WaveState<NC>& st, LAS float* wsf, int r32, int hi) {
    f32x16& p0 = st.p0; f32x16& p1 = st.p1;
    float mx = fmaxf(p0[0], p1[0]);
#pragma unroll
    for (int r = 1; r < 16; ++r) mx = fmaxf(mx, fmaxf(p0[r], p1[r]));
    mx = fmaxf(mx, __shfl_xor(mx, 32));
    if (__any(mx > st.m + THR)) {
        const float mn = fmaxf(st.m, mx), alpha = __builtin_amdgcn_exp2f(st.m - mn);
        st.m = mn; st.l *= alpha;
        if (hi == 0) wsf[r32] = alpha;
#pragma unroll
        for (int r = 0; r < 16; ++r) { const float a = wsf[crow(r, hi)];
#pragma unroll
            for (int c = 0; c < NC; ++c) st.o[c][r] *= a; }
    }
    float rs = 0.f;
#pragma unroll
    for (int r = 0; r < 16; ++r) { p0[r] = __builtin_amdgcn_exp2f(p0[r] - st.m); p1[r] = __builtin_amdgcn_exp2f(p1[r] - st.m); rs += p0[r] + p1[r]; }
    st.l += rs;
#pragma unroll
    for (int i = 0; i < 4; ++i) { st.pw[0][i] = pk2(p0[2 * i], p0[2 * i + 1]); st.pw[1][i] = pk2(p0[8 + 2 * i], p0[9 + 2 * i]); st.pw[2][i] = pk2(p1[2 * i], p1[2 * i + 1]); st.pw[3][i] = pk2(p1[8 + 2 * i], p1[9 + 2 * i]); }
}
template <int NC> __device__ __forceinline__ void state_init(WaveState<NC>& st, const bf16_t* qrow) {
#pragma unroll
    for (int d0 = 0; d0 < 4; ++d0) st.qr[d0] = *(const bf16x8*)(qrow + 16 * d0);
#pragma unroll
    for (int c = 0; c < NC; ++c)
#pragma unroll
        for (int r = 0; r < 16; ++r) st.o[c][r] = 0.f;
#pragma unroll
    for (int s = 0; s < 4; ++s) st.pw[s] = (u32x4){0u, 0u, 0u, 0u};
    st.m = NEGBIG; st.l = 0.f;
}

struct DiffCtx { const bf16_t* qkv; const bf16_t* kvc; int b, h; unsigned lds0; int wid, lane; };
__device__ __forceinline__ TileSrc diff_tile(const DiffCtx& c, int t) {
    if (t < 32) { const bf16_t* base = c.qkv + (size_t)(c.b * SEQ + t * 64) * NQKV; return TileSrc{base + 1024 + 128 * c.h, base + 2048 + 128 * c.h, NQKV}; }
    const bf16_t* base = c.kvc + (size_t)(c.b * CTX + (t - 32) * 64) * NKVC; return TileSrc{base + 128 * c.h, base + 1024 + 128 * c.h, NKVC};
}
__device__ __forceinline__ float max3f(float a, float b, float c) { float r; asm("v_max3_f32 %0, %1, %2, %3" : "=v"(r) : "v"(a), "v"(b), "v"(c)); return r; }
__device__ __forceinline__ float rowmax32(const f32x16& p0, const f32x16& p1) {
    float a = max3f(p0[0], p0[1], p1[0]), b = max3f(p0[2], p0[3], p1[1]); a = max3f(a, p1[2], p1[3]);
#pragma unroll
    for (int r = 4; r < 16; r += 4) { a = max3f(a, p0[r], p0[r + 1]); b = max3f(b, p0[r + 2], p0[r + 3]); a = max3f(a, p1[r], p1[r + 1]); b = max3f(b, p1[r + 2], p1[r + 3]); }
    float m = max3f(a, b, b);
    auto rr = __builtin_amdgcn_permlane32_swap(__float_as_uint(m), __float_as_uint(m), false, false);
    return max3f(__uint_as_float(rr[0]), __uint_as_float(rr[1]), __uint_as_float(rr[1]));
}
__device__ __forceinline__ void exp_pack(const f32x16& s0, const f32x16& s1, const float m, u32x4 (&pw)[4], float& rs_out) {
    float p0[16], p1[16]; float rs = 0.f;
#pragma unroll
    for (int r = 0; r < 16; ++r) { p0[r] = __builtin_amdgcn_exp2f(s0[r] - m); p1[r] = __builtin_amdgcn_exp2f(s1[r] - m); rs += p0[r] + p1[r]; }
    rs_out = rs;
#pragma unroll
    for (int i = 0; i < 4; ++i) { pw[0][i] = pk2(p0[2 * i], p0[2 * i + 1]); pw[1][i] = pk2(p0[8 + 2 * i], p0[9 + 2 * i]); pw[2][i] = pk2(p1[2 * i], p1[2 * i + 1]); pw[3][i] = pk2(p1[8 + 2 * i], p1[9 + 2 * i]); }
}
template <bool DIFF> __device__ __forceinline__ void qkt_from(f32x16& p0, f32x16& p1, const f32x16& init, LAS const unsigned char* kimg, const Lay<DIFF>& L, const bf16x8 (&qr)[4]) {
#pragma unroll
    for (int d0 = 0; d0 < 4; ++d0) {
        const bf16x8 b0 = *(LAS const bf16x8*)(kimg + L.koff[d0]), b1 = *(LAS const bf16x8*)(kimg + L.koff[d0] + (DIFF ? 8192 : 4096));
        p0 = __builtin_amdgcn_mfma_f32_32x32x16_bf16(b0, qr[d0], d0 == 0 ? init : p0, 0, 0, 0);
        p1 = __builtin_amdgcn_mfma_f32_32x32x16_bf16(b1, qr[d0], d0 == 0 ? init : p1, 0, 0, 0);
    }
}
__device__ __forceinline__ void diff_loop3(WaveState<4>& st, const DiffCtx& c, LAS unsigned char* lds, LAS float* wsf, const Lay<true>& L, int r32, int hi) {
    constexpr int NT = 36;
    for (int t = 0; t < NT; ++t) {
        if (t + 2 < NT) tile_dma<true>(diff_tile(c, t + 2), c.lds0 + ((t + 2) & 3) * RING_BUF, c.wid, c.lane);
        const int tv = t ? t - 1 : 0, tk = (t + 1 < NT) ? t + 1 : t;
        const float mx = rowmax32(st.p0, st.p1);
        const bool need = __any(mx > st.m + THR);
        const float m_use = need ? fmaxf(st.m, mx) : st.m, alpha = __builtin_amdgcn_exp2f(st.m - m_use);
        u32x4 pwn[4]; float rs; f32x16 n0, n1;
        exp_pack(st.p0, st.p1, m_use, pwn, rs);
        pv<true, 4>(st, lds + (tv & 3) * RING_BUF + 16384, L);
        qkt<true>(n0, n1, lds + (tk & 3) * RING_BUF, L, st.qr);
        __builtin_amdgcn_sched_group_barrier(0x100, 6, 0);
#pragma unroll
        for (int i = 0; i < 24; ++i) { __builtin_amdgcn_sched_group_barrier(0x008, 1, 0); __builtin_amdgcn_sched_group_barrier(0x100, 2, 0); __builtin_amdgcn_sched_group_barrier(0x402, 5, 0); }
        asm volatile("" : "+v"(pwn[0]), "+v"(pwn[1]), "+v"(pwn[2]), "+v"(pwn[3]), "+v"(rs));
        if (need) {
            if (hi == 0) wsf[r32] = alpha;
#pragma unroll
            for (int r = 0; r < 16; ++r) { const float a = wsf[crow(r, hi)];
#pragma unroll
                for (int cc = 0; cc < 4; ++cc) st.o[cc][r] *= a; }
            st.l *= alpha; st.m = m_use;
        }
        st.l += rs;
#pragma unroll
        for (int s = 0; s < 4; ++s) st.pw[s] = pwn[s];
        st.p0 = n0; st.p1 = n1;
        ATT_WAIT_BAR(0);
    }
    pv<true, 4>(st, lds + ((NT - 1) & 3) * RING_BUF + 16384, L);
    ATT_WAIT_BAR(0);
}
__device__ __forceinline__ void diff_unit(const Params& p, LAS unsigned char* lds, const int tid_in, int b, int h, int qb, float lam, const int var) {
    int tid = tid_in; asm volatile("" : "+v"(tid));
    const int lane = tid & 63, r32 = lane & 31, hi = lane >> 5, wid = __builtin_amdgcn_readfirstlane(tid >> 6), rg = wid & 3, map = wid >> 2;
    const bf16_t* qkv = (const bf16_t*)(p.ws + WS_QKV); bf16_t* mix = (bf16_t*)(p.ws + ((var & 8) ? WS_A2 : WS_MIX));
    LAS float* wsf = (LAS float*)(lds + OFF_WSF) + wid * 64;
    Lay<true> L; lay_init<true>(L, lane, map);
    const DiffCtx c{qkv, (const bf16_t*)(p.ws + WS_KVC), b, h, (unsigned)(uintptr_t)lds, wid, lane};
    if (!(var & 4)) { tile_dma<true>(diff_tile(c, 0), c.lds0, wid, lane); tile_dma<true>(diff_tile(c, 1), c.lds0 + RING_BUF, wid, lane); }
    WaveState<4> st;
    state_init<4>(st, qkv + (size_t)(b * SEQ + qb * 128 + rg * 32 + r32) * NQKV + 128 * h + 64 * map + 8 * hi);
    ATT_WAIT_BAR(0);
    qkt<true>(st.p0, st.p1, lds, L, st.qr);
    diff_loop3(st, c, lds, wsf, L, r32, hi);
    {   int tid2 = tid; asm volatile("" : "+v"(tid2));
        const int lane2 = tid2 & 63, r32b = lane2 & 31, hib = lane2 >> 5;
        float lt = st.l + __shfl_xor(st.l, 32);
        if (hib == 0) wsf[r32b] = 1.0f / lt;
        LAS float* stg = (LAS float*)(lds + OFF_STAGE);
#pragma unroll
        for (int r = 0; r < 16; ++r) { const float inv = wsf[crow(r, hib)]; const int R = map * 128 + rg * 32 + crow(r, hib);
#pragma unroll
            for (int cc = 0; cc < 4; ++cc) stg[R * 132 + 32 * cc + r32b] = st.o[cc][r] * inv; }
        __syncthreads();
        const int row = tid2 >> 2, part = tid2 & 3;
        float o[32]; float ss = 0.f;
#pragma unroll
        for (int i = 0; i < 8; ++i) { const f32x4 a = *(LAS const f32x4*)(stg + row * 132 + part * 32 + 4 * i), bb = *(LAS const f32x4*)(stg + (128 + row) * 132 + part * 32 + 4 * i);
#pragma unroll
            for (int e = 0; e < 4; ++e) { const float v = a[e] - lam * bb[e]; o[4 * i + e] = v; ss += v * v; } }
        ss += __shfl_xor(ss, 1); ss += __shfl_xor(ss, 2);
        const float rstd = rsqrtf(ss * (1.0f / 128.0f) + EPS) * (1.0f - LAM_INIT);
        bf16_t* dst = mix + (size_t)(b * SEQ + qb * 128 + row) * DM + 128 * h + part * 32;
#pragma unroll
        for (int i = 0; i < 4; ++i) { const f32x4 g0 = *(const f32x4*)(p.subln_g + part * 32 + 8 * i), g1 = *(const f32x4*)(p.subln_g + part * 32 + 8 * i + 4);
            u32x4 w; w.x = pk2(o[8 * i] * rstd * g0.x, o[8 * i + 1] * rstd * g0.y); w.y = pk2(o[8 * i + 2] * rstd * g0.z, o[8 * i + 3] * rstd * g0.w);
            w.z = pk2(o[8 * i + 4] * rstd * g1.x, o[8 * i + 5] * rstd * g1.y); w.w = pk2(o[8 * i + 6] * rstd * g1.z, o[8 * i + 7] * rstd * g1.w);
            *(u32x4*)(dst + 8 * i) = w; }
        asm volatile("s_waitcnt vmcnt(0)" ::: "memory");
        __syncthreads();
    }
}
constexpr int NA_SLOT = 16384;
constexpr float MASKV = -3.0e38f;
struct NaCtx { const bf16_t* qkv; const bf16_t* kvc; int b, hh, lo0, nrows; unsigned lds0; int wid, lane; };
__device__ __forceinline__ TileSrc na_tile(const NaCtx& c, int i) {
    if (i < c.nrows) { const bf16_t* base = c.qkv + (size_t)(c.b * SEQ + (c.lo0 + i) * 64) * NQKV; return TileSrc{base + 1536 + 64 * c.hh, base + 2560 + 64 * c.hh, NQKV}; }
    const bf16_t* base = c.kvc + (size_t)(c.b * CTX + (i - c.nrows) * 64) * NKVC; return TileSrc{base + 512 + 64 * c.hh, base + 1536 + 64 * c.hh, NKVC};
}
struct NaState { f32x16 o[2]; f32x16 s0, s1; u32x4 pw[4]; float m, l; bf16x8 qr[4]; };
template <int NK> __device__ __forceinline__ void na_pv(NaState& st, LAS const unsigned char* vimg, const int (&vb)[2]) {
#pragma unroll
    for (int cc = 0; cc < 2; ++cc)
#pragma unroll
        for (int s = 0; s < NK; ++s) {
            const s16x4 lo = vtr(vimg + vb[cc] + s * 2048), hv = vtr(vimg + vb[cc] + s * 2048 + 1024);
            const bf16x8 vf = {lo[0], lo[1], lo[2], lo[3], hv[0], hv[1], hv[2], hv[3]};
            st.o[cc] = __builtin_amdgcn_mfma_f32_32x32x16_bf16(__builtin_bit_cast(bf16x8, st.pw[s]), vf, st.o[cc], 0, 0, 0);
        }
}
template <bool TWO> __device__ __forceinline__ void na_qk(f32x16& n0, f32x16& n1, LAS const unsigned char* kimg, const int (&koff)[4], const bf16x8 (&qr)[4]) {
#pragma unroll
    for (int r = 0; r < 16; ++r) { n0[r] = 0.f; if (TWO) n1[r] = 0.f; }
#pragma unroll
    for (int d0 = 0; d0 < 4; ++d0) {
        n0 = __builtin_amdgcn_mfma_f32_32x32x16_bf16(*(LAS const bf16x8*)(kimg + koff[d0]), qr[d0], n0, 0, 0, 0);
        if (TWO) n1 = __builtin_amdgcn_mfma_f32_32x32x16_bf16(*(LAS const bf16x8*)(kimg + koff[d0] + 4096), qr[d0], n1, 0, 0, 0);
    }
}
__device__ __forceinline__ void na_rescale(NaState& st, LAS float* wsf, float alpha, float m_use, int r32, int hi) {
    if (hi == 0) wsf[r32] = alpha;
#pragma unroll
    for (int r = 0; r < 16; ++r) { const float a = wsf[crow(r, hi)]; st.o[0][r] *= a; st.o[1][r] *= a; }
    st.l *= alpha; st.m = m_use;
}
__device__ __forceinline__ void na_unit(const Params& p, LAS unsigned char* lds, const int tid_in, int b, int hh, int rg4) {
    int tid = tid_in; asm volatile("" : "+v"(tid));
    const int lane = tid & 63, r32 = lane & 31, hi = lane >> 5, wid = __builtin_amdgcn_readfirstlane(tid >> 6), pr = wid >> 2, cb = wid & 3;
    const bf16_t* qkv = (const bf16_t*)(p.ws + WS_QKV); bf16_t* mix = (bf16_t*)(p.ws + WS_MIX);
    LAS float* wsf = (LAS float*)(lds + OFF_WSF) + wid * 64;
    LAS float* rpbL = (LAS float*)(lds + OFF_RPB);
    const int r0 = 4 * rg4;
    const int lo0 = min(max(r0 - 4, 0), 24), hi0 = min(max(r0 - 3, 0), 24) + 7, lo1 = min(max(r0 - 2, 0), 24), hi1 = min(max(r0 - 1, 0), 24) + 7;
    const int d = lo1 - lo0, nrows = hi1 - lo0 + 1, n0c = hi0 - lo0 + 1, n1c = hi1 - lo1 + 1, S_lat = max(n0c, n1c), ntiles = nrows + 4;
    const int off = pr ? d : 0, np = pr ? n1c : n0c;
    const NaCtx c{qkv, (const bf16_t*)(p.ws + WS_KVC), b, hh, lo0, nrows, (unsigned)(uintptr_t)lds, wid, lane};
    for (int i = 0; i < d + 3; ++i) tile_dma<false>(na_tile(c, i), c.lds0 + (i & 7) * NA_SLOT, wid, lane);
    if (tid < 465) rpbL[tid] = p.rpb[hh * 465 + tid] * LOG2E;
    const int qrow = r0 + 2 * pr + (r32 >> 4), jq = 16 * cb + (r32 & 15), kc0 = (cb == 0) ? 0 : (cb == 1) ? 8 : (cb == 2) ? 24 : 32;
    const int qstart = min(max(qrow - 4, 0), 24), cs = min(max(jq - 8, 0), 48);
    NaState st;
#pragma unroll
    for (int d0 = 0; d0 < 4; ++d0) st.qr[d0] = *(const bf16x8*)(qkv + (size_t)(b * SEQ + qrow * 64 + jq) * NQKV + 512 + 64 * hh + 8 * hi + 16 * d0);
#pragma unroll
    for (int r = 0; r < 16; ++r) { st.o[0][r] = 0.f; st.o[1][r] = 0.f; }
#pragma unroll
    for (int s = 0; s < 4; ++s) st.pw[s] = (u32x4){0u, 0u, 0u, 0u};
    st.m = NEGBIG; st.l = 0.f;
    unsigned cmask = 0u;
#pragma unroll
    for (int r = 0; r < 16; ++r) { const int jk = kc0 + crow(r, hi); if (jk >= cs && jk < cs + 16) cmask |= 1u << r; }
    int koffL[4], koffC[4], vbL[2], vbC[2];
    {   const int q = (lane & 15) >> 2, g1 = (lane >> 4) & 1, pp = lane & 3, keyL = kc0 + r32;
#pragma unroll
        for (int d0 = 0; d0 < 4; ++d0) { koffL[d0] = keyL * 128 + (((2 * d0 + hi) ^ ((keyL >> 1) & 7)) << 4); koffC[d0] = r32 * 128 + (((2 * d0 + hi) ^ ((r32 >> 1) & 7)) << 4); }
#pragma unroll
        for (int cc = 0; cc < 2; ++cc) { vbC[cc] = (4 * hi + q) * 128 + ((cc ^ ((q >> 1) & 1)) << 6) + g1 * 32 + pp * 8; vbL[cc] = vbC[cc] + kc0 * 128; } }
    const int bias_base = 15 - jq + kc0 + 4 * hi;
    asm volatile("s_waitcnt vmcnt(2) lgkmcnt(0)\n\ts_barrier" ::: "memory");
    na_qk<false>(st.s0, st.s1, lds + (off & 7) * NA_SLOT, koffL, st.qr);
    for (int s = 0; s < S_lat; ++s) {
        if (s + d + 3 < ntiles) tile_dma<false>(na_tile(c, s + d + 3), c.lds0 + ((s + d + 3) & 7) * NA_SLOT, wid, lane);
        const bool live = s < np;
        const int ic = off + (live ? s : np - 1), ipv = off + (s ? min(s, np) - 1 : 0), inx = off + min(s + 1, np - 1);
        const int kr = lo0 + ic;
        {   const bool rowok = live && kr >= qstart && kr < qstart + 8;
            LAS const float* bp = rpbL + (kr - qrow + 7) * 31 + bias_base;
#pragma unroll
            for (int r = 0; r < 16; ++r) { const float bv = bp[(r & 3) + 8 * (r >> 2)]; st.s0[r] = (rowok && ((cmask >> r) & 1u)) ? st.s0[r] + bv : MASKV; } }
        float mx = max3f(st.s0[0], st.s0[1], st.s0[2]);
#pragma unroll
        for (int r = 3; r < 15; r += 2) mx = max3f(mx, st.s0[r], st.s0[r + 1]);
        mx = max3f(mx, st.s0[15], st.s0[15]);
        { auto rr = __builtin_amdgcn_permlane32_swap(__float_as_uint(mx), __float_as_uint(mx), false, false); mx = max3f(__uint_as_float(rr[0]), __uint_as_float(rr[1]), __uint_as_float(rr[1])); }
        const bool need = __any(mx > st.m + THR);
        const float m_use = need ? fmaxf(st.m, mx) : st.m, alpha = __builtin_amdgcn_exp2f(st.m - m_use);
        u32x4 pwn[2]; float rs = 0.f;
        {   float e[16];
#pragma unroll
            for (int r = 0; r < 16; ++r) { e[r] = __builtin_amdgcn_exp2f(st.s0[r] - m_use); rs += e[r]; }
#pragma unroll
            for (int i = 0; i < 4; ++i) { pwn[0][i] = pk2(e[2 * i], e[2 * i + 1]); pwn[1][i] = pk2(e[8 + 2 * i], e[9 + 2 * i]); } }
        f32x16 n0, n1;
        na_pv<2>(st, lds + (ipv & 7) * NA_SLOT + 8192, vbL);
        na_qk<false>(n0, n1, lds + (inx & 7) * NA_SLOT, koffL, st.qr);
        __builtin_amdgcn_sched_group_barrier(0x100, 4, 0);
#pragma unroll
        for (int i = 0; i < 8; ++i) { __builtin_amdgcn_sched_group_barrier(0x008, 1, 0); __builtin_amdgcn_sched_group_barrier(0x100, 2, 0); __builtin_amdgcn_sched_group_barrier(0x402, 12, 0); }
        asm volatile("" : "+v"(pwn[0]), "+v"(pwn[1]), "+v"(rs));
        if (need) na_rescale(st, wsf, alpha, m_use, r32, hi);
        st.l += rs; st.pw[0] = pwn[0]; st.pw[1] = pwn[1]; st.s0 = n0;
        if (s + d + 3 < ntiles) asm volatile("s_waitcnt vmcnt(2) lgkmcnt(0)\n\ts_barrier" ::: "memory");
        else asm volatile("s_waitcnt vmcnt(0) lgkmcnt(0)\n\ts_barrier" ::: "memory");
    }
    na_pv<2>(st, lds + ((off + np - 1) & 7) * NA_SLOT + 8192, vbL);
    na_qk<true>(st.s0, st.s1, lds + (nrows & 7) * NA_SLOT, koffC, st.qr);
#pragma unroll
    for (int s = 0; s < 4; ++s) st.pw[s] = (u32x4){0u, 0u, 0u, 0u};
    for (int cs4 = 0; cs4 < 4; ++cs4) {
        const int gs = S_lat + cs4;
        if (gs + d + 3 < ntiles) tile_dma<false>(na_tile(c, gs + d + 3), c.lds0 + ((gs + d + 3) & 7) * NA_SLOT, wid, lane);
        const int ipv = nrows + (cs4 ? cs4 - 1 : 0), inx = nrows + min(cs4 + 1, 3);
        const float mx = rowmax32(st.s0, st.s1);
        const bool need = __any(mx > st.m + THR);
        const float m_use = need ? fmaxf(st.m, mx) : st.m, alpha = __builtin_amdgcn_exp2f(st.m - m_use);
        u32x4 pwn[4]; float rs; f32x16 n0, n1;
        exp_pack(st.s0, st.s1, m_use, pwn, rs);
        na_pv<4>(st, lds + (ipv & 7) * NA_SLOT + 8192, vbC);
        na_qk<true>(n0, n1, lds + (inx & 7) * NA_SLOT, koffC, st.qr);
        __builtin_amdgcn_sched_group_barrier(0x100, 6, 0);
#pragma unroll
        for (int i = 0; i < 16; ++i) { __builtin_amdgcn_sched_group_barrier(0x008, 1, 0); __builtin_amdgcn_sched_group_barrier(0x100, 2, 0); __builtin_amdgcn_sched_group_barrier(0x402, 8, 0); }
        asm volatile("" : "+v"(pwn[0]), "+v"(pwn[1]), "+v"(pwn[2]), "+v"(pwn[3]), "+v"(rs));
        if (need) na_rescale(st, wsf, alpha, m_use, r32, hi);
        st.l += rs;
#pragma unroll
        for (int s = 0; s < 4; ++s) st.pw[s] = pwn[s];
        st.s0 = n0; st.s1 = n1;
        if (gs + d + 3 < ntiles) asm volatile("s_waitcnt vmcnt(2) lgkmcnt(0)\n\ts_barrier" ::: "memory");
        else asm volatile("s_waitcnt vmcnt(0) lgkmcnt(0)\n\ts_barrier" ::: "memory");
    }
    na_pv<4>(st, lds + ((nrows + 3) & 7) * NA_SLOT + 8192, vbC);
    asm volatile("s_waitcnt vmcnt(0) lgkmcnt(0)\n\ts_barrier" ::: "memory");
    {   int tid2 = tid; asm volatile("" : "+v"(tid2));
        const int lane2 = tid2 & 63, r32b = lane2 & 31, hib = lane2 >> 5;
        float lt = st.l + __shfl_xor(st.l, 32);
        if (hib == 0) wsf[r32b] = 1.0f / lt;
        LAS float* stg = (LAS float*)(lds + OFF_STAGE) + wid * (32 * 68);
#pragma unroll
        for (int r = 0; r < 16; ++r) { const float inv = wsf[crow(r, hib)];
#pragma unroll
            for (int cc = 0; cc < 2; ++cc) stg[crow(r, hib) * 68 + 32 * cc + r32b] = st.o[cc][r] * inv; }
        const int row = lane2 >> 1, half = lane2 & 1;
        bf16_t* dst = mix + (size_t)(b * SEQ + (r0 + 2 * pr + (row >> 4)) * 64 + 16 * cb + (row & 15)) * DM + 512 + 64 * hh + half * 32;
#pragma unroll
        for (int i = 0; i < 4; ++i) { const f32x4 a = *(LAS const f32x4*)(stg + row * 68 + half * 32 + 8 * i), c4 = *(LAS const f32x4*)(stg + row * 68 + half * 32 + 8 * i + 4);
            u32x4 w; w.x = pk2(a.x, a.y); w.y = pk2(a.z, a.w); w.z = pk2(c4.x, c4.y); w.w = pk2(c4.z, c4.w);
            *(u32x4*)(dst + 8 * i) = w; }
        asm volatile("s_waitcnt vmcnt(0)" ::: "memory");
        __syncthreads();
    }
}
}
__device__ __forceinline__ void phase_attn(const Params& p, LAS unsigned char* lds, const int which = 3, const int var = 0) {
    const int G = (int)gridDim.x, bx = (int)blockIdx.x, vcu = (G % 8 == 0) ? (bx % 8) * (G / 8) + bx / 8 : bx;
    const float lam = *(const float*)(p.ws + WS_LAM);
    const int tid = opaque_tid();
    if (which & 1) for (int u = vcu; u < 2048; u += G) att::diff_unit(p, lds, tid, u >> 6, (u >> 4) & 3, u & 15, lam, var);
    if (which & 2) for (int u = vcu; u < 2048; u += G) att::na_unit(p, lds, tid, u >> 6, (u >> 3) & 7, u & 7);
}

__device__ __forceinline__ void phase_final(const Params& p, int gw, int NGW, int lane) {
    const float* ssq2 = (const float*)(p.ws + WS_SSQ2);
    for (int row = gw; row < MLAT; row += NGW) {
        const float sv = (lane < 16) ? ssq2[(size_t)row * 16 + lane] : 0.f;
        const float rstd = rsqrtf(wave_sum(sv) * (1.0f / DM) + EPS);
        float* o = p.out + (size_t)row * DM;
#pragma unroll
        for (int j = 0; j < 4; ++j) { const int col = 4 * lane + 256 * j; const f32x4 v = *(const f32x4*)(o + col), g = *(const f32x4*)(p.final_g + col); *(f32x4*)(o + col) = v * rstd * g; }
    }
}

#ifndef PHASE_MASK
#define PHASE_MASK 255
#endif
#ifndef ATT_VAR
#define ATT_VAR 0
#endif
#ifndef REPEAT_MASK
#define REPEAT_MASK 0
#endif
constexpr int LDS_MISC = 163840 - 64;
constexpr int CW_BAR = 4096;
#define RLX_AGENT __ATOMIC_RELAXED, __HIP_MEMORY_SCOPE_AGENT
#define XB_TMO      128
#define XB_XCNT(j)  (256  + 64 * (j))
#define XB_XSUB(j)  (1280 + 64 * (j))
#define XB_XGEN(j)  (2304 + 64 * (j))
#define XB_TOP      3328
#define XB_TOPGEN   3392
#define XCD_BAR_WORDS 3456
#define XB_SPIN_CAP (1u << 18)

__device__ __forceinline__ unsigned xb_ld(unsigned* p)              { return __hip_atomic_load(p, __ATOMIC_RELAXED, __HIP_MEMORY_SCOPE_AGENT); }
__device__ __forceinline__ unsigned xb_add(unsigned* p, unsigned v) { return __hip_atomic_fetch_add(p, v, __ATOMIC_RELAXED, __HIP_MEMORY_SCOPE_AGENT); }
__device__ __forceinline__ unsigned xb_xcc_id() { return (unsigned)__builtin_amdgcn_s_getreg((3 << 11) | 20) & 0xFu; }
#define XB_SPIN(cond, bar) do { unsigned _sp = 0; while (cond) { __builtin_amdgcn_s_sleep(1); \
    if ((++_sp & 255u) == 0u) { if (xb_ld(&(bar)[XB_TMO])) break; if (_sp > XB_SPIN_CAP) { atomicAdd(&(bar)[XB_TMO], 1u); break; } } } } while (0)

struct XcdBarrier {
    unsigned* bar; unsigned x;
    volatile LAS unsigned* st;
};

__device__ __forceinline__ XcdBarrier xcd_barrier_post(unsigned* bar, volatile LAS unsigned* st) {
    XcdBarrier b; b.bar = bar; b.x = xb_xcc_id(); b.st = st;
    if (threadIdx.x == 0) (void)xb_add(&bar[XB_XCNT(b.x)], 1u);
    return b;
}
__device__ __forceinline__ void xcd_barrier_complete(unsigned* bar, unsigned x, unsigned& nloc, unsigned& nx) {
    const unsigned G = gridDim.x * gridDim.y * gridDim.z;
    unsigned sum, cnt, mine, sp = 0u;
    for (;;) {
        sum = 0u; cnt = 0u; mine = 0u;
#pragma unroll
        for (unsigned j = 0; j < 16; ++j) { const unsigned c = xb_ld(&bar[XB_XCNT(j)]); sum += c; cnt += (c > 0u) ? 1u : 0u; mine = (j == x) ? c : mine; }
        if (sum == G) break;
        __builtin_amdgcn_s_sleep(1);
        if ((++sp & 255u) == 0u) { if (xb_ld(&bar[XB_TMO])) break; if (sp > XB_SPIN_CAP) { atomicAdd(&bar[XB_TMO], 1u); break; } }
    }
    nloc = mine > 0u ? mine : 1u; nx = cnt > 0u ? cnt : 1u;
}

__device__ __forceinline__ void xcd_barrier(const XcdBarrier& b) {
    asm volatile("s_waitcnt vmcnt(0)" ::: "memory");
    __syncthreads();
    if (threadIdx.x == 0) {
        unsigned* bar = b.bar;
        __builtin_amdgcn_s_waitcnt(0);
        unsigned nloc = b.st[0], nx = b.st[1];
        if (nloc == 0u) { xcd_barrier_complete(bar, b.x, nloc, nx); b.st[0] = nloc; b.st[1] = nx; }
        const unsigned old = xb_add(&bar[XB_XSUB(b.x)], 1u);
        const unsigned gen = old / nloc;
        if (old + 1u == (gen + 1u) * nloc) {
            __builtin_amdgcn_fence(__ATOMIC_RELEASE, "agent");
            asm volatile("s_waitcnt vmcnt(0)" ::: "memory");
            const unsigned og = xb_add(&bar[XB_TOP], 1u);
            const unsigned tg = og / nx;
            if (og + 1u == (tg + 1u) * nx) xb_add(&bar[XB_TOPGEN], 1u);
            else XB_SPIN(xb_ld(&bar[XB_TOPGEN]) == tg, bar);
            __builtin_amdgcn_fence(__ATOMIC_ACQUIRE, "agent");
            xb_add(&bar[XB_XGEN(b.x)], 1u);
            asm volatile("s_waitcnt vmcnt(0)" ::: "memory");
        } else {
            XB_SPIN(xb_ld(&bar[XB_XGEN(b.x)]) == gen, bar);
            __builtin_amdgcn_fence(__ATOMIC_ACQUIRE, "agent");
            asm volatile("s_waitcnt vmcnt(0)" ::: "memory");
        }
    }
    __syncthreads();
}

typedef const Params __attribute__((address_space(4))) CParams;
__device__ __forceinline__ Params kparams() {
#if defined(__HIP_DEVICE_COMPILE__)
    CParams* k = (CParams*)__builtin_amdgcn_kernarg_segment_ptr(); asm volatile("" : "+s"(k)); return *k;
#else
    return Params{};
#endif
}
#define PH_IDS const int tid_ = opaque_tid(), wid = tid_ >> 6, lane = tid_ & 63, gw = blockIdx.x * 8 + wid, NGW = gridDim.x * 8
__global__ __launch_bounds__(512, 2) void k_mega(Params p_unused) {
    extern __shared__ __attribute__((aligned(16))) unsigned char lds[];
    cg::grid_group grid = cg::this_grid();
    volatile LAS unsigned* MISC = (volatile LAS unsigned*)((LAS unsigned char*)lds + LDS_MISC);
    if (threadIdx.x < 16) MISC[threadIdx.x] = 0u;
    __syncthreads();
    XcdBarrier bar;
    { const Params p = kparams(); bar = xcd_barrier_post((unsigned*)(p.ws + WS_CTL) + CW_BAR, MISC); }
#define SEAM() xcd_barrier(bar)
#define RUN(k, call) do { if (PHASE_MASK & (1 << (k))) { call; } if (REPEAT_MASK & (1 << (k))) { SEAM(); call; } } while (0)
    RUN(0, { const Params p = kparams(); PH_IDS; phase_prep_a(p, (float*)lds + wid * 2112, gw, NGW, lane); });
    grid.sync();
    RUN(1, { const Params p = kparams(); PH_IDS; phase_prep_b(p, (float*)lds + wid * 2112, gw, NGW, lane); });
    SEAM();
    RUN(2, { const Params p = kparams(); phase_qkv(p, (LAS unsigned char*)lds); });
    SEAM();
    RUN(3, { const Params p = kparams(); phase_attn(p, (LAS unsigned char*)lds); });
    if (REPEAT_MASK & 256) { SEAM(); const Params p = kparams(); phase_attn(p, (LAS unsigned char*)lds, 1, ATT_VAR); }
    if (REPEAT_MASK & 512) { SEAM(); const Params p = kparams(); phase_attn(p, (LAS unsigned char*)lds, 2); }
    SEAM();
    RUN(4, { const Params p = kparams(); phase_outproj(p, (LAS unsigned char*)lds); });
    SEAM();
    if (PHASE_MASK & 32) { const Params p = kparams(); phase_rstd1(p); }
    SEAM();
    RUN(5, { const Params p = kparams(); phase_fc1(p, (LAS unsigned char*)lds); });
    if (REPEAT_MASK & 1024) { SEAM(); const Params p = kparams(); phase_fc1_noepi(p, (LAS unsigned char*)lds); }
    SEAM();
    RUN(6, { const Params p = kparams(); phase_fc2(p, (LAS unsigned char*)lds); });
    SEAM();
    RUN(7, { const Params p = kparams(); PH_IDS; phase_final(p, gw, NGW, lane); });
}

extern "C" void kernel_launch(void* const* d_in, const int* in_sizes, int n_in, void* d_out, int out_size, void* d_ws, size_t ws_size, hipStream_t stream) {
    if (n_in != 19 || in_sizes[0] != MLAT * DM || out_size != MLAT * DM || ws_size < WS_END) {
        fprintf(stderr, "kernel_launch: unexpected shapes: n_in %d in0 %d out %d ws %zu (need %zu)\n", n_in, n_in > 0 ? in_sizes[0] : -1, out_size, ws_size, (size_t)WS_END);
        return;
    }
    Params p{};
    const float** pf = (const float**)&p;
    for (int i = 0; i < 19; ++i) pf[i] = (const float*)d_in[i];
    p.out = (float*)d_out; p.ws = (unsigned char*)d_ws;
    unsigned char* ws = p.ws;
    static int grid_blocks = 0;
    if (grid_blocks == 0) {
        int dev = 0, cus = 0, per_cu = 0;
        (void)hipGetDevice(&dev);
        (void)hipDeviceGetAttribute(&cus, hipDeviceAttributeMultiprocessorCount, dev);
        (void)hipFuncSetAttribute((const void*)k_mega, hipFuncAttributeMaxDynamicSharedMemorySize, LDS_BYTES);
        (void)hipOccupancyMaxActiveBlocksPerMultiprocessor(&per_cu, (const void*)k_mega, 512, LDS_BYTES);
        if (per_cu < 1) { fprintf(stderr, "kernel_launch: occupancy query reports %d blocks per CU\n", per_cu); per_cu = 1; }
        grid_blocks = cus;
        (void)hipGetLastError();
    }
    (void)hipMemsetAsync(ws, 0, WS_ZERO_BYTES, stream);
    void* args[] = {&p};
    hipError_t e = hipLaunchCooperativeKernel((const void*)k_mega, dim3(grid_blocks), dim3(512), args, LDS_BYTES, stream);
    if (e != hipSuccess) fprintf(stderr, "kernel_launch: cooperative launch failed: %s (grid %d)\n", hipGetErrorString(e), grid_blocks);
}
```

```cpp
#include <hip/hip_runtime.h>
#include <hip/hip_cooperative_groups.h>
#include <cstdio>
#include <cstdint>

namespace cg = cooperative_groups;
typedef unsigned short bf16_t;
typedef float f32x4 __attribute__((ext_vector_type(4)));
typedef float f32x2 __attribute__((ext_vector_type(2)));
typedef unsigned u32x4 __attribute__((ext_vector_type(4)));
typedef unsigned u32x2 __attribute__((ext_vector_type(2)));
typedef __bf16 bf16x2_t __attribute__((ext_vector_type(2)));

constexpr int NB = 32, SEQ = 2048, DM = 1024, CTX = 256, FF = 4096, NQKV = 3072, NKVC = 2048;
constexpr int MLAT = NB * SEQ, MCTX = NB * CTX, MALL = MLAT + MCTX;
constexpr int MODN = 6 * DM;
constexpr float EPS = 1e-6f;
constexpr float LOG2E = 1.4426950408889634f;
constexpr float C2 = 0.125f * LOG2E;
constexpr float LAM_INIT = 0.2f;
constexpr float NEGBIG = -1e30f;

constexpr size_t MiB = 1u << 20;
constexpr size_t WS_CTL = 0;
constexpr size_t WS_MOD = 1 * MiB;
constexpr size_t WS_BIAS1 = 2 * MiB;
constexpr size_t WS_ROPE = 3 * MiB;
constexpr size_t WS_LAM = 3 * MiB + 65536;
constexpr size_t WS_ZERO_BYTES = 3 * MiB;
constexpr size_t WS_SSQ1 = 4 * MiB;
constexpr size_t WS_SSQ2 = 8 * MiB;
constexpr size_t WS_RSTD1 = 3 * MiB + 131072;
constexpr size_t WS_WIN = 12 * MiB;
constexpr size_t WS_WOUT = 18 * MiB;
constexpr size_t WS_W1 = 20 * MiB;
constexpr size_t WS_W2 = 28 * MiB;
constexpr size_t WS_KVC = 36 * MiB;
constexpr size_t WS_A2 = 84 * MiB;
constexpr size_t WS_MIX = 212 * MiB;
constexpr size_t WS_A1 = 340 * MiB;
constexpr size_t WS_QKV = 484 * MiB;
constexpr size_t WS_HID = 340 * MiB;
constexpr size_t WS_END = 868 * MiB;

struct Params {
    const float *x, *c, *ctx, *c_ctx, *w_mod, *b_mod, *norm1_g, *w_in, *lam_q1, *lam_k1, *lam_q2, *lam_k2, *subln_g, *rpb, *w_out, *norm2_g, *w_fc1, *w_fc2, *final_g;
    float* out; unsigned char* ws;
};

__device__ __forceinline__ unsigned pk2(float lo, float hi) { f32x2 v = {lo, hi}; bf16x2_t b = __builtin_convertvector(v, bf16x2_t); return __builtin_bit_cast(unsigned, b); }
__device__ __forceinline__ float bf_lo(unsigned w) { return __uint_as_float(w << 16); }
__device__ __forceinline__ float bf_hi(unsigned w) { return __uint_as_float(w & 0xffff0000u); }
__device__ __forceinline__ float bf2f(bf16_t v) { return __uint_as_float(((unsigned)v) << 16); }
__device__ __forceinline__ float wave_sum(float v) {
#pragma unroll
    for (int o = 1; o < 64; o <<= 1) v += __shfl_xor(v, o);
    return v;
}
__device__ __forceinline__ float wave_max(float v) {
#pragma unroll
    for (int o = 1; o < 64; o <<= 1) v = fmaxf(v, __shfl_xor(v, o));
    return v;
}
__host__ __device__ __forceinline__ int win_src_col(int n) {
    const bool perm = (n < 512) || (n >= 1024 && n < 1536);
    if (!perm) return n;
    const int nd = n & 63, base = n - nd, i = nd >> 1, par = nd & 1;
    const int old = (i < 16 ? i : 32 + (i - 16)) + 16 * par;
    return base + old;
}

template <bool PERMW>
__device__ __forceinline__ void transpose_item(const float* __restrict__ W, int K, int N, bf16_t* __restrict__ WT, float* scr, int item, int lane) {
    const int nblk = N / 32, kb = item / nblk, nb = item % nblk, k0 = 64 * kb, n0 = 32 * nb;
    const int nsrc = PERMW ? win_src_col(n0 + (lane & 31)) : (n0 + (lane & 31));
#pragma unroll 8
    for (int i = 0; i < 32; ++i) { const int kk = 2 * i + (lane >> 5); scr[kk * 33 + (lane & 31)] = W[(size_t)(k0 + kk) * N + nsrc]; }
    __builtin_amdgcn_s_waitcnt(0xC07F); asm volatile("" ::: "memory");
    const int c = lane & 7;
#pragma unroll
    for (int j = 0; j < 4; ++j) { const int n = (lane >> 3) + 8 * j; const float* s = scr + (8 * c) * 33 + n;
        u32x4 o; o.x = pk2(s[0 * 33], s[1 * 33]); o.y = pk2(s[2 * 33], s[3 * 33]); o.z = pk2(s[4 * 33], s[5 * 33]); o.w = pk2(s[6 * 33], s[7 * 33]);
        *(u32x4*)(WT + (size_t)(n0 + n) * K + k0 + 8 * c) = o; }
    __builtin_amdgcn_s_waitcnt(0xC07F); asm volatile("" ::: "memory");
}
template <int NR, bool SILU>
__device__ __forceinline__ void small_mm_task(const float* __restrict__ src, size_t src_stride, const float* __restrict__ last_row, const float* __restrict__ W, int N,
                                              int k0, int n0, float* out, size_t out_stride, const float* __restrict__ bias, float* scr, int lane) {
#pragma unroll
    for (int r = 0; r < NR; ++r) {
        const float* sr = (last_row && r == NR - 1) ? last_row : src + (size_t)r * src_stride;
        float v = sr[k0 + lane];
        if (SILU) v = v / (1.0f + __expf(-v));
        scr[r * 64 + lane] = v;
    }
    __builtin_amdgcn_s_waitcnt(0xC07F); asm volatile("" ::: "memory");
    float acc[NR];
#pragma unroll
    for (int r = 0; r < NR; ++r) acc[r] = 0.f;
#pragma unroll 1
    for (int kk = 0; kk < 64; kk += 4) {
        const float w0 = W[(size_t)(k0 + kk + 0) * N + n0 + lane], w1 = W[(size_t)(k0 + kk + 1) * N + n0 + lane];
        const float w2 = W[(size_t)(k0 + kk + 2) * N + n0 + lane], w3 = W[(size_t)(k0 + kk + 3) * N + n0 + lane];
#pragma unroll
        for (int r = 0; r < NR; ++r) { const f32x4 s = *(const f32x4*)(scr + r * 64 + kk); acc[r] += s.x * w0 + s.y * w1 + s.z * w2 + s.w * w3; }
    }
    const float bv = (bias && k0 == 0) ? bias[n0 + lane] : 0.f;
#pragma unroll
    for (int r = 0; r < NR; ++r) atomicAdd(out + (size_t)r * out_stride + n0 + lane, acc[r] + bv);
    __builtin_amdgcn_s_waitcnt(0xC07F); asm volatile("" ::: "memory");
}

__device__ __forceinline__ void phase_prep_a(const Params& p, float* scr  , int gw, int NGW, int lane) {
    unsigned char* ws = p.ws;
    constexpr int T_MOD = (MODN / 64) * (DM / 64);
    constexpr int I_IN = (DM / 64) * (NQKV / 32), I_OUT = (DM / 64) * (DM / 32), I_1 = (DM / 64) * (FF / 32), I_2 = (FF / 64) * (DM / 32);
    constexpr int T_ALL = T_MOD + I_IN + I_OUT + I_1 + I_2 + 17;
    for (int t = gw; t < T_ALL; t += NGW) {
        int r = t;
        if (r < T_MOD) { const int nb = r % (MODN / 64), kc = r / (MODN / 64);
            small_mm_task<33, true>(p.c, DM, p.c_ctx, p.w_mod, MODN, kc * 64, nb * 64, (float*)(ws + WS_MOD), MODN, p.b_mod, scr, lane); continue; }
        r -= T_MOD;
        if (r < I_IN) { transpose_item<true>(p.w_in, DM, NQKV, (bf16_t*)(ws + WS_WIN), scr, r, lane); continue; } r -= I_IN;
        if (r < I_OUT) { transpose_item<false>(p.w_out, DM, DM, (bf16_t*)(ws + WS_WOUT), scr, r, lane); continue; } r -= I_OUT;
        if (r < I_1) { transpose_item<false>(p.w_fc1, DM, FF, (bf16_t*)(ws + WS_W1), scr, r, lane); continue; } r -= I_1;
        if (r < I_2) { transpose_item<false>(p.w_fc2, FF, DM, (bf16_t*)(ws + WS_W2), scr, r, lane); continue; } r -= I_2;
        if (r < 16) {
            const int pos = 4 * r + (lane >> 4), f = lane & 15;
            const float inv = powf(10000.0f, -(float)f / 16.0f);
            const float ang = (float)pos * inv;
            float* T = (float*)(ws + WS_ROPE) + (pos * 16 + f) * 2;
            T[0] = cosf(ang); T[1] = sinf(ang);
        } else {
            const float a = wave_sum(p.lam_q1[lane] * p.lam_k1[lane]), b = wave_sum(p.lam_q2[lane] * p.lam_k2[lane]);
            if (lane == 0) *(float*)(ws + WS_LAM) = expf(a) - expf(b) + LAM_INIT;
        }
    }
}
__device__ __forceinline__ void phase_prep_b(const Params& p, float* scr, int gw, int NGW, int lane) {
    unsigned char* ws = p.ws;
    const float* mod = (const float*)(ws + WS_MOD);
    constexpr int T_B1 = (FF / 64) * (DM / 64);
    for (int t = gw; t < T_B1; t += NGW) { const int nb = t % (FF / 64), kc = t / (FF / 64);
        small_mm_task<32, false>(mod + 3 * DM, MODN, nullptr, p.w_fc1, FF, kc * 64, nb * 64, (float*)(ws + WS_BIAS1), FF, nullptr, scr, lane); }
    bf16_t* A1 = (bf16_t*)(ws + WS_A1);
    for (int row = gw; row < MALL; row += NGW) {
        const float* xr; const float* mrow;
        if (row < MLAT) { xr = p.x + (size_t)row * DM; mrow = mod + (size_t)(row >> 11) * MODN; }
        else { xr = p.ctx + (size_t)(row - MLAT) * DM; mrow = mod + (size_t)32 * MODN; }
        f32x4 v[4]; float ss = 0.f;
#pragma unroll
        for (int j = 0; j < 4; ++j) { v[j] = *((const f32x4*)xr + lane + 64 * j); ss += (v[j].x * v[j].x + v[j].y * v[j].y) + (v[j].z * v[j].z + v[j].w * v[j].w); }
        const float rstd = rsqrtf(wave_sum(ss) * (1.0f / DM) + EPS);
#pragma unroll
        for (int j = 0; j < 4; ++j) {
            const int col = 4 * lane + 256 * j;
            const f32x4 g = *(const f32x4*)(p.norm1_g + col), sh = *(const f32x4*)(mrow + col), sc = *(const f32x4*)(mrow + DM + col);
            const f32x4 h = (v[j] * rstd) * g * (sc + 1.0f) + sh;
            u32x2 o; o.x = pk2(h.x, h.y); o.y = pk2(h.z, h.w);
            *(u32x2*)(A1 + (size_t)row * DM + col) = o;
        }
    }
}
#define LAS __attribute__((address_space(3)))
constexpr int LDS_SPARE = 131072;
struct E_QKV {
    static constexpr bool SSQ = false; static constexpr int PB = 4;
    bf16_t* qkv; bf16_t* kvc; LAS const float* rope;
    struct Col {};
    struct Pre { f32x4 t0, t1; };
    template <class U> __device__ __forceinline__ float rowval(const U&, int) const { return 0.f; }
    template <class U> __device__ __forceinline__ Col col_prep(const U&, int, int) const { return Col{}; }
    __device__ __forceinline__ static bool rope_cols(int col0) { return (col0 < 512) || (col0 >= 1024 && col0 < 1536); }
    __device__ __forceinline__ Pre preload(int row, int col0) const {
        Pre pr; pr.t0 = (f32x4){1.f, 0.f, 1.f, 0.f}; pr.t1 = pr.t0;
        if (row < MLAT && rope_cols(col0)) {
            const int s = row & (SEQ - 1), gr = s >> 6, gc = s & 63;
            const int i0 = (col0 & 63) >> 1, pos = (i0 >= 16) ? gc : gr, f0 = i0 & 15;
            LAS const f32x4* T = (LAS const f32x4*)(rope + (pos * 16 + f0) * 2);
            pr.t0 = T[0]; pr.t1 = T[1];
        }
        return pr;
    }
    __device__ __forceinline__ float epi8(int row, int col0, const Col&, const float (&a)[8], float, const Pre& pr) const {
        float v[8];
#pragma unroll
        for (int j = 0; j < 8; ++j) v[j] = a[j];
        if (row < MLAT) {
            if (rope_cols(col0)) {
                const float cs[4] = {pr.t0.x, pr.t0.z, pr.t1.x, pr.t1.z}, sn[4] = {pr.t0.y, pr.t0.w, pr.t1.y, pr.t1.w};
#pragma unroll
                for (int q = 0; q < 4; ++q) { const float x1 = v[2 * q], x2 = v[2 * q + 1]; v[2 * q] = x1 * cs[q] - x2 * sn[q]; v[2 * q + 1] = x1 * sn[q] + x2 * cs[q]; }
            }
            if (col0 < 1024) {
#pragma unroll
                for (int j = 0; j < 8; ++j) v[j] *= C2;
            }
            u32x4 o; o.x = pk2(v[0], v[1]); o.y = pk2(v[2], v[3]); o.z = pk2(v[4], v[5]); o.w = pk2(v[6], v[7]);
            *(u32x4*)(qkv + (size_t)row * NQKV + col0) = o;
        } else if (col0 >= 1024) {
            u32x4 o; o.x = pk2(v[0], v[1]); o.y = pk2(v[2], v[3]); o.z = pk2(v[4], v[5]); o.w = pk2(v[6], v[7]);
            *(u32x4*)(kvc + (size_t)(row - MLAT) * NKVC + (col0 - 1024)) = o;
        }
        return 0.f;
    }
};
struct E_OUT {
    static constexpr bool SSQ = true; static constexpr int PB = 2;
    const float* x; float* x1; bf16_t* a2; const float* mod; const float* g2;
    struct Col { f32x4 ga0, ga1, gm0, gm1; };
    struct Pre { f32x4 x0, x4; };
    template <class U> __device__ __forceinline__ float rowval(const U&, int) const { return 0.f; }
    template <class U> __device__ __forceinline__ Col col_prep(const U&, int b, int col0) const {
        Col c; const float* m = mod + (size_t)b * MODN + col0;
        c.ga0 = *(const f32x4*)(m + 2 * DM); c.ga1 = *(const f32x4*)(m + 2 * DM + 4);
        c.gm0 = *(const f32x4*)(g2 + col0) * (*(const f32x4*)(m + 4 * DM) + 1.0f); c.gm1 = *(const f32x4*)(g2 + col0 + 4) * (*(const f32x4*)(m + 4 * DM + 4) + 1.0f);
        return c;
    }
    __device__ __forceinline__ Pre preload(int row, int col0) const { const size_t off = (size_t)row * DM + col0; Pre pr; pr.x0 = *(const f32x4*)(x + off); pr.x4 = *(const f32x4*)(x + off + 4); return pr; }
    __device__ __forceinline__ float epi8(int row, int col0, const Col& c, const float (&a)[8], float, const Pre& pr) const {
        const size_t off = (size_t)row * DM + col0;
        const f32x4 v0 = pr.x0 + c.ga0 * (f32x4){a[0], a[1], a[2], a[3]}, v1 = pr.x4 + c.ga1 * (f32x4){a[4], a[5], a[6], a[7]};
        __builtin_nontemporal_store(v0, (f32x4*)(x1 + off)); __builtin_nontemporal_store(v1, (f32x4*)(x1 + off + 4));
        const f32x4 h0 = v0 * c.gm0, h1 = v1 * c.gm1;
        u32x4 o; o.x = pk2(h0.x, h0.y); o.y = pk2(h0.z, h0.w); o.z = pk2(h1.x, h1.y); o.w = pk2(h1.z, h1.w);
        *(u32x4*)(a2 + off) = o;
        const f32x4 q = v0 * v0 + v1 * v1;
        return (q.x + q.y) + (q.z + q.w);
    }
};
struct E_FC1 {
    static constexpr bool SSQ = false; static constexpr int PB = 4;
    LAS const float* tab; bf16_t* hid;
    struct Col { f32x4 b0, b1; };
    struct Pre {};
    __device__ __forceinline__ Pre preload(int, int) const { return Pre{}; }
    template <class U> __device__ __forceinline__ float rowval(const U& u, int row) const { return tab[u.aux * 512 + (row - u.pm * 256)]; }
    template <class U> __device__ __forceinline__ Col col_prep(const U& u, int, int col0) const { Col c; LAS const f32x4* t = (LAS const f32x4*)(tab + u.aux * 512 + 256 + (col0 - u.pn * 256)); c.b0 = t[0]; c.b1 = t[1]; return c; }
    __device__ __forceinline__ float epi8(int row, int col0, const Col& c, const float (&a)[8], float rv, const Pre&) const {
        const float bs[8] = {c.b0.x, c.b0.y, c.b0.z, c.b0.w, c.b1.x, c.b1.y, c.b1.z, c.b1.w};
        float v[8];
#pragma unroll
        for (int j = 0; j < 8; ++j) { const float z = fmaxf(rv * a[j] + bs[j], 0.f); v[j] = z * z; }
        u32x4 o; o.x = pk2(v[0], v[1]); o.y = pk2(v[2], v[3]); o.z = pk2(v[4], v[5]); o.w = pk2(v[6], v[7]);
        __builtin_nontemporal_store(o, (u32x4*)(hid + (size_t)row * FF + col0));
        return 0.f;
    }
};
struct E_FC2 {
    static constexpr bool SSQ = true; static constexpr int PB = 4;
    float* xio; const float* mod;
    struct Col { f32x4 gm0, gm1; };
    struct Pre { f32x4 x0, x4; };
    template <class U> __device__ __forceinline__ float rowval(const U&, int) const { return 0.f; }
    template <class U> __device__ __forceinline__ Col col_prep(const U&, int b, int col0) const { Col c; const float* m = mod + (size_t)b * MODN + 5 * DM + col0; c.gm0 = *(const f32x4*)m; c.gm1 = *(const f32x4*)(m + 4); return c; }
    __device__ __forceinline__ Pre preload(int row, int col0) const { const size_t off = (size_t)row * DM + col0; Pre pr; pr.x0 = *(const f32x4*)(xio + off); pr.x4 = *(const f32x4*)(xio + off + 4); return pr; }
    __device__ __forceinline__ float epi8(int row, int col0, const Col& c, const float (&a)[8], float, const Pre& pr) const {
        const size_t off = (size_t)row * DM + col0;
        const f32x4 v0 = pr.x0 + c.gm0 * (f32x4){a[0], a[1], a[2], a[3]}, v1 = pr.x4 + c.gm1 * (f32x4){a[4], a[5], a[6], a[7]};
        *(f32x4*)(xio + off) = v0; *(f32x4*)(xio + off + 4) = v1;
        const f32x4 q = v0 * v0 + v1 * v1;
        return (q.x + q.y) + (q.z + q.w);
    }
};

__device__ __forceinline__ int opaque_tid() { int t = threadIdx.x; asm volatile("" : "+v"(t)); return t; }
namespace pg8 {
#define PG8_LAS __attribute__((address_space(3)))
typedef unsigned short bf16_t;
typedef short bf16x8 __attribute__((ext_vector_type(8)));
typedef float f32x4 __attribute__((ext_vector_type(4)));
typedef unsigned u32x4 __attribute__((ext_vector_type(4)));
constexpr int BM = 256, BK = 64, HALF = 128, HTB = HALF * BK * 2  , STAGE_BYTES = 8 * HTB, NXCD = 8, WGM = 8;

__host__ __device__ __forceinline__ int lds_byte(int r, int c) { const int st = (r >> 4) * 2 + (c >> 5), rr = r & 15, cc = c & 31, ob = rr * 64 + cc * 2; return st * 1024 + (ob ^ (((ob >> 9) & 1) << 5)); }
__host__ __device__ __forceinline__ void stage_rc(int b, int& R, int& C) { const int st = b / 1024, sb = b % 1024, swz = sb ^ (((sb >> 9) & 1) << 5); R = (st >> 1) * 16 + swz / 64; C = (st & 1) * 32 + (swz % 64) / 2; }
__host__ __device__ __forceinline__ int perm32(int rho) { const int n = rho >> 4, i = rho & 15; return 8 * (i >> 2) + 4 * n + (i & 3); }

struct Unit { int pm, pn, aux; };
struct Gemm { const bf16_t* A; const bf16_t* Bt; int M, N, K; };

struct StaticOrder {
    int nM, nN, nwg, G, c;
    __host__ __device__ void init(int M, int N, int G_, int c_) { nM = M / BM; nN = N / BM; nwg = nM * nN; G = G_; c = c_; }
    __host__ __device__ bool next(int i, Unit& u) const {
        const long L = (long)i * G + c; if (L >= nwg) return false;
        int wgid = (int)L; { const int q = nwg / NXCD, r = nwg % NXCD, xcd = wgid % NXCD, off = wgid / NXCD; wgid = (xcd < r ? xcd * (q + 1) : r * (q + 1) + (xcd - r) * q) + off; }
        const int nig = WGM * nN, gid = wgid / nig, fm = gid * WGM, gsz = (nM - fm) < WGM ? (nM - fm) : WGM;
        u.pm = fm + ((wgid % nig) % gsz); u.pn = (wgid % nig) / gsz; return true;
    }
    __device__ __forceinline__ void a_ready(const Unit&) const {}
    __device__ __forceinline__ void done(const Unit&) const {}
};


template <class Epi, class Sched, bool ALIGN_EPI = false, bool SP2 = false>
__device__ __forceinline__ void gemm_phase(PG8_LAS unsigned char* lds, const Gemm g, const Sched& S, const Epi& E) {
    const int tid = opaque_tid(), wid = __builtin_amdgcn_readfirstlane(tid >> 6), lane = tid & 63, wr = wid >> 2, wc = wid & 3, fr = lane & 15, fq = lane >> 4;
    const int K = g.K, nt = K / BK;
    unsigned voffA[2], voffB[2];
#pragma unroll
    for (int i = 0; i < 2; ++i) { int R, C; stage_rc(tid * 16 + i * 8192, R, C); const int Rb = Epi::PERM ? ((R & ~31) + perm32(R & 31)) : R;
        voffA[i] = (unsigned)(R * K + C) * 2u; voffB[i] = (unsigned)(Rb * K + C) * 2u; }
    const size_t kstep = (size_t)(BK * 2);
    const size_t hstep = (size_t)HALF * K * 2;
    const size_t tstep = 2 * hstep;
    const unsigned ldsw = (unsigned)wid * 1024u;
    const int aoff = lds_byte(wr * 64 + fr, fq * 8), boff = lds_byte(wc * 32 + fr, fq * 8);
#define PG8_SA(b, h) (((b) * 2 + (h)) * HTB)
#define PG8_SB(b, h) ((4 + (b) * 2 + (h)) * HTB)
#define PG8_STAGE(bufoff, gbase, voff) do { _Pragma("unroll") for (int _i = 0; _i < 2; ++_i) \
        __builtin_amdgcn_global_load_lds((const unsigned*)((const char*)(gbase) + (voff)[_i]), (PG8_LAS unsigned*)(lds + (bufoff) + ldsw + _i * 8192), 16, 0, 0); } while (0)
#define PG8_LDA(dst, b, h) do { _Pragma("unroll") for (int m = 0; m < 4; ++m) _Pragma("unroll") for (int k = 0; k < 2; ++k) dst[m][k] = *(const PG8_LAS bf16x8*)(lds + PG8_SA(b, h) + aoff + m * 2048 + k * 1024); } while (0)
#define PG8_LDB(dst, b, h) do { _Pragma("unroll") for (int n = 0; n < 2; ++n) _Pragma("unroll") for (int k = 0; k < 2; ++k) dst[n][k] = *(const PG8_LAS bf16x8*)(lds + PG8_SB(b, h) + boff + n * 2048 + k * 1024); } while (0)
#define PG8_MMA(ai, bj, At, Bt) do { __builtin_amdgcn_s_setprio(1); _Pragma("unroll") for (int m = 0; m < 4; ++m) _Pragma("unroll") for (int n = 0; n < 2; ++n) _Pragma("unroll") for (int k = 0; k < 2; ++k) \
        acc[ai][bj][m][n] = __builtin_amdgcn_mfma_f32_16x16x32_bf16(Bt[n][k], At[m][k], acc[ai][bj][m][n], 0, 0, 0); __builtin_amdgcn_s_setprio(0); } while (0)
#define PG8_WAIT_V(n) asm volatile("s_waitcnt vmcnt(" #n ")" ::: "memory")
#define PG8_WAIT_L(n) asm volatile("s_waitcnt lgkmcnt(" #n ")" ::: "memory")
#define PG8_BAR __builtin_amdgcn_s_barrier()
#define PG8_SCHED __builtin_amdgcn_sched_barrier(0)
    Unit cur, nxt; int ui = 0;
    if (!S.next(0, cur)) return;
    f32x4 acc[2][2][4][2];
#pragma unroll
    for (int a = 0; a < 2; ++a)
#pragma unroll
        for (int b = 0; b < 2; ++b)
#pragma unroll
            for (int m = 0; m < 4; ++m)
#pragma unroll
                for (int n = 0; n < 2; ++n) acc[a][b][m][n] = (f32x4){0.f, 0.f, 0.f, 0.f};
    bf16x8 At[4][2], B0[2][2], B1[2][2];
    const char* cA = (const char*)g.A + (size_t)cur.pm * tstep; const char* cB = (const char*)g.Bt + (size_t)cur.pn * tstep;
    S.a_ready(cur);
    if constexpr (SP2) {
        PG8_STAGE(PG8_SB(0, 0), cB, voffB); PG8_STAGE(PG8_SB(0, 1), cB + hstep, voffB); PG8_STAGE(PG8_SA(0, 0), cA, voffA); PG8_STAGE(PG8_SA(0, 1), cA + hstep, voffA);
        if (wr == 1) PG8_BAR;
        PG8_WAIT_V(2); PG8_BAR;
        PG8_STAGE(PG8_SB(1, 0), cB + kstep, voffB); PG8_STAGE(PG8_SA(1, 0), cA + kstep, voffA); PG8_STAGE(PG8_SB(1, 1), cB + hstep + kstep, voffB);
        PG8_WAIT_V(6); PG8_BAR;
    } else {
        PG8_STAGE(PG8_SB(0, 0), cB, voffB); PG8_STAGE(PG8_SA(0, 0), cA, voffA); PG8_STAGE(PG8_SB(0, 1), cB + hstep, voffB); PG8_STAGE(PG8_SA(0, 1), cA + hstep, voffA);
        if (wr == 1) PG8_BAR;
        PG8_WAIT_V(4); PG8_BAR;
        PG8_STAGE(PG8_SB(1, 0), cB + kstep, voffB); PG8_STAGE(PG8_SA(1, 0), cA + kstep, voffA); PG8_STAGE(PG8_SB(1, 1), cB + hstep + kstep, voffB);
        PG8_WAIT_V(6); PG8_BAR;
    }
    for (;;) {
        const bool has_next = S.next(ui + 1, nxt);
        const char* nA = has_next ? (const char*)g.A + (size_t)nxt.pm * tstep : cA; const char* nB = has_next ? (const char*)g.Bt + (size_t)nxt.pn * tstep : cB;
        for (int t = 0; t < nt; t += 2) {
            const bool last = (t == nt - 2);
            const char* a1 = cA + (size_t)(t + 1) * kstep;
            const char* a2 = last ? nA : cA + (size_t)(t + 2) * kstep; const char* b2 = last ? nB : cB + (size_t)(t + 2) * kstep;
            const char* a3 = a2 + kstep; const char* b3 = b2 + kstep;
            if (last && has_next) S.a_ready(nxt);
            if constexpr (SP2) {
            PG8_LDB(B0, 0, 0); PG8_LDB(B1, 0, 1); PG8_SCHED; PG8_LDA(At, 0, 0); PG8_STAGE(PG8_SA(1, 1), a1 + hstep, voffA);
            PG8_WAIT_V(8); PG8_WAIT_L(0); PG8_BAR; PG8_MMA(0, 0, At, B0); PG8_MMA(0, 1, At, B1); PG8_BAR; PG8_SCHED;
            PG8_LDA(At, 0, 1); PG8_STAGE(PG8_SB(0, 0), b2, voffB); PG8_STAGE(PG8_SB(0, 1), b2 + hstep, voffB); PG8_STAGE(PG8_SA(0, 0), a2, voffA);
            PG8_WAIT_V(8); PG8_WAIT_L(0); PG8_BAR; PG8_MMA(1, 0, At, B0); PG8_MMA(1, 1, At, B1); PG8_BAR; PG8_SCHED;
            PG8_LDB(B0, 1, 0); PG8_LDB(B1, 1, 1); PG8_SCHED; PG8_LDA(At, 1, 0); PG8_STAGE(PG8_SA(0, 1), a2 + hstep, voffA);
            PG8_WAIT_V(8); PG8_WAIT_L(0); PG8_BAR; PG8_MMA(0, 0, At, B0); PG8_MMA(0, 1, At, B1); PG8_BAR; PG8_SCHED;
            PG8_LDA(At, 1, 1); PG8_STAGE(PG8_SB(1, 0), b3, voffB); PG8_STAGE(PG8_SB(1, 1), b3 + hstep, voffB); PG8_STAGE(PG8_SA(1, 0), a3, voffA);
            PG8_WAIT_V(8); PG8_WAIT_L(0); PG8_BAR; PG8_MMA(1, 0, At, B0); PG8_MMA(1, 1, At, B1); PG8_BAR; PG8_SCHED;
            } else {
            PG8_LDB(B0, 0, 0); PG8_SCHED; PG8_LDA(At, 0, 0); PG8_STAGE(PG8_SA(1, 1), a1 + hstep, voffA);
            PG8_WAIT_L(8); PG8_BAR; PG8_WAIT_L(0); PG8_MMA(0, 0, At, B0); PG8_BAR; PG8_SCHED;
            PG8_LDB(B1, 0, 1); PG8_STAGE(PG8_SB(0, 0), b2, voffB);
            PG8_BAR; PG8_WAIT_L(0); PG8_MMA(0, 1, At, B1); PG8_BAR;
            PG8_LDA(At, 0, 1); PG8_STAGE(PG8_SA(0, 0), a2, voffA);
            PG8_BAR; PG8_WAIT_L(0); PG8_MMA(1, 0, At, B0); PG8_BAR; PG8_SCHED;
            PG8_STAGE(PG8_SB(0, 1), b2 + hstep, voffB);
            PG8_WAIT_V(6); PG8_BAR; PG8_MMA(1, 1, At, B1); PG8_BAR;
            PG8_LDB(B0, 1, 0); PG8_SCHED; PG8_LDA(At, 1, 0); PG8_STAGE(PG8_SA(0, 1), a2 + hstep, voffA);
            PG8_WAIT_L(8); PG8_BAR; PG8_WAIT_L(0); PG8_MMA(0, 0, At, B0); PG8_BAR; PG8_SCHED;
            PG8_LDB(B1, 1, 1); PG8_STAGE(PG8_SB(1, 0), b3, voffB);
            PG8_BAR; PG8_WAIT_L(0); PG8_MMA(0, 1, At, B1); PG8_BAR;
            PG8_LDA(At, 1, 1); PG8_STAGE(PG8_SA(1, 0), a3, voffA);
            PG8_BAR; PG8_WAIT_L(0); PG8_MMA(1, 0, At, B0); PG8_BAR; PG8_SCHED;
            PG8_STAGE(PG8_SB(1, 1), b3 + hstep, voffB);
            PG8_WAIT_V(6); PG8_BAR; PG8_MMA(1, 1, At, B1); PG8_BAR;
            }
        }
        if constexpr (ALIGN_EPI) { if (wr == 0) PG8_BAR; }
        if constexpr (!Epi::AFTER_DRAIN) { E(acc, cur, wr, wc, fr, fq); S.done(cur); }
        if (!has_next) break;
#pragma unroll
        for (int a = 0; a < 2; ++a)
#pragma unroll
            for (int b = 0; b < 2; ++b)
#pragma unroll
                for (int m = 0; m < 4; ++m)
#pragma unroll
                    for (int n = 0; n < 2; ++n) acc[a][b][m][n] = (f32x4){0.f, 0.f, 0.f, 0.f};
        cur = nxt; cA = nA; cB = nB; ++ui;
        if constexpr (ALIGN_EPI) { if (wr == 1) PG8_BAR; }
    }
    PG8_WAIT_V(0);
    if constexpr (!ALIGN_EPI) { if (wr == 0) PG8_BAR; }
    PG8_BAR;
    if constexpr (Epi::AFTER_DRAIN) { E.fused(acc, cur, wr, wc, fr, fq, lds, wid, lane); S.done(cur); }
#undef PG8_SA
#undef PG8_SB
#undef PG8_STAGE
#undef PG8_LDA
#undef PG8_LDB
#undef PG8_MMA
#undef PG8_WAIT_V
#undef PG8_WAIT_L
#undef PG8_BAR
#undef PG8_SCHED
}
}


template <class E8> struct EpiWrap {
    static constexpr bool PERM = true, AFTER_DRAIN = false;
    E8 e; float* ssq;
    __device__ __forceinline__ void operator()(const pg8::f32x4 (&acc)[2][2][4][2], const pg8::Unit& u, int wr, int wc, int fr, int fq) const {
        const int rowb = u.pm * 256 + wr * 64 + fr;
        const int b = (u.pm < 256) ? (u.pm >> 3) : 0;
        float rv[2][4], ss[2][4];
#pragma unroll
        for (int ai = 0; ai < 2; ++ai)
#pragma unroll
            for (int m = 0; m < 4; ++m) { rv[ai][m] = e.rowval(u, rowb + ai * 128 + m * 16); ss[ai][m] = 0.f; }
#pragma unroll
        for (int bj = 0; bj < 2; ++bj) {
            const int col0 = u.pn * 256 + bj * 128 + wc * 32 + 8 * fq;
            const typename E8::Col cc = e.col_prep(u, b, col0);
#pragma unroll
            for (int ai = 0; ai < 2; ++ai)
#pragma unroll
                for (int mb = 0; mb < 4; mb += E8::PB) {
                    typename E8::Pre pre[E8::PB];
#pragma unroll
                    for (int m = 0; m < E8::PB; ++m) pre[m] = e.preload(rowb + ai * 128 + (mb + m) * 16, col0);
#pragma unroll
                    for (int m = 0; m < E8::PB; ++m) {
                        const pg8::f32x4 v0 = acc[ai][bj][mb + m][0], v1 = acc[ai][bj][mb + m][1];
                        const float a[8] = {v0[0], v0[1], v0[2], v0[3], v1[0], v1[1], v1[2], v1[3]};
                        ss[ai][mb + m] += e.epi8(rowb + ai * 128 + (mb + m) * 16, col0, cc, a, rv[ai][mb + m], pre[m]);
                    }
                    asm volatile("" ::: "memory");
                }
        }
        if (E8::SSQ) {
#pragma unroll
            for (int ai = 0; ai < 2; ++ai)
#pragma unroll
                for (int m = 0; m < 4; ++m) { float s = ss[ai][m]; s += __shfl_xor(s, 16); s += __shfl_xor(s, 32);
                    if (fq == 0) ssq[(size_t)(rowb + ai * 128 + m * 16) * 16 + u.pn * 4 + wc] = s; }
        }
    }
};
__device__ __forceinline__ void glds16(const void* gsrc, unsigned lds_dst) { unsigned keep;
    asm volatile("s_mov_b32 %0, m0\n\ts_mov_b32 m0, %2\n\ts_nop 0\n\tglobal_load_lds_dwordx4 %1, off\n\ts_mov_b32 m0, %0" : "=&s"(keep) : "v"(gsrc), "s"(lds_dst) : "memory"); }
struct QkvOrder {
    pg8::StaticOrder base; int G, c;
    __device__ __forceinline__ void init(int G_, int c_) { base.init(MLAT, NQKV, G_, c_); G = G_; c = c_; }
    __device__ __forceinline__ bool next(int i, pg8::Unit& u) const {
        u.aux = 0;
        if (base.next(i, u)) return true;
        const long L = (long)i * G + c - base.nwg; if (L < 0 || L >= 256) return false;
        const int id = (int)L, w = (id & 7) * 32 + (id >> 3);
        u.pm = 256 + (w >> 3); u.pn = 4 + (w & 7); return true;
    }
    __device__ __forceinline__ void a_ready(const pg8::Unit&) const {}
    __device__ __forceinline__ void done(const pg8::Unit&) const {}
};
__device__ __forceinline__ void phase_qkv(const Params& p, LAS unsigned char* lds) {
    unsigned char* ws = p.ws;
    pg8::Gemm g{(const bf16_t*)(ws + WS_A1), (const bf16_t*)(ws + WS_WIN), MALL, NQKV, DM};
    QkvOrder S; S.init((int)gridDim.x, (int)blockIdx.x);
    {   const int t = opaque_tid();
        *(LAS f32x4*)(lds + LDS_SPARE + t * 16) = *(const f32x4*)(ws + WS_ROPE + t * 16);
        __syncthreads(); }
    EpiWrap<E_QKV> E{{(bf16_t*)(ws + WS_QKV), (bf16_t*)(ws + WS_KVC), (LAS const float*)(lds + LDS_SPARE)}, nullptr};
    pg8::gemm_phase<EpiWrap<E_QKV>, QkvOrder, true, true>(lds, g, S, E);
}
__device__ __forceinline__ void phase_outproj(const Params& p, LAS unsigned char* lds) {
    unsigned char* ws = p.ws;
    pg8::Gemm g{(const bf16_t*)(ws + WS_MIX), (const bf16_t*)(ws + WS_WOUT), MLAT, DM, DM};
    pg8::StaticOrder S; S.init(MLAT, DM, (int)gridDim.x, (int)blockIdx.x);
    EpiWrap<E_OUT> E{{p.x, p.out, (bf16_t*)(ws + WS_A2), (const float*)(ws + WS_MOD), p.norm2_g}, (float*)(ws + WS_SSQ1)};
    pg8::gemm_phase<EpiWrap<E_OUT>, pg8::StaticOrder, true, true>(lds, g, S, E);
}
struct Fc1Order {
    pg8::StaticOrder base; const float* rstd; const float* bias1; unsigned tab_lds;
    __device__ __forceinline__ bool next(int i, pg8::Unit& u) const { u.aux = i & 1; return base.next(i, u); }
    __device__ __forceinline__ void a_ready(const pg8::Unit& u) const {
        const int wid = __builtin_amdgcn_readfirstlane(threadIdx.x >> 6), lane = threadIdx.x & 63;
        if (wid == 0) glds16(rstd + (size_t)u.pm * 256 + lane * 4, (unsigned)__builtin_amdgcn_readfirstlane(tab_lds + u.aux * 2048));
        else if (wid == 1) glds16(bias1 + (size_t)(u.pm >> 3) * FF + u.pn * 256 + lane * 4, (unsigned)__builtin_amdgcn_readfirstlane(tab_lds + u.aux * 2048 + 1024));
    }
    __device__ __forceinline__ void done(const pg8::Unit&) const {}
};
__device__ __forceinline__ void phase_rstd1(const Params& p) {
    const float* ssq = (const float*)(p.ws + WS_SSQ1); float* rs = (float*)(p.ws + WS_RSTD1);
    for (int row = blockIdx.x * 512 + opaque_tid(); row < MLAT; row += gridDim.x * 512) {
        const f32x4* s = (const f32x4*)(ssq + (size_t)row * 16); const f32x4 a = s[0], b = s[1], c = s[2], d = s[3];
        const float t = ((a.x + a.y) + (a.z + a.w)) + ((b.x + b.y) + (b.z + b.w)) + ((c.x + c.y) + (c.z + c.w)) + ((d.x + d.y) + (d.z + d.w));
        rs[row] = rsqrtf(t * (1.0f / DM) + EPS);
    }
}
__device__ __forceinline__ void phase_fc1(const Params& p, LAS unsigned char* lds) {
    unsigned char* ws = p.ws;
    pg8::Gemm g{(const bf16_t*)(ws + WS_A2), (const bf16_t*)(ws + WS_W1), MLAT, FF, DM};
    Fc1Order S; S.base.init(MLAT, FF, (int)gridDim.x, (int)blockIdx.x); S.rstd = (const float*)(ws + WS_RSTD1); S.bias1 = (const float*)(ws + WS_BIAS1); S.tab_lds = (unsigned)(uintptr_t)(lds + LDS_SPARE);
    EpiWrap<E_FC1> E{{(LAS const float*)(lds + LDS_SPARE), (bf16_t*)(ws + WS_HID)}, nullptr};
    pg8::gemm_phase<EpiWrap<E_FC1>, Fc1Order, true, true>(lds, g, S, E);
}
__device__ __forceinline__ void phase_fc2(const Params& p, LAS unsigned char* lds) {
    unsigned char* ws = p.ws;
    pg8::Gemm g{(const bf16_t*)(ws + WS_HID), (const bf16_t*)(ws + WS_W2), MLAT, DM, FF};
    pg8::StaticOrder S; S.init(MLAT, DM, (int)gridDim.x, (int)blockIdx.x);
    EpiWrap<E_FC2> E{{p.out, (const float*)(ws + WS_MOD)}, (float*)(ws + WS_SSQ2)};
    pg8::gemm_phase<EpiWrap<E_FC2>, pg8::StaticOrder, true, true>(lds, g, S, E);
}
struct EpiNone {
    static constexpr bool PERM = true, AFTER_DRAIN = false;
    __device__ __forceinline__ void operator()(const pg8::f32x4 (&acc)[2][2][4][2], const pg8::Unit&, int, int, int, int) const {
#pragma unroll
        for (int ai = 0; ai < 2; ++ai)
#pragma unroll
            for (int bj = 0; bj < 2; ++bj)
#pragma unroll
                for (int m = 0; m < 4; ++m)
#pragma unroll
                    for (int n = 0; n < 2; ++n) asm volatile("" :: "v"(acc[ai][bj][m][n]));
    }
};
__device__ __forceinline__ void phase_fc1_noepi(const Params& p, LAS unsigned char* lds) {
    unsigned char* ws = p.ws;
    pg8::Gemm g{(const bf16_t*)(ws + WS_A2), (const bf16_t*)(ws + WS_W1), MLAT, FF, DM};
    pg8::StaticOrder S; S.init(MLAT, FF, (int)gridDim.x, (int)blockIdx.x);
    EpiNone E{};
    pg8::gemm_phase<EpiNone, pg8::StaticOrder, true, true>(lds, g, S, E);
}
constexpr int LDS_BYTES = 163840;

namespace att {
typedef short bf16x8 __attribute__((ext_vector_type(8)));
typedef short s16x4 __attribute__((ext_vector_type(4)));
typedef short v4i16_t __attribute__((ext_vector_type(4)));
typedef float f32x16 __attribute__((ext_vector_type(16)));
constexpr int NBUF = 4, RING_BUF = 32768;
constexpr int OFF_STAGE = 0;
constexpr int OFF_WSF = 135168;
constexpr int OFF_RPB = 137216;
constexpr float THR = 8.0f;
__device__ __forceinline__ int crow(int r, int hi) { return (r & 3) + 8 * (r >> 2) + 4 * hi; }
__device__ __forceinline__ s16x4 vtr(LAS const unsigned char* p) { return __builtin_bit_cast(s16x4, __builtin_amdgcn_ds_read_tr16_b64_v4i16((LAS v4i16_t*)p)); }
struct TileSrc { const bf16_t* k; const bf16_t* v; int pitch; };
template <bool DIFF> __device__ __forceinline__ void tile_dma(const TileSrc& s, unsigned ldsbuf, int wid, int lane) {
    if (DIFF) {
#pragma unroll
        for (int i = 0; i < 2; ++i) { const int pc = wid * 2 + i, key = pc * 4 + (lane >> 4), u = lane & 15;
            glds16(s.k + (size_t)key * s.pitch + ((u ^ (key & 15)) << 3), (unsigned)__builtin_amdgcn_readfirstlane(ldsbuf + pc * 1024));
            glds16(s.v + (size_t)key * s.pitch + (((u >> 2) ^ (key & 3)) << 5) + ((u & 3) << 3), (unsigned)__builtin_amdgcn_readfirstlane(ldsbuf + 16384 + pc * 1024)); }
    } else {
        const int key = wid * 8 + (lane >> 3), u = lane & 7;
        glds16(s.k + (size_t)key * s.pitch + ((u ^ ((key >> 1) & 7)) << 3), (unsigned)__builtin_amdgcn_readfirstlane(ldsbuf + wid * 1024));
        glds16(s.v + (size_t)key * s.pitch + (((u >> 2) ^ ((key >> 1) & 1)) << 5) + ((u & 3) << 3), (unsigned)__builtin_amdgcn_readfirstlane(ldsbuf + 8192 + wid * 1024));
    }
}
template <bool DIFF> struct Lay { int koff[4]; int vb[DIFF ? 4 : 2]; };
template <bool DIFF> __device__ __forceinline__ void lay_init(Lay<DIFF>& L, int lane, int map) {
    const int r32 = lane & 31, hi = lane >> 5, q = (lane & 15) >> 2, g1 = (lane >> 4) & 1, pp = lane & 3;
#pragma unroll
    for (int d0 = 0; d0 < 4; ++d0) L.koff[d0] = DIFF ? r32 * 256 + (((8 * map + 2 * d0 + hi) ^ (r32 & 15)) << 4) : r32 * 128 + (((2 * d0 + hi) ^ ((r32 >> 1) & 7)) << 4);
#pragma unroll
    for (int c = 0; c < (DIFF ? 4 : 2); ++c) L.vb[c] = DIFF ? (4 * hi + q) * 256 + ((c ^ q) << 6) + g1 * 32 + pp * 8 : (4 * hi + q) * 128 + ((c ^ ((q >> 1) & 1)) << 6) + g1 * 32 + pp * 8;
}
#define ATT_BAR() asm volatile("s_waitcnt lgkmcnt(0)\n\ts_barrier" ::: "memory")
#define ATT_WAIT_BAR(N) asm volatile("s_waitcnt vmcnt(" #N ") lgkmcnt(0)\n\ts_barrier" ::: "memory")
template <int NC> struct WaveState { f32x16 o[NC]; f32x16 p0, p1; u32x4 pw[4]; float m, l; bf16x8 qr[4]; };
template <bool DIFF> __device__ __forceinline__ void qkt(f32x16& p0, f32x16& p1, LAS const unsigned char* kimg, const Lay<DIFF>& L, const bf16x8 (&qr)[4]) {
#pragma unroll
    for (int r = 0; r < 16; ++r) { p0[r] = 0.f; p1[r] = 0.f; }
#pragma unroll
    for (int d0 = 0; d0 < 4; ++d0) {
        const bf16x8 b0 = *(LAS const bf16x8*)(kimg + L.koff[d0]), b1 = *(LAS const bf16x8*)(kimg + L.koff[d0] + (DIFF ? 8192 : 4096));
        p0 = __builtin_amdgcn_mfma_f32_32x32x16_bf16(b0, qr[d0], p0, 0, 0, 0);
        p1 = __builtin_amdgcn_mfma_f32_32x32x16_bf16(b1, qr[d0], p1, 0, 0, 0);
    }
}
template <bool DIFF, int NC> __device__ __forceinline__ void pv(WaveState<NC>& st, LAS const unsigned char* vimg, const Lay<DIFF>& L) {
    constexpr int SS = DIFF ? 4096 : 2048;
#pragma unroll
    for (int c = 0; c < NC; ++c)
#pragma unroll
        for (int s = 0; s < 4; ++s) {
            const s16x4 lo = vtr(vimg + L.vb[c] + s * SS), hv = vtr(vimg + L.vb[c] + s * SS + SS / 2);
            const bf16x8 vf = {lo[0], lo[1], lo[2], lo[3], hv[0], hv[1], hv[2], hv[3]};
            st.o[c] = __builtin_amdgcn_mfma_f32_32x32x16_bf16(__builtin_bit_cast(bf16x8, st.pw[s]), vf, st.o[c], 0, 0, 0);
        }
}
template <bool DIFF, int NC, bool DO_PV, bool DO_QK> __device__ __forceinline__ void mblock(WaveState<NC>& st, LAS const unsigned char* vimg, LAS const unsigned char* kimg, const Lay<DIFF>& L) {
    if (DO_PV) pv<DIFF, NC>(st, vimg, L);
    if (DO_QK) qkt<DIFF>(st.p0, st.p1, kimg, L, st.qr);
    constexpr int NM = (DO_PV ? NC * 4 : 0) + (DO_QK ? 8 : 0);
    __builtin_amdgcn_sched_group_barrier(0x100, 6, 0);
#pragma unroll
    for (int i = 0; i < NM; ++i) { __builtin_amdgcn_sched_group_barrier(0x008, 1, 0); __builtin_amdgcn_sched_group_barrier(0x100, 2, 0); }
}
template <int NC> __device__ __forceinline__ void softmax_block(WaveState<NC>& st, LAS float* wsf, int r32, int hi) {
    f32x16& p0 = st.p0; f32x16& p1 = st.p1;
    float mx = fmaxf(p0[0], p1[0]);
#pragma unroll
    for (int r = 1; r < 16; ++r) mx = fmaxf(mx, fmaxf(p0[r], p1[r]));
    mx = fmaxf(mx, __shfl_xor(mx, 32));
    if (__any(mx > st.m + THR)) {
        const float mn = fmaxf(st.m, mx), alpha = __builtin_amdgcn_exp2f(st.m - mn);
        st.m = mn; st.l *= alpha;
        if (hi == 0) wsf[r32] = alpha;
#pragma unroll
        for (int r = 0; r < 16; ++r) { const float a = wsf[crow(r, hi)];
#pragma unroll
            for (int c = 0; c < NC; ++c) st.o[c][r] *= a; }
    }
    float rs = 0.f;
#pragma unroll
    for (int r = 0; r < 16; ++r) { p0[r] = __builtin_amdgcn_exp2f(p0[r] - st.m); p1[r] = __builtin_amdgcn_exp2f(p1[r] - st.m); rs += p0[r] + p1[r]; }
    st.l += rs;
#pragma unroll
    for (int i = 0; i < 4; ++i) { st.pw[0][i] = pk2(p0[2 * i], p0[2 * i + 1]); st.pw[1][i] = pk2(p0[8 + 2 * i], p0[9 + 2 * i]); st.pw[2][i] = pk2(p1[2 * i], p1[2 * i + 1]); st.pw[3][i] = pk2(p1[8 + 2 * i], p1[9 + 2 * i]); }
}
template <int NC> __device__ __forceinline__ void state_init(WaveState<NC>& st, const bf16_t* qrow) {
#pragma unroll
    for (int d0 = 0; d0 < 4; ++d0) st.qr[d0] = *(const bf16x8*)(qrow + 16 * d0);
#pragma unroll
    for (int c = 0; c < NC; ++c)
#pragma unroll
        for (int r = 0; r < 16; ++r) st.o[c][r] = 0.f;
#pragma unroll
    for (int s = 0; s < 4; ++s) st.pw[s] = (u32x4){0u, 0u, 0u, 0u};
    st.m = NEGBIG; st.l = 0.f;
}

struct DiffCtx { const bf16_t* qkv; const bf16_t* kvc; int b, h; unsigned lds0; int wid, lane; };
__device__ __forceinline__ TileSrc diff_tile(const DiffCtx& c, int t) {
    if (t < 32) { const bf16_t* base = c.qkv + (size_t)(c.b * SEQ + t * 64) * NQKV; return TileSrc{base + 1024 + 128 * c.h, base + 2048 + 128 * c.h, NQKV}; }
    const bf16_t* base = c.kvc + (size_t)(c.b * CTX + (t - 32) * 64) * NKVC; return TileSrc{base + 128 * c.h, base + 1024 + 128 * c.h, NKVC};
}
__device__ __forceinline__ float max3f(float a, float b, float c) { float r; asm("v_max3_f32 %0, %1, %2, %3" : "=v"(r) : "v"(a), "v"(b), "v"(c)); return r; }
__device__ __forceinline__ float rowmax32(const f32x16& p0, const f32x16& p1) {
    float a = max3f(p0[0], p0[1], p1[0]), b = max3f(p0[2], p0[3], p1[1]); a = max3f(a, p1[2], p1[3]);
#pragma unroll
    for (int r = 4; r < 16; r += 4) { a = max3f(a, p0[r], p0[r + 1]); b = max3f(b, p0[r + 2], p0[r + 3]); a = max3f(a, p1[r], p1[r + 1]); b = max3f(b, p1[r + 2], p1[r + 3]); }
    float m = max3f(a, b, b);
    auto rr = __builtin_amdgcn_permlane32_swap(__float_as_uint(m), __float_as_uint(m), false, false);
    return max3f(__uint_as_float(rr[0]), __uint_as_float(rr[1]), __uint_as_float(rr[1]));
}
__device__ __forceinline__ void exp_pack(const f32x16& s0, const f32x16& s1, const float m, u32x4 (&pw)[4], float& rs_out) {
    float p0[16], p1[16]; float rs = 0.f;
#pragma unroll
    for (int r = 0; r < 16; ++r) { p0[r] = __builtin_amdgcn_exp2f(s0[r] - m); p1[r] = __builtin_amdgcn_exp2f(s1[r] - m); rs += p0[r] + p1[r]; }
    rs_out = rs;
#pragma unroll
    for (int i = 0; i < 4; ++i) { pw[0][i] = pk2(p0[2 * i], p0[2 * i + 1]); pw[1][i] = pk2(p0[8 + 2 * i], p0[9 + 2 * i]); pw[2][i] = pk2(p1[2 * i], p1[2 * i + 1]); pw[3][i] = pk2(p1[8 + 2 * i], p1[9 + 2 * i]); }
}
__device__ __forceinline__ void exp_pack_rel(const f32x16& s0, const f32x16& s1, u32x4 (&pw)[4], float& rs_out) {
    float p0[16], p1[16]; float rs = 0.f;
#pragma unroll
    for (int r = 0; r < 16; ++r) { p0[r] = __builtin_amdgcn_exp2f(s0[r]); p1[r] = __builtin_amdgcn_exp2f(s1[r]); rs += p0[r] + p1[r]; }
    rs_out = rs;
#pragma unroll
    for (int i = 0; i < 4; ++i) { pw[0][i] = pk2(p0[2 * i], p0[2 * i + 1]); pw[1][i] = pk2(p0[8 + 2 * i], p0[9 + 2 * i]); pw[2][i] = pk2(p1[2 * i], p1[2 * i + 1]); pw[3][i] = pk2(p1[8 + 2 * i], p1[9 + 2 * i]); }
}
template <bool DIFF> __device__ __forceinline__ void qkt_from(f32x16& p0, f32x16& p1, const f32x16& init, LAS const unsigned char* kimg, const Lay<DIFF>& L, const bf16x8 (&qr)[4]) {
#pragma unroll
    for (int d0 = 0; d0 < 4; ++d0) {
        const bf16x8 b0 = *(LAS const bf16x8*)(kimg + L.koff[d0]), b1 = *(LAS const bf16x8*)(kimg + L.koff[d0] + (DIFF ? 8192 : 4096));
        p0 = __builtin_amdgcn_mfma_f32_32x32x16_bf16(b0, qr[d0], d0 == 0 ? init : p0, 0, 0, 0);
        p1 = __builtin_amdgcn_mfma_f32_32x32x16_bf16(b1, qr[d0], d0 == 0 ? init : p1, 0, 0, 0);
    }
}
__device__ __forceinline__ void diff_loop3(WaveState<4>& st, f32x16& negm, const DiffCtx& c, LAS unsigned char* lds, LAS float* wsf, const Lay<true>& L, int r32, int hi) {
    constexpr int NT = 36;
    for (int t = 0; t < NT; ++t) {
        if (t + 2 < NT) tile_dma<true>(diff_tile(c, t + 2), c.lds0 + ((t + 2) & 3) * RING_BUF, c.wid, c.lane);
        const int tv = t ? t - 1 : 0, tk = (t + 1 < NT) ? t + 1 : t;
        const float mx = rowmax32(st.p0, st.p1);
        const bool need = __any(mx > THR) || t == 0;
        float alpha = 1.f;
        if (need) {
            const float dm = (t == 0) ? mx : fmaxf(mx, 0.f);
            alpha = (t == 0) ? 0.f : __builtin_amdgcn_exp2f(-dm);
            st.m += dm;
#pragma unroll
            for (int r = 0; r < 16; ++r) { st.p0[r] -= dm; st.p1[r] -= dm; negm[r] = -st.m; }
        }
        u32x4 pwn[4]; float rs; f32x16 n0, n1;
        exp_pack_rel(st.p0, st.p1, pwn, rs);
        pv<true, 4>(st, lds + (tv & 3) * RING_BUF + 16384, L);
        qkt_from<true>(n0, n1, negm, lds + (tk & 3) * RING_BUF, L, st.qr);
        __builtin_amdgcn_sched_group_barrier(0x100, 6, 0);
#pragma unroll
        for (int i = 0; i < 24; ++i) { __builtin_amdgcn_sched_group_barrier(0x008, 1, 0); __builtin_amdgcn_sched_group_barrier(0x100, 2, 0); __builtin_amdgcn_sched_group_barrier(0x402, 4, 0); }
        asm volatile("" : "+v"(pwn[0]), "+v"(pwn[1]), "+v"(pwn[2]), "+v"(pwn[3]), "+v"(rs));
        if (need) {
            if (hi == 0) wsf[r32] = alpha;
#pragma unroll
            for (int r = 0; r < 16; ++r) { const float a = wsf[crow(r, hi)];
#pragma unroll
                for (int cc = 0; cc < 4; ++cc) st.o[cc][r] *= a; }
            st.l *= alpha;
        }
        st.l += rs;
#pragma unroll
        for (int s = 0; s < 4; ++s) st.pw[s] = pwn[s];
        st.p0 = n0; st.p1 = n1;
        ATT_WAIT_BAR(0);
    }
    pv<true, 4>(st, lds + ((NT - 1) & 3) * RING_BUF + 16384, L);
    ATT_WAIT_BAR(0);
}
__device__ __forceinline__ void diff_unit(const Params& p, LAS unsigned char* lds, const int tid_in, int b, int h, int qb, float lam, const int var) {
    int tid = tid_in; asm volatile("" : "+v"(tid));
    const int lane = tid & 63, r32 = lane & 31, hi = lane >> 5, wid = __builtin_amdgcn_readfirstlane(tid >> 6), rg = wid & 3, map = wid >> 2;
    const bf16_t* qkv = (const bf16_t*)(p.ws + WS_QKV); bf16_t* mix = (bf16_t*)(p.ws + ((var & 8) ? WS_A2 : WS_MIX));
    LAS float* wsf = (LAS float*)(lds + OFF_WSF) + wid * 64;
    Lay<true> L; lay_init<true>(L, lane, map);
    const DiffCtx c{qkv, (const bf16_t*)(p.ws + WS_KVC), b, h, (unsigned)(uintptr_t)lds, wid, lane};
    if (!(var & 4)) { tile_dma<true>(diff_tile(c, 0), c.lds0, wid, lane); tile_dma<true>(diff_tile(c, 1), c.lds0 + RING_BUF, wid, lane); }
    WaveState<4> st;
    state_init<4>(st, qkv + (size_t)(b * SEQ + qb * 128 + rg * 32 + r32) * NQKV + 128 * h + 64 * map + 8 * hi);
    ATT_WAIT_BAR(0);
    f32x16 negm;
#pragma unroll
    for (int r = 0; r < 16; ++r) negm[r] = 0.f;
    st.m = 0.f;
    qkt<true>(st.p0, st.p1, lds, L, st.qr);
    diff_loop3(st, negm, c, lds, wsf, L, r32, hi);
    {   int tid2 = tid; asm volatile("" : "+v"(tid2));
        const int lane2 = tid2 & 63, r32b = lane2 & 31, hib = lane2 >> 5;
        float lt = st.l + __shfl_xor(st.l, 32);
        if (hib == 0) wsf[r32b] = 1.0f / lt;
        LAS float* stg = (LAS float*)(lds + OFF_STAGE);
#pragma unroll
        for (int r = 0; r < 16; ++r) { const float inv = wsf[crow(r, hib)]; const int R = map * 128 + rg * 32 + crow(r, hib);
#pragma unroll
            for (int cc = 0; cc < 4; ++cc) stg[R * 132 + 32 * cc + r32b] = st.o[cc][r] * inv; }
        __syncthreads();
        const int row = tid2 >> 2, part = tid2 & 3;
        float o[32]; float ss = 0.f;
#pragma unroll
        for (int i = 0; i < 8; ++i) { const f32x4 a = *(LAS const f32x4*)(stg + row * 132 + part * 32 + 4 * i), bb = *(LAS const f32x4*)(stg + (128 + row) * 132 + part * 32 + 4 * i);
#pragma unroll
            for (int e = 0; e < 4; ++e) { const float v = a[e] - lam * bb[e]; o[4 * i + e] = v; ss += v * v; } }
        ss += __shfl_xor(ss, 1); ss += __shfl_xor(ss, 2);
        const float rstd = rsqrtf(ss * (1.0f / 128.0f) + EPS) * (1.0f - LAM_INIT);
        bf16_t* dst = mix + (size_t)(b * SEQ + qb * 128 + row) * DM + 128 * h + part * 32;
#pragma unroll
        for (int i = 0; i < 4; ++i) { const f32x4 g0 = *(const f32x4*)(p.subln_g + part * 32 + 8 * i), g1 = *(const f32x4*)(p.subln_g + part * 32 + 8 * i + 4);
            u32x4 w; w.x = pk2(o[8 * i] * rstd * g0.x, o[8 * i + 1] * rstd * g0.y); w.y = pk2(o[8 * i + 2] * rstd * g0.z, o[8 * i + 3] * rstd * g0.w);
            w.z = pk2(o[8 * i + 4] * rstd * g1.x, o[8 * i + 5] * rstd * g1.y); w.w = pk2(o[8 * i + 6] * rstd * g1.z, o[8 * i + 7] * rstd * g1.w);
            *(u32x4*)(dst + 8 * i) = w; }
        asm volatile("s_waitcnt vmcnt(0)" ::: "memory");
        __syncthreads();
    }
}
constexpr int NA_SLOT = 16384;
constexpr float MASKV = -3.0e38f;
struct NaCtx { const bf16_t* qkv; const bf16_t* kvc; int b, hh, lo0, nrows; unsigned lds0; int wid, lane; };
__device__ __forceinline__ TileSrc na_tile(const NaCtx& c, int i) {
    if (i < c.nrows) { const bf16_t* base = c.qkv + (size_t)(c.b * SEQ + (c.lo0 + i) * 64) * NQKV; return TileSrc{base + 1536 + 64 * c.hh, base + 2560 + 64 * c.hh, NQKV}; }
    const bf16_t* base = c.kvc + (size_t)(c.b * CTX + (i - c.nrows) * 64) * NKVC; return TileSrc{base + 512 + 64 * c.hh, base + 1536 + 64 * c.hh, NKVC};
}
struct NaState { f32x16 o[2]; f32x16 s0, s1; u32x4 pw[4]; float m, l; bf16x8 qr[4]; };
template <int NK> __device__ __forceinline__ void na_pv(NaState& st, LAS const unsigned char* vimg, const int (&vb)[2]) {
#pragma unroll
    for (int cc = 0; cc < 2; ++cc)
#pragma unroll
        for (int s = 0; s < NK; ++s) {
            const s16x4 lo = vtr(vimg + vb[cc] + s * 2048), hv = vtr(vimg + vb[cc] + s * 2048 + 1024);
            const bf16x8 vf = {lo[0], lo[1], lo[2], lo[3], hv[0], hv[1], hv[2], hv[3]};
            st.o[cc] = __builtin_amdgcn_mfma_f32_32x32x16_bf16(__builtin_bit_cast(bf16x8, st.pw[s]), vf, st.o[cc], 0, 0, 0);
        }
}
template <bool TWO> __device__ __forceinline__ void na_qk(f32x16& n0, f32x16& n1, LAS const unsigned char* kimg, const int (&koff)[4], const bf16x8 (&qr)[4]) {
#pragma unroll
    for (int r = 0; r < 16; ++r) { n0[r] = 0.f; if (TWO) n1[r] = 0.f; }
#pragma unroll
    for (int d0 = 0; d0 < 4; ++d0) {
        n0 = __builtin_amdgcn_mfma_f32_32x32x16_bf16(*(LAS const bf16x8*)(kimg + koff[d0]), qr[d0], n0, 0, 0, 0);
        if (TWO) n1 = __builtin_amdgcn_mfma_f32_32x32x16_bf16(*(LAS const bf16x8*)(kimg + koff[d0] + 4096), qr[d0], n1, 0, 0, 0);
    }
}
__device__ __forceinline__ void na_rescale(NaState& st, LAS float* wsf, float alpha, float m_use, int r32, int hi) {
    if (hi == 0) wsf[r32] = alpha;
#pragma unroll
    for (int r = 0; r < 16; ++r) { const float a = wsf[crow(r, hi)]; st.o[0][r] *= a; st.o[1][r] *= a; }
    st.l *= alpha; st.m = m_use;
}
__device__ __forceinline__ void na_unit(const Params& p, LAS unsigned char* lds, const int tid_in, int b, int hh, int rg4) {
    int tid = tid_in; asm volatile("" : "+v"(tid));
    const int lane = tid & 63, r32 = lane & 31, hi = lane >> 5, wid = __builtin_amdgcn_readfirstlane(tid >> 6), pr = wid >> 2, cb = wid & 3;
    const bf16_t* qkv = (const bf16_t*)(p.ws + WS_QKV); bf16_t* mix = (bf16_t*)(p.ws + WS_MIX);
    LAS float* wsf = (LAS float*)(lds + OFF_WSF) + wid * 64;
    LAS float* rpbL = (LAS float*)(lds + OFF_RPB);
    const int r0 = 4 * rg4;
    const int lo0 = min(max(r0 - 4, 0), 24), hi0 = min(max(r0 - 3, 0), 24) + 7, lo1 = min(max(r0 - 2, 0), 24), hi1 = min(max(r0 - 1, 0), 24) + 7;
    const int d = lo1 - lo0, nrows = hi1 - lo0 + 1, n0c = hi0 - lo0 + 1, n1c = hi1 - lo1 + 1, S_lat = max(n0c, n1c), ntiles = nrows + 4;
    const int off = pr ? d : 0, np = pr ? n1c : n0c;
    const NaCtx c{qkv, (const bf16_t*)(p.ws + WS_KVC), b, hh, lo0, nrows, (unsigned)(uintptr_t)lds, wid, lane};
    for (int i = 0; i < d + 3; ++i) tile_dma<false>(na_tile(c, i), c.lds0 + (i & 7) * NA_SLOT, wid, lane);
    if (tid < 465) rpbL[tid] = p.rpb[hh * 465 + tid] * LOG2E;
    const int qrow = r0 + 2 * pr + (r32 >> 4), jq = 16 * cb + (r32 & 15), kc0 = (cb == 0) ? 0 : (cb == 1) ? 8 : (cb == 2) ? 24 : 32;
    const int qstart = min(max(qrow - 4, 0), 24), cs = min(max(jq - 8, 0), 48);
    NaState st;
#pragma unroll
    for (int d0 = 0; d0 < 4; ++d0) st.qr[d0] = *(const bf16x8*)(qkv + (size_t)(b * SEQ + qrow * 64 + jq) * NQKV + 512 + 64 * hh + 8 * hi + 16 * d0);
#pragma unroll
    for (int r = 0; r < 16; ++r) { st.o[0][r] = 0.f; st.o[1][r] = 0.f; }
#pragma unroll
    for (int s = 0; s < 4; ++s) st.pw[s] = (u32x4){0u, 0u, 0u, 0u};
    st.m = NEGBIG; st.l = 0.f;
    unsigned cmask = 0u;
#pragma unroll
    for (int r = 0; r < 16; ++r) { const int jk = kc0 + crow(r, hi); if (jk >= cs && jk < cs + 16) cmask |= 1u << r; }
    int koffL[4], koffC[4], vbL[2], vbC[2];
    {   const int q = (lane & 15) >> 2, g1 = (lane >> 4) & 1, pp = lane & 3, keyL = kc0 + r32;
#pragma unroll
        for (int d0 = 0; d0 < 4; ++d0) { koffL[d0] = keyL * 128 + (((2 * d0 + hi) ^ ((keyL >> 1) & 7)) << 4); koffC[d0] = r32 * 128 + (((2 * d0 + hi) ^ ((r32 >> 1) & 7)) << 4); }
#pragma unroll
        for (int cc = 0; cc < 2; ++cc) { vbC[cc] = (4 * hi + q) * 128 + ((cc ^ ((q >> 1) & 1)) << 6) + g1 * 32 + pp * 8; vbL[cc] = vbC[cc] + kc0 * 128; } }
    const int bias_base = 15 - jq + kc0 + 4 * hi;
    asm volatile("s_waitcnt vmcnt(2) lgkmcnt(0)\n\ts_barrier" ::: "memory");
    na_qk<false>(st.s0, st.s1, lds + (off & 7) * NA_SLOT, koffL, st.qr);
    for (int s = 0; s < S_lat; ++s) {
        if (s + d + 3 < ntiles) tile_dma<false>(na_tile(c, s + d + 3), c.lds0 + ((s + d + 3) & 7) * NA_SLOT, wid, lane);
        const bool live = s < np;
        const int ic = off + (live ? s : np - 1), ipv = off + (s ? min(s, np) - 1 : 0), inx = off + min(s + 1, np - 1);
        const int kr = lo0 + ic;
        {   const bool rowok = live && kr >= qstart && kr < qstart + 8;
            LAS const float* bp = rpbL + (kr - qrow + 7) * 31 + bias_base;
#pragma unroll
            for (int r = 0; r < 16; ++r) { const float bv = bp[(r & 3) + 8 * (r >> 2)]; st.s0[r] = (rowok && ((cmask >> r) & 1u)) ? st.s0[r] + bv : MASKV; } }
        float mx = max3f(st.s0[0], st.s0[1], st.s0[2]);
#pragma unroll
        for (int r = 3; r < 15; r += 2) mx = max3f(mx, st.s0[r], st.s0[r + 1]);
        mx = max3f(mx, st.s0[15], st.s0[15]);
        { auto rr = __builtin_amdgcn_permlane32_swap(__float_as_uint(mx), __float_as_uint(mx), false, false); mx = max3f(__uint_as_float(rr[0]), __uint_as_float(rr[1]), __uint_as_float(rr[1])); }
        const bool need = __any(mx > st.m + THR);
        const float m_use = need ? fmaxf(st.m, mx) : st.m, alpha = __builtin_amdgcn_exp2f(st.m - m_use);
        u32x4 pwn[2]; float rs = 0.f;
        {   float e[16];
#pragma unroll
            for (int r = 0; r < 16; ++r) { e[r] = __builtin_amdgcn_exp2f(st.s0[r] - m_use); rs += e[r]; }
#pragma unroll
            for (int i = 0; i < 4; ++i) { pwn[0][i] = pk2(e[2 * i], e[2 * i + 1]); pwn[1][i] = pk2(e[8 + 2 * i], e[9 + 2 * i]); } }
        f32x16 n0, n1;
        na_pv<2>(st, lds + (ipv & 7) * NA_SLOT + 8192, vbL);
        na_qk<false>(n0, n1, lds + (inx & 7) * NA_SLOT, koffL, st.qr);
        __builtin_amdgcn_sched_group_barrier(0x100, 4, 0);
#pragma unroll
        for (int i = 0; i < 8; ++i) { __builtin_amdgcn_sched_group_barrier(0x008, 1, 0); __builtin_amdgcn_sched_group_barrier(0x100, 2, 0); __builtin_amdgcn_sched_group_barrier(0x402, 12, 0); }
        asm volatile("" : "+v"(pwn[0]), "+v"(pwn[1]), "+v"(rs));
        if (need) na_rescale(st, wsf, alpha, m_use, r32, hi);
        st.l += rs; st.pw[0] = pwn[0]; st.pw[1] = pwn[1]; st.s0 = n0;
        if (s + d + 3 < ntiles) asm volatile("s_waitcnt vmcnt(2) lgkmcnt(0)\n\ts_barrier" ::: "memory");
        else asm volatile("s_waitcnt vmcnt(0) lgkmcnt(0)\n\ts_barrier" ::: "memory");
    }
    na_pv<2>(st, lds + ((off + np - 1) & 7) * NA_SLOT + 8192, vbL);
    na_qk<true>(st.s0, st.s1, lds + (nrows & 7) * NA_SLOT, koffC, st.qr);
#pragma unroll
    for (int s = 0; s < 4; ++s) st.pw[s] = (u32x4){0u, 0u, 0u, 0u};
    for (int cs4 = 0; cs4 < 4; ++cs4) {
        const int gs = S_lat + cs4;
        if (gs + d + 3 < ntiles) tile_dma<false>(na_tile(c, gs + d + 3), c.lds0 + ((gs + d + 3) & 7) * NA_SLOT, wid, lane);
        const int ipv = nrows + (cs4 ? cs4 - 1 : 0), inx = nrows + min(cs4 + 1, 3);
        const float mx = rowmax32(st.s0, st.s1);
        const bool need = __any(mx > st.m + THR);
        const float m_use = need ? fmaxf(st.m, mx) : st.m, alpha = __builtin_amdgcn_exp2f(st.m - m_use);
        u32x4 pwn[4]; float rs; f32x16 n0, n1;
        exp_pack(st.s0, st.s1, m_use, pwn, rs);
        na_pv<4>(st, lds + (ipv & 7) * NA_SLOT + 8192, vbC);
        na_qk<true>(n0, n1, lds + (inx & 7) * NA_SLOT, koffC, st.qr);
        __builtin_amdgcn_sched_group_barrier(0x100, 6, 0);
#pragma unroll
        for (int i = 0; i < 16; ++i) { __builtin_amdgcn_sched_group_barrier(0x008, 1, 0); __builtin_amdgcn_sched_group_barrier(0x100, 2, 0); __builtin_amdgcn_sched_group_barrier(0x402, 8, 0); }
        asm volatile("" : "+v"(pwn[0]), "+v"(pwn[1]), "+v"(pwn[2]), "+v"(pwn[3]), "+v"(rs));
        if (need) na_rescale(st, wsf, alpha, m_use, r32, hi);
        st.l += rs;
#pragma unroll
        for (int s = 0; s < 4; ++s) st.pw[s] = pwn[s];
        st.s0 = n0; st.s1 = n1;
        if (gs + d + 3 < ntiles) asm volatile("s_waitcnt vmcnt(2) lgkmcnt(0)\n\ts_barrier" ::: "memory");
        else asm volatile("s_waitcnt vmcnt(0) lgkmcnt(0)\n\ts_barrier" ::: "memory");
    }
    na_pv<4>(st, lds + ((nrows + 3) & 7) * NA_SLOT + 8192, vbC);
    asm volatile("s_waitcnt vmcnt(0) lgkmcnt(0)\n\ts_barrier" ::: "memory");
    {   int tid2 = tid; asm volatile("" : "+v"(tid2));
        const int lane2 = tid2 & 63, r32b = lane2 & 31, hib = lane2 >> 5;
        float lt = st.l + __shfl_xor(st.l, 32);
        if (hib == 0) wsf[r32b] = 1.0f / lt;
        LAS float* stg = (LAS float*)(lds + OFF_STAGE) + wid * (32 * 68);
#pragma unroll
        for (int r = 0; r < 16; ++r) { const float inv = wsf[crow(r, hib)];
#pragma unroll
            for (int cc = 0; cc < 2; ++cc) stg[crow(r, hib) * 68 + 32 * cc + r32b] = st.o[cc][r] * inv; }
        const int row = lane2 >> 1, half = lane2 & 1;
        bf16_t* dst = mix + (size_t)(b * SEQ + (r0 + 2 * pr + (row >> 4)) * 64 + 16 * cb + (row & 15)) * DM + 512 + 64 * hh + half * 32;
#pragma unroll
        for (int i = 0; i < 4; ++i) { const f32x4 a = *(LAS const f32x4*)(stg + row * 68 + half * 32 + 8 * i), c4 = *(LAS const f32x4*)(stg + row * 68 + half * 32 + 8 * i + 4);
            u32x4 w; w.x = pk2(a.x, a.y); w.y = pk2(a.z, a.w); w.z = pk2(c4.x, c4.y); w.w = pk2(c4.z, c4.w);
            *(u32x4*)(dst + 8 * i) = w; }
        asm volatile("s_waitcnt vmcnt(0)" ::: "memory");
        __syncthreads();
    }
}
}
__device__ __forceinline__ void phase_attn(const Params& p, LAS unsigned char* lds, const int which = 3, const int var = 0) {
    const int G = (int)gridDim.x, bx = (int)blockIdx.x, vcu = (G % 8 == 0) ? (bx % 8) * (G / 8) + bx / 8 : bx;
    const float lam = *(const float*)(p.ws + WS_LAM);
    const int tid = opaque_tid();
    if (which & 1) for (int u = vcu; u < 2048; u += G) att::diff_unit(p, lds, tid, u >> 6, (u >> 4) & 3, u & 15, lam, var);
    if (which & 2) for (int u = vcu; u < 2048; u += G) att::na_unit(p, lds, tid, u >> 6, (u >> 3) & 7, u & 7);
}

__device__ __forceinline__ void phase_final(const Params& p, int gw, int NGW, int lane) {
    const float* ssq2 = (const float*)(p.ws + WS_SSQ2);
    for (int row = gw; row < MLAT; row += NGW) {
        const float sv = (lane < 16) ? ssq2[(size_t)row * 16 + lane] : 0.f;
        const float rstd = rsqrtf(wave_sum(sv) * (1.0f / DM) + EPS);
        float* o = p.out + (size_t)row * DM;
#pragma unroll
        for (int j = 0; j < 4; ++j) { const int col = 4 * lane + 256 * j; const f32x4 v = *(const f32x4*)(o + col), g = *(const f32x4*)(p.final_g + col); __builtin_nontemporal_store(v * rstd * g, (f32x4*)(o + col)); }
    }
}

#ifndef PHASE_MASK
#define PHASE_MASK 255
#endif
#ifndef ATT_VAR
#define ATT_VAR 0
#endif
#ifndef REPEAT_MASK
#define REPEAT_MASK 0
#endif
constexpr int LDS_MISC = 163840 - 64;
constexpr int CW_BAR = 4096;
#define RLX_AGENT __ATOMIC_RELAXED, __HIP_MEMORY_SCOPE_AGENT
#define XB_TMO      128
#define XB_XCNT(j)  (256  + 64 * (j))
#define XB_XSUB(j)  (1280 + 64 * (j))
#define XB_XGEN(j)  (2304 + 64 * (j))
#define XB_TOP      3328
#define XB_TOPGEN   3392
#define XCD_BAR_WORDS 3456
#define XB_SPIN_CAP (1u << 18)

__device__ __forceinline__ unsigned xb_ld(unsigned* p)              { return __hip_atomic_load(p, __ATOMIC_RELAXED, __HIP_MEMORY_SCOPE_AGENT); }
__device__ __forceinline__ unsigned xb_add(unsigned* p, unsigned v) { return __hip_atomic_fetch_add(p, v, __ATOMIC_RELAXED, __HIP_MEMORY_SCOPE_AGENT); }
__device__ __forceinline__ unsigned xb_xcc_id() { return (unsigned)__builtin_amdgcn_s_getreg((3 << 11) | 20) & 0xFu; }
#define XB_SPIN(cond, bar) do { unsigned _sp = 0; while (cond) { __builtin_amdgcn_s_sleep(1); \
    if ((++_sp & 255u) == 0u) { if (xb_ld(&(bar)[XB_TMO])) break; if (_sp > XB_SPIN_CAP) { atomicAdd(&(bar)[XB_TMO], 1u); break; } } } } while (0)

struct XcdBarrier {
    unsigned* bar; unsigned x;
    volatile LAS unsigned* st;
};

__device__ __forceinline__ XcdBarrier xcd_barrier_post(unsigned* bar, volatile LAS unsigned* st) {
    XcdBarrier b; b.bar = bar; b.x = xb_xcc_id(); b.st = st;
    if (threadIdx.x == 0) (void)xb_add(&bar[XB_XCNT(b.x)], 1u);
    return b;
}
__device__ __forceinline__ void xcd_barrier_complete(unsigned* bar, unsigned x, unsigned& nloc, unsigned& nx) {
    const unsigned G = gridDim.x * gridDim.y * gridDim.z;
    unsigned sum, cnt, mine, sp = 0u;
    for (;;) {
        sum = 0u; cnt = 0u; mine = 0u;
#pragma unroll
        for (unsigned j = 0; j < 16; ++j) { const unsigned c = xb_ld(&bar[XB_XCNT(j)]); sum += c; cnt += (c > 0u) ? 1u : 0u; mine = (j == x) ? c : mine; }
        if (sum == G) break;
        __builtin_amdgcn_s_sleep(1);
        if ((++sp & 255u) == 0u) { if (xb_ld(&bar[XB_TMO])) break; if (sp > XB_SPIN_CAP) { atomicAdd(&bar[XB_TMO], 1u); break; } }
    }
    nloc = mine > 0u ? mine : 1u; nx = cnt > 0u ? cnt : 1u;
}

__device__ __forceinline__ void xcd_barrier(const XcdBarrier& b) {
    asm volatile("s_waitcnt vmcnt(0)" ::: "memory");
    __syncthreads();
    if (threadIdx.x == 0) {
        unsigned* bar = b.bar;
        __builtin_amdgcn_s_waitcnt(0);
        unsigned nloc = b.st[0], nx = b.st[1];
        if (nloc == 0u) { xcd_barrier_complete(bar, b.x, nloc, nx); b.st[0] = nloc; b.st[1] = nx; }
        const unsigned old = xb_add(&bar[XB_XSUB(b.x)], 1u);
        const unsigned gen = old / nloc;
        if (old + 1u == (gen + 1u) * nloc) {
            __builtin_amdgcn_fence(__ATOMIC_RELEASE, "agent");
            asm volatile("s_waitcnt vmcnt(0)" ::: "memory");
            const unsigned og = xb_add(&bar[XB_TOP], 1u);
            const unsigned tg = og / nx;
            if (og + 1u == (tg + 1u) * nx) xb_add(&bar[XB_TOPGEN], 1u);
            else XB_SPIN(xb_ld(&bar[XB_TOPGEN]) == tg, bar);
            __builtin_amdgcn_fence(__ATOMIC_ACQUIRE, "agent");
            xb_add(&bar[XB_XGEN(b.x)], 1u);
            asm volatile("s_waitcnt vmcnt(0)" ::: "memory");
        } else {
            XB_SPIN(xb_ld(&bar[XB_XGEN(b.x)]) == gen, bar);
            __builtin_amdgcn_fence(__ATOMIC_ACQUIRE, "agent");
            asm volatile("s_waitcnt vmcnt(0)" ::: "memory");
        }
    }
    __syncthreads();
}

typedef const Params __attribute__((address_space(4))) CParams;
__device__ __forceinline__ Params kparams() {
#if defined(__HIP_DEVICE_COMPILE__)
    CParams* k = (CParams*)__builtin_amdgcn_kernarg_segment_ptr(); asm volatile("" : "+s"(k)); return *k;
#else
    return Params{};
#endif
}
#define PH_IDS const int tid_ = opaque_tid(), wid = tid_ >> 6, lane = tid_ & 63, gw = blockIdx.x * 8 + wid, NGW = gridDim.x * 8
__global__ __launch_bounds__(512, 2) void k_mega(Params p_unused) {
    extern __shared__ __attribute__((aligned(16))) unsigned char lds[];
    volatile LAS unsigned* MISC = (volatile LAS unsigned*)((LAS unsigned char*)lds + LDS_MISC);
    if (threadIdx.x < 16) MISC[threadIdx.x] = 0u;
    __syncthreads();
    XcdBarrier bar;
    { const Params p = kparams(); bar = xcd_barrier_post((unsigned*)(p.ws + WS_CTL) + CW_BAR, MISC); }
#define SEAM() xcd_barrier(bar)
#define RUN(k, call) do { if (PHASE_MASK & (1 << (k))) { call; } if (REPEAT_MASK & (1 << (k))) { SEAM(); call; } } while (0)
    RUN(0, { const Params p = kparams(); PH_IDS; phase_prep_a(p, (float*)lds + wid * 2112, gw, NGW, lane); });
    SEAM();
    RUN(1, { const Params p = kparams(); PH_IDS; phase_prep_b(p, (float*)lds + wid * 2112, gw, NGW, lane); });
    SEAM();
    RUN(2, { const Params p = kparams(); phase_qkv(p, (LAS unsigned char*)lds); });
    SEAM();
    RUN(3, { const Params p = kparams(); phase_attn(p, (LAS unsigned char*)lds); });
    if (REPEAT_MASK & 256) { SEAM(); const Params p = kparams(); phase_attn(p, (LAS unsigned char*)lds, 1, ATT_VAR); }
    if (REPEAT_MASK & 512) { SEAM(); const Params p = kparams(); phase_attn(p, (LAS unsigned char*)lds, 2); }
    SEAM();
    RUN(4, { const Params p = kparams(); phase_outproj(p, (LAS unsigned char*)lds); });
    SEAM();
    if (PHASE_MASK & 32) { const Params p = kparams(); phase_rstd1(p); }
    SEAM();
    RUN(5, { const Params p = kparams(); phase_fc1(p, (LAS unsigned char*)lds); });
    if (REPEAT_MASK & 1024) { SEAM(); const Params p = kparams(); phase_fc1_noepi(p, (LAS unsigned char*)lds); }
    SEAM();
    RUN(6, { const Params p = kparams(); phase_fc2(p, (LAS unsigned char*)lds); });
    SEAM();
    RUN(7, { const Params p = kparams(); PH_IDS; phase_final(p, gw, NGW, lane); });
}

extern "C" void kernel_launch(void* const* d_in, const int* in_sizes, int n_in, void* d_out, int out_size, void* d_ws, size_t ws_size, hipStream_t stream) {
    if (n_in != 19 || in_sizes[0] != MLAT * DM || out_size != MLAT * DM || ws_size < WS_END) {
        fprintf(stderr, "kernel_launch: unexpected shapes: n_in %d in0 %d out %d ws %zu (need %zu)\n", n_in, n_in > 0 ? in_sizes[0] : -1, out_size, ws_size, (size_t)WS_END);
        return;
    }
    Params p{};
    const float** pf = (const float**)&p;
    for (int i = 0; i < 19; ++i) pf[i] = (const float*)d_in[i];
    p.out = (float*)d_out; p.ws = (unsigned char*)d_ws;
    unsigned char* ws = p.ws;
    static int grid_blocks = 0;
    if (grid_blocks == 0) {
        int dev = 0, cus = 0, per_cu = 0;
        (void)hipGetDevice(&dev);
        (void)hipDeviceGetAttribute(&cus, hipDeviceAttributeMultiprocessorCount, dev);
        (void)hipFuncSetAttribute((const void*)k_mega, hipFuncAttributeMaxDynamicSharedMemorySize, LDS_BYTES);
        (void)hipOccupancyMaxActiveBlocksPerMultiprocessor(&per_cu, (const void*)k_mega, 512, LDS_BYTES);
        if (per_cu < 1) { fprintf(stderr, "kernel_launch: occupancy query reports %d blocks per CU\n", per_cu); per_cu = 1; }
        grid_blocks = cus;
        (void)hipGetLastError();
    }
    (void)hipMemsetAsync(ws, 0, WS_ZERO_BYTES, stream);
    void* args[] = {&p};
    hipError_t e = hipLaunchCooperativeKernel((const void*)k_mega, dim3(grid_blocks), dim3(512), args, LDS_BYTES, stream);
    if (e != hipSuccess) fprintf(stderr, "kernel_launch: cooperative launch failed: %s (grid %d)\n", hipGetErrorString(e), grid_blocks);
}
```

```cpp
#include <hip/hip_runtime.h>
#include <cstdio>
#include <cstdint>

typedef unsigned short bf16_t;
typedef float f32x4 __attribute__((ext_vector_type(4)));
typedef float f32x2 __attribute__((ext_vector_type(2)));
typedef unsigned u32x4 __attribute__((ext_vector_type(4)));
typedef unsigned u32x2 __attribute__((ext_vector_type(2)));
typedef __bf16 bf16x2_t __attribute__((ext_vector_type(2)));

constexpr int NB = 32, SEQ = 2048, DM = 1024, CTX = 256, FF = 4096, NQKV = 3072, NKVC = 2048;
constexpr int MLAT = NB * SEQ, MCTX = NB * CTX, MALL = MLAT + MCTX;
constexpr int MODN = 6 * DM;
constexpr float EPS = 1e-6f;
constexpr float LOG2E = 1.4426950408889634f;
constexpr float C2 = 0.125f * LOG2E;
constexpr float LAM_INIT = 0.2f;
constexpr float NEGBIG = -1e30f;

constexpr size_t MiB = 1u << 20;
constexpr size_t WS_CTL = 0;
constexpr size_t WS_MOD = 1 * MiB;
constexpr size_t WS_BIAS1 = 2 * MiB;
constexpr size_t WS_ROPE = 3 * MiB;
constexpr size_t WS_LAM = 3 * MiB + 65536;
constexpr size_t WS_ZERO_BYTES = 3 * MiB;
constexpr size_t WS_SSQ1 = 4 * MiB;
constexpr size_t WS_SSQ2 = 8 * MiB;
constexpr size_t WS_RSTD1 = 3 * MiB + 131072;
constexpr size_t WS_WIN = 12 * MiB;
constexpr size_t WS_WOUT = 18 * MiB;
constexpr size_t WS_W1 = 20 * MiB;
constexpr size_t WS_W2 = 28 * MiB;
constexpr size_t WS_KVC = 36 * MiB;
constexpr size_t WS_A2 = 84 * MiB;
constexpr size_t WS_MIX = 212 * MiB;
constexpr size_t WS_A1 = 340 * MiB;
constexpr size_t WS_QKV = 484 * MiB;
constexpr size_t WS_HID = 340 * MiB;
constexpr size_t WS_END = 868 * MiB;

struct Params {
    const float *x, *c, *ctx, *c_ctx, *w_mod, *b_mod, *norm1_g, *w_in, *lam_q1, *lam_k1, *lam_q2, *lam_k2, *subln_g, *rpb, *w_out, *norm2_g, *w_fc1, *w_fc2, *final_g;
    float* out; unsigned char* ws;
};

__device__ __forceinline__ unsigned pk2(float lo, float hi) { f32x2 v = {lo, hi}; bf16x2_t b = __builtin_convertvector(v, bf16x2_t); return __builtin_bit_cast(unsigned, b); }
__device__ __forceinline__ float bf_lo(unsigned w) { return __uint_as_float(w << 16); }
__device__ __forceinline__ float bf_hi(unsigned w) { return __uint_as_float(w & 0xffff0000u); }
__device__ __forceinline__ float bf2f(bf16_t v) { return __uint_as_float(((unsigned)v) << 16); }
__device__ __forceinline__ float wave_sum(float v) {
#pragma unroll
    for (int o = 1; o < 64; o <<= 1) v += __shfl_xor(v, o);
    return v;
}
__device__ __forceinline__ float wave_max(float v) {
#pragma unroll
    for (int o = 1; o < 64; o <<= 1) v = fmaxf(v, __shfl_xor(v, o));
    return v;
}
__host__ __device__ __forceinline__ int win_src_col(int n) {
    const bool perm = (n < 512) || (n >= 1024 && n < 1536);
    if (!perm) return n;
    const int nd = n & 63, base = n - nd, i = nd >> 1, par = nd & 1;
    const int old = (i < 16 ? i : 32 + (i - 16)) + 16 * par;
    return base + old;
}

template <bool PERMW>
__device__ __forceinline__ void transpose_item(const float* __restrict__ W, int K, int N, bf16_t* __restrict__ WT, float* scr, int item, int lane) {
    const int nblk = N / 32, kb = item / nblk, nb = item % nblk, k0 = 64 * kb, n0 = 32 * nb;
    const int nsrc = PERMW ? win_src_col(n0 + (lane & 31)) : (n0 + (lane & 31));
#pragma unroll 8
    for (int i = 0; i < 32; ++i) { const int kk = 2 * i + (lane >> 5); scr[kk * 33 + (lane & 31)] = W[(size_t)(k0 + kk) * N + nsrc]; }
    __builtin_amdgcn_s_waitcnt(0xC07F); asm volatile("" ::: "memory");
    const int c = lane & 7;
#pragma unroll
    for (int j = 0; j < 4; ++j) { const int n = (lane >> 3) + 8 * j; const float* s = scr + (8 * c) * 33 + n;
        u32x4 o; o.x = pk2(s[0 * 33], s[1 * 33]); o.y = pk2(s[2 * 33], s[3 * 33]); o.z = pk2(s[4 * 33], s[5 * 33]); o.w = pk2(s[6 * 33], s[7 * 33]);
        *(u32x4*)(WT + (size_t)(n0 + n) * K + k0 + 8 * c) = o; }
    __builtin_amdgcn_s_waitcnt(0xC07F); asm volatile("" ::: "memory");
}
template <int NR, bool SILU>
__device__ __forceinline__ void small_mm_task(const float* __restrict__ src, size_t src_stride, const float* __restrict__ last_row, const float* __restrict__ W, int N,
                                              int k0, int n0, float* out, size_t out_stride, const float* __restrict__ bias, float* scr, int lane) {
#pragma unroll
    for (int r = 0; r < NR; ++r) {
        const float* sr = (last_row && r == NR - 1) ? last_row : src + (size_t)r * src_stride;
        float v = sr[k0 + lane];
        if (SILU) v = v / (1.0f + __expf(-v));
        scr[r * 64 + lane] = v;
    }
    __builtin_amdgcn_s_waitcnt(0xC07F); asm volatile("" ::: "memory");
    float acc[NR];
#pragma unroll
    for (int r = 0; r < NR; ++r) acc[r] = 0.f;
#pragma unroll 1
    for (int kk = 0; kk < 64; kk += 4) {
        const float w0 = W[(size_t)(k0 + kk + 0) * N + n0 + lane], w1 = W[(size_t)(k0 + kk + 1) * N + n0 + lane];
        const float w2 = W[(size_t)(k0 + kk + 2) * N + n0 + lane], w3 = W[(size_t)(k0 + kk + 3) * N + n0 + lane];
#pragma unroll
        for (int r = 0; r < NR; ++r) { const f32x4 s = *(const f32x4*)(scr + r * 64 + kk); acc[r] += s.x * w0 + s.y * w1 + s.z * w2 + s.w * w3; }
    }
    const float bv = (bias && k0 == 0) ? bias[n0 + lane] : 0.f;
#pragma unroll
    for (int r = 0; r < NR; ++r) atomicAdd(out + (size_t)r * out_stride + n0 + lane, acc[r] + bv);
    __builtin_amdgcn_s_waitcnt(0xC07F); asm volatile("" ::: "memory");
}

__device__ __forceinline__ void phase_prep_a(const Params& p, float* scr  , int gw, int NGW, int lane) {
    unsigned char* ws = p.ws;
    constexpr int T_MOD = (MODN / 64) * (DM / 64);
    constexpr int I_IN = (DM / 64) * (NQKV / 32), I_OUT = (DM / 64) * (DM / 32), I_1 = (DM / 64) * (FF / 32), I_2 = (FF / 64) * (DM / 32);
    constexpr int T_ALL = T_MOD + I_IN + I_OUT + I_1 + I_2 + 17;
    for (int t = gw; t < T_ALL; t += NGW) {
        int r = t;
        if (r < T_MOD) { const int nb = r % (MODN / 64), kc = r / (MODN / 64);
            small_mm_task<33, true>(p.c, DM, p.c_ctx, p.w_mod, MODN, kc * 64, nb * 64, (float*)(ws + WS_MOD), MODN, p.b_mod, scr, lane); continue; }
        r -= T_MOD;
        if (r < I_IN) { transpose_item<true>(p.w_in, DM, NQKV, (bf16_t*)(ws + WS_WIN), scr, r, lane); continue; } r -= I_IN;
        if (r < I_OUT) { transpose_item<false>(p.w_out, DM, DM, (bf16_t*)(ws + WS_WOUT), scr, r, lane); continue; } r -= I_OUT;
        if (r < I_1) { transpose_item<false>(p.w_fc1, DM, FF, (bf16_t*)(ws + WS_W1), scr, r, lane); continue; } r -= I_1;
        if (r < I_2) { transpose_item<false>(p.w_fc2, FF, DM, (bf16_t*)(ws + WS_W2), scr, r, lane); continue; } r -= I_2;
        if (r < 16) {
            const int pos = 4 * r + (lane >> 4), f = lane & 15;
            const float inv = powf(10000.0f, -(float)f / 16.0f);
            const float ang = (float)pos * inv;
            float* T = (float*)(ws + WS_ROPE) + (pos * 16 + f) * 2;
            T[0] = cosf(ang); T[1] = sinf(ang);
        } else {
            const float a = wave_sum(p.lam_q1[lane] * p.lam_k1[lane]), b = wave_sum(p.lam_q2[lane] * p.lam_k2[lane]);
            if (lane == 0) *(float*)(ws + WS_LAM) = expf(a) - expf(b) + LAM_INIT;
        }
    }
}
__device__ __forceinline__ void phase_prep_b(const Params& p, float* scr, int gw, int NGW, int lane) {
    unsigned char* ws = p.ws;
    const float* mod = (const float*)(ws + WS_MOD);
    constexpr int T_B1 = (FF / 64) * (DM / 64);
    for (int t = gw; t < T_B1; t += NGW) { const int nb = t % (FF / 64), kc = t / (FF / 64);
        small_mm_task<32, false>(mod + 3 * DM, MODN, nullptr, p.w_fc1, FF, kc * 64, nb * 64, (float*)(ws + WS_BIAS1), FF, nullptr, scr, lane); }
    bf16_t* A1 = (bf16_t*)(ws + WS_A1);
    for (int row = gw; row < MALL; row += NGW) {
        const float* xr; const float* mrow;
        if (row < MLAT) { xr = p.x + (size_t)row * DM; mrow = mod + (size_t)(row >> 11) * MODN; }
        else { xr = p.ctx + (size_t)(row - MLAT) * DM; mrow = mod + (size_t)32 * MODN; }
        f32x4 v[4]; float ss = 0.f;
#pragma unroll
        for (int j = 0; j < 4; ++j) { v[j] = *((const f32x4*)xr + lane + 64 * j); ss += (v[j].x * v[j].x + v[j].y * v[j].y) + (v[j].z * v[j].z + v[j].w * v[j].w); }
        const float rstd = rsqrtf(wave_sum(ss) * (1.0f / DM) + EPS);
#pragma unroll
        for (int j = 0; j < 4; ++j) {
            const int col = 4 * lane + 256 * j;
            const f32x4 g = *(const f32x4*)(p.norm1_g + col), sh = *(const f32x4*)(mrow + col), sc = *(const f32x4*)(mrow + DM + col);
            const f32x4 h = (v[j] * rstd) * g * (sc + 1.0f) + sh;
            u32x2 o; o.x = pk2(h.x, h.y); o.y = pk2(h.z, h.w);
            *(u32x2*)(A1 + (size_t)row * DM + col) = o;
        }
    }
}
#define LAS __attribute__((address_space(3)))
constexpr int LDS_SPARE = 131072;
struct E_QKV {
    static constexpr bool SSQ = false; static constexpr int PB = 4;
    bf16_t* qkv; bf16_t* kvc; LAS const float* rope;
    struct Col {};
    struct Pre { f32x4 t0, t1; };
    template <class U> __device__ __forceinline__ float rowval(const U&, int) const { return 0.f; }
    template <class U> __device__ __forceinline__ Col col_prep(const U&, int, int) const { return Col{}; }
    __device__ __forceinline__ static bool rope_cols(int col0) { return (col0 < 512) || (col0 >= 1024 && col0 < 1536); }
    __device__ __forceinline__ Pre preload(int row, int col0) const {
        Pre pr; pr.t0 = (f32x4){1.f, 0.f, 1.f, 0.f}; pr.t1 = pr.t0;
        if (row < MLAT && rope_cols(col0)) {
            const int s = row & (SEQ - 1), gr = s >> 6, gc = s & 63;
            const int i0 = (col0 & 63) >> 1, pos = (i0 >= 16) ? gc : gr, f0 = i0 & 15;
            LAS const f32x4* T = (LAS const f32x4*)(rope + (pos * 16 + f0) * 2);
            pr.t0 = T[0]; pr.t1 = T[1];
        }
        return pr;
    }
    __device__ __forceinline__ float epi8(int row, int col0, const Col&, const float (&a)[8], float, const Pre& pr) const {
        float v[8];
#pragma unroll
        for (int j = 0; j < 8; ++j) v[j] = a[j];
        if (row < MLAT) {
            if (rope_cols(col0)) {
                const float cs[4] = {pr.t0.x, pr.t0.z, pr.t1.x, pr.t1.z}, sn[4] = {pr.t0.y, pr.t0.w, pr.t1.y, pr.t1.w};
#pragma unroll
                for (int q = 0; q < 4; ++q) { const float x1 = v[2 * q], x2 = v[2 * q + 1]; v[2 * q] = x1 * cs[q] - x2 * sn[q]; v[2 * q + 1] = x1 * sn[q] + x2 * cs[q]; }
            }
            if (col0 < 1024) {
#pragma unroll
                for (int j = 0; j < 8; ++j) v[j] *= C2;
            }
            u32x4 o; o.x = pk2(v[0], v[1]); o.y = pk2(v[2], v[3]); o.z = pk2(v[4], v[5]); o.w = pk2(v[6], v[7]);
            *(u32x4*)(qkv + (size_t)row * NQKV + col0) = o;
        } else if (col0 >= 1024) {
            u32x4 o; o.x = pk2(v[0], v[1]); o.y = pk2(v[2], v[3]); o.z = pk2(v[4], v[5]); o.w = pk2(v[6], v[7]);
            *(u32x4*)(kvc + (size_t)(row - MLAT) * NKVC + (col0 - 1024)) = o;
        }
        return 0.f;
    }
};
struct E_OUT {
    static constexpr bool SSQ = true; static constexpr int PB = 2;
    const float* x; float* x1; bf16_t* a2; const float* mod; const float* g2;
    struct Col { f32x4 ga0, ga1, gm0, gm1; };
    struct Pre { f32x4 x0, x4; };
    template <class U> __device__ __forceinline__ float rowval(const U&, int) const { return 0.f; }
    template <class U> __device__ __forceinline__ Col col_prep(const U&, int b, int col0) const {
        Col c; const float* m = mod + (size_t)b * MODN + col0;
        c.ga0 = *(const f32x4*)(m + 2 * DM); c.ga1 = *(const f32x4*)(m + 2 * DM + 4);
        c.gm0 = *(const f32x4*)(g2 + col0) * (*(const f32x4*)(m + 4 * DM) + 1.0f); c.gm1 = *(const f32x4*)(g2 + col0 + 4) * (*(const f32x4*)(m + 4 * DM + 4) + 1.0f);
        return c;
    }
    __device__ __forceinline__ Pre preload(int row, int col0) const { const size_t off = (size_t)row * DM + col0; Pre pr; pr.x0 = *(const f32x4*)(x + off); pr.x4 = *(const f32x4*)(x + off + 4); return pr; }
    __device__ __forceinline__ float epi8(int row, int col0, const Col& c, const float (&a)[8], float, const Pre& pr) const {
        const size_t off = (size_t)row * DM + col0;
        const f32x4 v0 = pr.x0 + c.ga0 * (f32x4){a[0], a[1], a[2], a[3]}, v1 = pr.x4 + c.ga1 * (f32x4){a[4], a[5], a[6], a[7]};
        __builtin_nontemporal_store(v0, (f32x4*)(x1 + off)); __builtin_nontemporal_store(v1, (f32x4*)(x1 + off + 4));
        const f32x4 h0 = v0 * c.gm0, h1 = v1 * c.gm1;
        u32x4 o; o.x = pk2(h0.x, h0.y); o.y = pk2(h0.z, h0.w); o.z = pk2(h1.x, h1.y); o.w = pk2(h1.z, h1.w);
        *(u32x4*)(a2 + off) = o;
        const f32x4 q = v0 * v0 + v1 * v1;
        return (q.x + q.y) + (q.z + q.w);
    }
};
struct E_FC1 {
    static constexpr bool SSQ = false; static constexpr int PB = 4;
    LAS const float* tab; bf16_t* hid;
    struct Col { f32x4 b0, b1; };
    struct Pre {};
    __device__ __forceinline__ Pre preload(int, int) const { return Pre{}; }
    template <class U> __device__ __forceinline__ float rowval(const U& u, int row) const { return tab[u.aux * 512 + (row - u.pm * 256)]; }
    template <class U> __device__ __forceinline__ Col col_prep(const U& u, int, int col0) const { Col c; LAS const f32x4* t = (LAS const f32x4*)(tab + u.aux * 512 + 256 + (col0 - u.pn * 256)); c.b0 = t[0]; c.b1 = t[1]; return c; }
    __device__ __forceinline__ float epi8(int row, int col0, const Col& c, const float (&a)[8], float rv, const Pre&) const {
        const float bs[8] = {c.b0.x, c.b0.y, c.b0.z, c.b0.w, c.b1.x, c.b1.y, c.b1.z, c.b1.w};
        float v[8];
#pragma unroll
        for (int j = 0; j < 8; ++j) { const float z = fmaxf(rv * a[j] + bs[j], 0.f); v[j] = z * z; }
        u32x4 o; o.x = pk2(v[0], v[1]); o.y = pk2(v[2], v[3]); o.z = pk2(v[4], v[5]); o.w = pk2(v[6], v[7]);
        __builtin_nontemporal_store(o, (u32x4*)(hid + (size_t)row * FF + col0));
        return 0.f;
    }
};
struct E_FC2 {
    static constexpr bool SSQ = true; static constexpr int PB = 4;
    float* xio; const float* mod;
    struct Col { f32x4 gm0, gm1; };
    struct Pre { f32x4 x0, x4; };
    template <class U> __device__ __forceinline__ float rowval(const U&, int) const { return 0.f; }
    template <class U> __device__ __forceinline__ Col col_prep(const U&, int b, int col0) const { Col c; const float* m = mod + (size_t)b * MODN + 5 * DM + col0; c.gm0 = *(const f32x4*)m; c.gm1 = *(const f32x4*)(m + 4); return c; }
    __device__ __forceinline__ Pre preload(int row, int col0) const { const size_t off = (size_t)row * DM + col0; Pre pr; pr.x0 = *(const f32x4*)(xio + off); pr.x4 = *(const f32x4*)(xio + off + 4); return pr; }
    __device__ __forceinline__ float epi8(int row, int col0, const Col& c, const float (&a)[8], float, const Pre& pr) const {
        const size_t off = (size_t)row * DM + col0;
        const f32x4 v0 = pr.x0 + c.gm0 * (f32x4){a[0], a[1], a[2], a[3]}, v1 = pr.x4 + c.gm1 * (f32x4){a[4], a[5], a[6], a[7]};
        *(f32x4*)(xio + off) = v0; *(f32x4*)(xio + off + 4) = v1;
        const f32x4 q = v0 * v0 + v1 * v1;
        return (q.x + q.y) + (q.z + q.w);
    }
};

__device__ __forceinline__ int opaque_tid() { int t = threadIdx.x; asm volatile("" : "+v"(t)); return t; }
namespace pg8 {
#define PG8_LAS __attribute__((address_space(3)))
typedef unsigned short bf16_t;
typedef short bf16x8 __attribute__((ext_vector_type(8)));
typedef float f32x4 __attribute__((ext_vector_type(4)));
typedef unsigned u32x4 __attribute__((ext_vector_type(4)));
constexpr int BM = 256, BK = 64, HALF = 128, HTB = HALF * BK * 2  , STAGE_BYTES = 8 * HTB, NXCD = 8, WGM = 8;

__host__ __device__ __forceinline__ int lds_byte(int r, int c) { const int st = (r >> 4) * 2 + (c >> 5), rr = r & 15, cc = c & 31, ob = rr * 64 + cc * 2; return st * 1024 + (ob ^ (((ob >> 9) & 1) << 5)); }
__host__ __device__ __forceinline__ void stage_rc(int b, int& R, int& C) { const int st = b / 1024, sb = b % 1024, swz = sb ^ (((sb >> 9) & 1) << 5); R = (st >> 1) * 16 + swz / 64; C = (st & 1) * 32 + (swz % 64) / 2; }
__host__ __device__ __forceinline__ int perm32(int rho) { const int n = rho >> 4, i = rho & 15; return 8 * (i >> 2) + 4 * n + (i & 3); }

struct Unit { int pm, pn, aux; };
struct Gemm { const bf16_t* A; const bf16_t* Bt; int M, N, K; };

struct StaticOrder {
    int nM, nN, nwg, G, c;
    __host__ __device__ void init(int M, int N, int G_, int c_) { nM = M / BM; nN = N / BM; nwg = nM * nN; G = G_; c = c_; }
    __host__ __device__ bool next(int i, Unit& u) const {
        const long L = (long)i * G + c; if (L >= nwg) return false;
        int wgid = (int)L; { const int q = nwg / NXCD, r = nwg % NXCD, xcd = wgid % NXCD, off = wgid / NXCD; wgid = (xcd < r ? xcd * (q + 1) : r * (q + 1) + (xcd - r) * q) + off; }
        const int nig = WGM * nN, gid = wgid / nig, fm = gid * WGM, gsz = (nM - fm) < WGM ? (nM - fm) : WGM;
        u.pm = fm + ((wgid % nig) % gsz); u.pn = (wgid % nig) / gsz; return true;
    }
    __device__ __forceinline__ void a_ready(const Unit&) const {}
    __device__ __forceinline__ void done(const Unit&) const {}
};


template <class Epi, class Sched, bool ALIGN_EPI = false, bool SP2 = false>
__device__ __forceinline__ void gemm_phase(PG8_LAS unsigned char* lds, const Gemm g, const Sched& S, const Epi& E) {
    const int tid = opaque_tid(), wid = __builtin_amdgcn_readfirstlane(tid >> 6), lane = tid & 63, wr = wid >> 2, wc = wid & 3, fr = lane & 15, fq = lane >> 4;
    const int K = g.K, nt = K / BK;
    unsigned voffA[2], voffB[2];
#pragma unroll
    for (int i = 0; i < 2; ++i) { int R, C; stage_rc(tid * 16 + i * 8192, R, C); const int Rb = Epi::PERM ? ((R & ~31) + perm32(R & 31)) : R;
        voffA[i] = (unsigned)(R * K + C) * 2u; voffB[i] = (unsigned)(Rb * K + C) * 2u; }
    const size_t kstep = (size_t)(BK * 2);
    const size_t hstep = (size_t)HALF * K * 2;
    const size_t tstep = 2 * hstep;
    const unsigned ldsw = (unsigned)wid * 1024u;
    const int aoff = lds_byte(wr * 64 + fr, fq * 8), boff = lds_byte(wc * 32 + fr, fq * 8);
#define PG8_SA(b, h) (((b) * 2 + (h)) * HTB)
#define PG8_SB(b, h) ((4 + (b) * 2 + (h)) * HTB)
#define PG8_STAGE(bufoff, gbase, voff) do { _Pragma("unroll") for (int _i = 0; _i < 2; ++_i) \
        __builtin_amdgcn_global_load_lds((const unsigned*)((const char*)(gbase) + (voff)[_i]), (PG8_LAS unsigned*)(lds + (bufoff) + ldsw + _i * 8192), 16, 0, 0); } while (0)
#define PG8_LDA(dst, b, h) do { _Pragma("unroll") for (int m = 0; m < 4; ++m) _Pragma("unroll") for (int k = 0; k < 2; ++k) dst[m][k] = *(const PG8_LAS bf16x8*)(lds + PG8_SA(b, h) + aoff + m * 2048 + k * 1024); } while (0)
#define PG8_LDB(dst, b, h) do { _Pragma("unroll") for (int n = 0; n < 2; ++n) _Pragma("unroll") for (int k = 0; k < 2; ++k) dst[n][k] = *(const PG8_LAS bf16x8*)(lds + PG8_SB(b, h) + boff + n * 2048 + k * 1024); } while (0)
#define PG8_MMA(ai, bj, At, Bt) do { __builtin_amdgcn_s_setprio(1); _Pragma("unroll") for (int m = 0; m < 4; ++m) _Pragma("unroll") for (int n = 0; n < 2; ++n) _Pragma("unroll") for (int k = 0; k < 2; ++k) \
        acc[ai][bj][m][n] = __builtin_amdgcn_mfma_f32_16x16x32_bf16(Bt[n][k], At[m][k], acc[ai][bj][m][n], 0, 0, 0); __builtin_amdgcn_s_setprio(0); } while (0)
#define PG8_WAIT_V(n) asm volatile("s_waitcnt vmcnt(" #n ")" ::: "memory")
#define PG8_WAIT_L(n) asm volatile("s_waitcnt lgkmcnt(" #n ")" ::: "memory")
#define PG8_BAR __builtin_amdgcn_s_barrier()
#define PG8_SCHED __builtin_amdgcn_sched_barrier(0)
    Unit cur, nxt; int ui = 0;
    if (!S.next(0, cur)) return;
    f32x4 acc[2][2][4][2];
#pragma unroll
    for (int a = 0; a < 2; ++a)
#pragma unroll
        for (int b = 0; b < 2; ++b)
#pragma unroll
            for (int m = 0; m < 4; ++m)
#pragma unroll
                for (int n = 0; n < 2; ++n) acc[a][b][m][n] = (f32x4){0.f, 0.f, 0.f, 0.f};
    bf16x8 At[4][2], B0[2][2], B1[2][2];
    const char* cA = (const char*)g.A + (size_t)cur.pm * tstep; const char* cB = (const char*)g.Bt + (size_t)cur.pn * tstep;
    S.a_ready(cur);
    if constexpr (SP2) {
        PG8_STAGE(PG8_SB(0, 0), cB, voffB); PG8_STAGE(PG8_SB(0, 1), cB + hstep, voffB); PG8_STAGE(PG8_SA(0, 0), cA, voffA); PG8_STAGE(PG8_SA(0, 1), cA + hstep, voffA);
        if (wr == 1) PG8_BAR;
        PG8_WAIT_V(2); PG8_BAR;
        PG8_STAGE(PG8_SB(1, 0), cB + kstep, voffB); PG8_STAGE(PG8_SA(1, 0), cA + kstep, voffA); PG8_STAGE(PG8_SB(1, 1), cB + hstep + kstep, voffB);
        PG8_WAIT_V(6); PG8_BAR;
    } else {
        PG8_STAGE(PG8_SB(0, 0), cB, voffB); PG8_STAGE(PG8_SA(0, 0), cA, voffA); PG8_STAGE(PG8_SB(0, 1), cB + hstep, voffB); PG8_STAGE(PG8_SA(0, 1), cA + hstep, voffA);
        if (wr == 1) PG8_BAR;
        PG8_WAIT_V(4); PG8_BAR;
        PG8_STAGE(PG8_SB(1, 0), cB + kstep, voffB); PG8_STAGE(PG8_SA(1, 0), cA + kstep, voffA); PG8_STAGE(PG8_SB(1, 1), cB + hstep + kstep, voffB);
        PG8_WAIT_V(6); PG8_BAR;
    }
    for (;;) {
        const bool has_next = S.next(ui + 1, nxt);
        const char* nA = has_next ? (const char*)g.A + (size_t)nxt.pm * tstep : cA; const char* nB = has_next ? (const char*)g.Bt + (size_t)nxt.pn * tstep : cB;
        for (int t = 0; t < nt; t += 2) {
            const bool last = (t == nt - 2);
            const char* a1 = cA + (size_t)(t + 1) * kstep;
            const char* a2 = last ? nA : cA + (size_t)(t + 2) * kstep; const char* b2 = last ? nB : cB + (size_t)(t + 2) * kstep;
            const char* a3 = a2 + kstep; const char* b3 = b2 + kstep;
            if (last && has_next) S.a_ready(nxt);
            if constexpr (SP2) {
            PG8_LDB(B0, 0, 0); PG8_LDB(B1, 0, 1); PG8_SCHED; PG8_LDA(At, 0, 0); PG8_STAGE(PG8_SA(1, 1), a1 + hstep, voffA);
            PG8_WAIT_V(8); PG8_WAIT_L(0); PG8_BAR; PG8_MMA(0, 0, At, B0); PG8_MMA(0, 1, At, B1); PG8_BAR; PG8_SCHED;
            PG8_LDA(At, 0, 1); PG8_STAGE(PG8_SB(0, 0), b2, voffB); PG8_STAGE(PG8_SB(0, 1), b2 + hstep, voffB); PG8_STAGE(PG8_SA(0, 0), a2, voffA);
            PG8_WAIT_V(8); PG8_WAIT_L(0); PG8_BAR; PG8_MMA(1, 0, At, B0); PG8_MMA(1, 1, At, B1); PG8_BAR; PG8_SCHED;
            PG8_LDB(B0, 1, 0); PG8_LDB(B1, 1, 1); PG8_SCHED; PG8_LDA(At, 1, 0); PG8_STAGE(PG8_SA(0, 1), a2 + hstep, voffA);
            PG8_WAIT_V(8); PG8_WAIT_L(0); PG8_BAR; PG8_MMA(0, 0, At, B0); PG8_MMA(0, 1, At, B1); PG8_BAR; PG8_SCHED;
            PG8_LDA(At, 1, 1); PG8_STAGE(PG8_SB(1, 0), b3, voffB); PG8_STAGE(PG8_SB(1, 1), b3 + hstep, voffB); PG8_STAGE(PG8_SA(1, 0), a3, voffA);
            PG8_WAIT_V(8); PG8_WAIT_L(0); PG8_BAR; PG8_MMA(1, 0, At, B0); PG8_MMA(1, 1, At, B1); PG8_BAR; PG8_SCHED;
            } else {
            PG8_LDB(B0, 0, 0); PG8_SCHED; PG8_LDA(At, 0, 0); PG8_STAGE(PG8_SA(1, 1), a1 + hstep, voffA);
            PG8_WAIT_L(8); PG8_BAR; PG8_WAIT_L(0); PG8_MMA(0, 0, At, B0); PG8_BAR; PG8_SCHED;
            PG8_LDB(B1, 0, 1); PG8_STAGE(PG8_SB(0, 0), b2, voffB);
            PG8_BAR; PG8_WAIT_L(0); PG8_MMA(0, 1, At, B1); PG8_BAR;
            PG8_LDA(At, 0, 1); PG8_STAGE(PG8_SA(0, 0), a2, voffA);
            PG8_BAR; PG8_WAIT_L(0); PG8_MMA(1, 0, At, B0); PG8_BAR; PG8_SCHED;
            PG8_STAGE(PG8_SB(0, 1), b2 + hstep, voffB);
            PG8_WAIT_V(6); PG8_BAR; PG8_MMA(1, 1, At, B1); PG8_BAR;
            PG8_LDB(B0, 1, 0); PG8_SCHED; PG8_LDA(At, 1, 0); PG8_STAGE(PG8_SA(0, 1), a2 + hstep, voffA);
            PG8_WAIT_L(8); PG8_BAR; PG8_WAIT_L(0); PG8_MMA(0, 0, At, B0); PG8_BAR; PG8_SCHED;
            PG8_LDB(B1, 1, 1); PG8_STAGE(PG8_SB(1, 0), b3, voffB);
            PG8_BAR; PG8_WAIT_L(0); PG8_MMA(0, 1, At, B1); PG8_BAR;
            PG8_LDA(At, 1, 1); PG8_STAGE(PG8_SA(1, 0), a3, voffA);
            PG8_BAR; PG8_WAIT_L(0); PG8_MMA(1, 0, At, B0); PG8_BAR; PG8_SCHED;
            PG8_STAGE(PG8_SB(1, 1), b3 + hstep, voffB);
            PG8_WAIT_V(6); PG8_BAR; PG8_MMA(1, 1, At, B1); PG8_BAR;
            }
        }
        if constexpr (ALIGN_EPI) { if (wr == 0) PG8_BAR; }
        if constexpr (!Epi::AFTER_DRAIN) { E(acc, cur, wr, wc, fr, fq); S.done(cur); }
        if (!has_next) break;
#pragma unroll
        for (int a = 0; a < 2; ++a)
#pragma unroll
            for (int b = 0; b < 2; ++b)
#pragma unroll
                for (int m = 0; m < 4; ++m)
#pragma unroll
                    for (int n = 0; n < 2; ++n) acc[a][b][m][n] = (f32x4){0.f, 0.f, 0.f, 0.f};
        cur = nxt; cA = nA; cB = nB; ++ui;
        if constexpr (ALIGN_EPI) { if (wr == 1) PG8_BAR; }
    }
    PG8_WAIT_V(0);
    if constexpr (!ALIGN_EPI) { if (wr == 0) PG8_BAR; }
    PG8_BAR;
    if constexpr (Epi::AFTER_DRAIN) { E.fused(acc, cur, wr, wc, fr, fq, lds, wid, lane); S.done(cur); }
#undef PG8_SA
#undef PG8_SB
#undef PG8_STAGE
#undef PG8_LDA
#undef PG8_LDB
#undef PG8_MMA
#undef PG8_WAIT_V
#undef PG8_WAIT_L
#undef PG8_BAR
#undef PG8_SCHED
}
}


template <class E8> struct EpiWrap {
    static constexpr bool PERM = true, AFTER_DRAIN = false;
    E8 e; float* ssq;
    __device__ __forceinline__ void operator()(const pg8::f32x4 (&acc)[2][2][4][2], const pg8::Unit& u, int wr, int wc, int fr, int fq) const {
        const int rowb = u.pm * 256 + wr * 64 + fr;
        const int b = (u.pm < 256) ? (u.pm >> 3) : 0;
        float rv[2][4], ss[2][4];
#pragma unroll
        for (int ai = 0; ai < 2; ++ai)
#pragma unroll
            for (int m = 0; m < 4; ++m) { rv[ai][m] = e.rowval(u, rowb + ai * 128 + m * 16); ss[ai][m] = 0.f; }
#pragma unroll
        for (int bj = 0; bj < 2; ++bj) {
            const int col0 = u.pn * 256 + bj * 128 + wc * 32 + 8 * fq;
            const typename E8::Col cc = e.col_prep(u, b, col0);
#pragma unroll
            for (int ai = 0; ai < 2; ++ai)
#pragma unroll
                for (int mb = 0; mb < 4; mb += E8::PB) {
                    typename E8::Pre pre[E8::PB];
#pragma unroll
                    for (int m = 0; m < E8::PB; ++m) pre[m] = e.preload(rowb + ai * 128 + (mb + m) * 16, col0);
#pragma unroll
                    for (int m = 0; m < E8::PB; ++m) {
                        const pg8::f32x4 v0 = acc[ai][bj][mb + m][0], v1 = acc[ai][bj][mb + m][1];
                        const float a[8] = {v0[0], v0[1], v0[2], v0[3], v1[0], v1[1], v1[2], v1[3]};
                        ss[ai][mb + m] += e.epi8(rowb + ai * 128 + (mb + m) * 16, col0, cc, a, rv[ai][mb + m], pre[m]);
                    }
                    asm volatile("" ::: "memory");
                }
        }
        if (E8::SSQ) {
#pragma unroll
            for (int ai = 0; ai < 2; ++ai)
#pragma unroll
                for (int m = 0; m < 4; ++m) { float s = ss[ai][m]; s += __shfl_xor(s, 16); s += __shfl_xor(s, 32);
                    if (fq == 0) ssq[(size_t)(rowb + ai * 128 + m * 16) * 16 + u.pn * 4 + wc] = s; }
        }
    }
};
__device__ __forceinline__ void glds16(const void* gsrc, unsigned lds_dst) { unsigned keep;
    asm volatile("s_mov_b32 %0, m0\n\ts_mov_b32 m0, %2\n\ts_nop 0\n\tglobal_load_lds_dwordx4 %1, off\n\ts_mov_b32 m0, %0" : "=&s"(keep) : "v"(gsrc), "s"(lds_dst) : "memory"); }
struct QkvOrder {
    pg8::StaticOrder base; int G, c;
    __device__ __forceinline__ void init(int G_, int c_) { base.init(MLAT, NQKV, G_, c_); G = G_; c = c_; }
    __device__ __forceinline__ bool next(int i, pg8::Unit& u) const {
        u.aux = 0;
        if (base.next(i, u)) return true;
        const long L = (long)i * G + c - base.nwg; if (L < 0 || L >= 256) return false;
        const int id = (int)L, w = (id & 7) * 32 + (id >> 3);
        u.pm = 256 + (w >> 3); u.pn = 4 + (w & 7); return true;
    }
    __device__ __forceinline__ void a_ready(const pg8::Unit&) const {}
    __device__ __forceinline__ void done(const pg8::Unit&) const {}
};
__device__ __forceinline__ void phase_qkv(const Params& p, LAS unsigned char* lds) {
    unsigned char* ws = p.ws;
    pg8::Gemm g{(const bf16_t*)(ws + WS_A1), (const bf16_t*)(ws + WS_WIN), MALL, NQKV, DM};
    QkvOrder S; S.init((int)gridDim.x, (int)blockIdx.x);
    {   const int t = opaque_tid();
        *(LAS f32x4*)(lds + LDS_SPARE + t * 16) = *(const f32x4*)(ws + WS_ROPE + t * 16);
        __syncthreads(); }
    EpiWrap<E_QKV> E{{(bf16_t*)(ws + WS_QKV), (bf16_t*)(ws + WS_KVC), (LAS const float*)(lds + LDS_SPARE)}, nullptr};
    pg8::gemm_phase<EpiWrap<E_QKV>, QkvOrder, true, true>(lds, g, S, E);
}
__device__ __forceinline__ void phase_outproj(const Params& p, LAS unsigned char* lds) {
    unsigned char* ws = p.ws;
    pg8::Gemm g{(const bf16_t*)(ws + WS_MIX), (const bf16_t*)(ws + WS_WOUT), MLAT, DM, DM};
    pg8::StaticOrder S; S.init(MLAT, DM, (int)gridDim.x, (int)blockIdx.x);
    EpiWrap<E_OUT> E{{p.x, p.out, (bf16_t*)(ws + WS_A2), (const float*)(ws + WS_MOD), p.norm2_g}, (float*)(ws + WS_SSQ1)};
    pg8::gemm_phase<EpiWrap<E_OUT>, pg8::StaticOrder, true, true>(lds, g, S, E);
}
struct Fc1Order {
    pg8::StaticOrder base; const float* rstd; const float* bias1; unsigned tab_lds;
    __device__ __forceinline__ bool next(int i, pg8::Unit& u) const { u.aux = i & 1; return base.next(i, u); }
    __device__ __forceinline__ void a_ready(const pg8::Unit& u) const {
        const int wid = __builtin_amdgcn_readfirstlane(threadIdx.x >> 6), lane = threadIdx.x & 63;
        if (wid == 0) glds16(rstd + (size_t)u.pm * 256 + lane * 4, (unsigned)__builtin_amdgcn_readfirstlane(tab_lds + u.aux * 2048));
        else if (wid == 1) glds16(bias1 + (size_t)(u.pm >> 3) * FF + u.pn * 256 + lane * 4, (unsigned)__builtin_amdgcn_readfirstlane(tab_lds + u.aux * 2048 + 1024));
    }
    __device__ __forceinline__ void done(const pg8::Unit&) const {}
};
__device__ __forceinline__ void phase_rstd1(const Params& p) {
    const float* ssq = (const float*)(p.ws + WS_SSQ1); float* rs = (float*)(p.ws + WS_RSTD1);
    for (int row = blockIdx.x * 512 + opaque_tid(); row < MLAT; row += gridDim.x * 512) {
        const f32x4* s = (const f32x4*)(ssq + (size_t)row * 16); const f32x4 a = s[0], b = s[1], c = s[2], d = s[3];
        const float t = ((a.x + a.y) + (a.z + a.w)) + ((b.x + b.y) + (b.z + b.w)) + ((c.x + c.y) + (c.z + c.w)) + ((d.x + d.y) + (d.z + d.w));
        rs[row] = rsqrtf(t * (1.0f / DM) + EPS);
    }
}
__device__ __forceinline__ void phase_fc1(const Params& p, LAS unsigned char* lds) {
    unsigned char* ws = p.ws;
    pg8::Gemm g{(const bf16_t*)(ws + WS_A2), (const bf16_t*)(ws + WS_W1), MLAT, FF, DM};
    Fc1Order S; S.base.init(MLAT, FF, (int)gridDim.x, (int)blockIdx.x); S.rstd = (const float*)(ws + WS_RSTD1); S.bias1 = (const float*)(ws + WS_BIAS1); S.tab_lds = (unsigned)(uintptr_t)(lds + LDS_SPARE);
    EpiWrap<E_FC1> E{{(LAS const float*)(lds + LDS_SPARE), (bf16_t*)(ws + WS_HID)}, nullptr};
    pg8::gemm_phase<EpiWrap<E_FC1>, Fc1Order, true, true>(lds, g, S, E);
}
__device__ __forceinline__ void phase_fc2(const Params& p, LAS unsigned char* lds) {
    unsigned char* ws = p.ws;
    pg8::Gemm g{(const bf16_t*)(ws + WS_HID), (const bf16_t*)(ws + WS_W2), MLAT, DM, FF};
    pg8::StaticOrder S; S.init(MLAT, DM, (int)gridDim.x, (int)blockIdx.x);
    EpiWrap<E_FC2> E{{p.out, (const float*)(ws + WS_MOD)}, (float*)(ws + WS_SSQ2)};
    pg8::gemm_phase<EpiWrap<E_FC2>, pg8::StaticOrder, true, true>(lds, g, S, E);
}
constexpr int LDS_BYTES = 163840;

namespace att {
typedef short bf16x8 __attribute__((ext_vector_type(8)));
typedef short s16x4 __attribute__((ext_vector_type(4)));
typedef short v4i16_t __attribute__((ext_vector_type(4)));
typedef float f32x16 __attribute__((ext_vector_type(16)));
constexpr int NBUF = 4, RING_BUF = 32768;
constexpr int OFF_STAGE = 0;
constexpr int OFF_WSF = 135168;
constexpr int OFF_RPB = 137216;
constexpr float THR = 8.0f;
__device__ __forceinline__ int crow(int r, int hi) { return (r & 3) + 8 * (r >> 2) + 4 * hi; }
__device__ __forceinline__ s16x4 vtr(LAS const unsigned char* p) { return __builtin_bit_cast(s16x4, __builtin_amdgcn_ds_read_tr16_b64_v4i16((LAS v4i16_t*)p)); }
struct TileSrc { const bf16_t* k; const bf16_t* v; int pitch; };
template <bool DIFF> __device__ __forceinline__ void tile_dma(const TileSrc& s, unsigned ldsbuf, int wid, int lane) {
    if (DIFF) {
#pragma unroll
        for (int i = 0; i < 2; ++i) { const int pc = wid * 2 + i, key = pc * 4 + (lane >> 4), u = lane & 15;
            glds16(s.k + (size_t)key * s.pitch + ((u ^ (key & 15)) << 3), (unsigned)__builtin_amdgcn_readfirstlane(ldsbuf + pc * 1024));
            glds16(s.v + (size_t)key * s.pitch + (((u >> 2) ^ (key & 3)) << 5) + ((u & 3) << 3), (unsigned)__builtin_amdgcn_readfirstlane(ldsbuf + 16384 + pc * 1024)); }
    } else {
        const int key = wid * 8 + (lane >> 3), u = lane & 7;
        glds16(s.k + (size_t)key * s.pitch + ((u ^ ((key >> 1) & 7)) << 3), (unsigned)__builtin_amdgcn_readfirstlane(ldsbuf + wid * 1024));
        glds16(s.v + (size_t)key * s.pitch + (((u >> 2) ^ ((key >> 1) & 1)) << 5) + ((u & 3) << 3), (unsigned)__builtin_amdgcn_readfirstlane(ldsbuf + 8192 + wid * 1024));
    }
}
template <bool DIFF> struct Lay { int koff[4]; int vb[DIFF ? 4 : 2]; };
template <bool DIFF> __device__ __forceinline__ void lay_init(Lay<DIFF>& L, int lane, int map) {
    const int r32 = lane & 31, hi = lane >> 5, q = (lane & 15) >> 2, g1 = (lane >> 4) & 1, pp = lane & 3;
#pragma unroll
    for (int d0 = 0; d0 < 4; ++d0) L.koff[d0] = DIFF ? r32 * 256 + (((8 * map + 2 * d0 + hi) ^ (r32 & 15)) << 4) : r32 * 128 + (((2 * d0 + hi) ^ ((r32 >> 1) & 7)) << 4);
#pragma unroll
    for (int c = 0; c < (DIFF ? 4 : 2); ++c) L.vb[c] = DIFF ? (4 * hi + q) * 256 + ((c ^ q) << 6) + g1 * 32 + pp * 8 : (4 * hi + q) * 128 + ((c ^ ((q >> 1) & 1)) << 6) + g1 * 32 + pp * 8;
}
#define ATT_BAR() asm volatile("s_waitcnt lgkmcnt(0)\n\ts_barrier" ::: "memory")
#define ATT_WAIT_BAR(N) asm volatile("s_waitcnt vmcnt(" #N ") lgkmcnt(0)\n\ts_barrier" ::: "memory")
template <int NC> struct WaveState { f32x16 o[NC]; f32x16 p0, p1; u32x4 pw[4]; float m, l; bf16x8 qr[4]; };
template <bool DIFF> __device__ __forceinline__ void qkt(f32x16& p0, f32x16& p1, LAS const unsigned char* kimg, const Lay<DIFF>& L, const bf16x8 (&qr)[4]) {
#pragma unroll
    for (int r = 0; r < 16; ++r) { p0[r] = 0.f; p1[r] = 0.f; }
#pragma unroll
    for (int d0 = 0; d0 < 4; ++d0) {
        const bf16x8 b0 = *(LAS const bf16x8*)(kimg + L.koff[d0]), b1 = *(LAS const bf16x8*)(kimg + L.koff[d0] + (DIFF ? 8192 : 4096));
        p0 = __builtin_amdgcn_mfma_f32_32x32x16_bf16(b0, qr[d0], p0, 0, 0, 0);
        p1 = __builtin_amdgcn_mfma_f32_32x32x16_bf16(b1, qr[d0], p1, 0, 0, 0);
    }
}
template <bool DIFF, int NC> __device__ __forceinline__ void pv(WaveState<NC>& st, LAS const unsigned char* vimg, const Lay<DIFF>& L) {
    constexpr int SS = DIFF ? 4096 : 2048;
#pragma unroll
    for (int c = 0; c < NC; ++c)
#pragma unroll
        for (int s = 0; s < 4; ++s) {
            const s16x4 lo = vtr(vimg + L.vb[c] + s * SS), hv = vtr(vimg + L.vb[c] + s * SS + SS / 2);
            const bf16x8 vf = {lo[0], lo[1], lo[2], lo[3], hv[0], hv[1], hv[2], hv[3]};
            st.o[c] = __builtin_amdgcn_mfma_f32_32x32x16_bf16(__builtin_bit_cast(bf16x8, st.pw[s]), vf, st.o[c], 0, 0, 0);
        }
}
template <bool DIFF, int NC, bool DO_PV, bool DO_QK> __device__ __forceinline__ void mblock(WaveState<NC>& st, LAS const unsigned char* vimg, LAS const unsigned char* kimg, const Lay<DIFF>& L) {
    if (DO_PV) pv<DIFF, NC>(st, vimg, L);
    if (DO_QK) qkt<DIFF>(st.p0, st.p1, kimg, L, st.qr);
    constexpr int NM = (DO_PV ? NC * 4 : 0) + (DO_QK ? 8 : 0);
    __builtin_amdgcn_sched_group_barrier(0x100, 6, 0);
#pragma unroll
    for (int i = 0; i < NM; ++i) { __builtin_amdgcn_sched_group_barrier(0x008, 1, 0); __builtin_amdgcn_sched_group_barrier(0x100, 2, 0); }
}
template <int NC> __device__ __forceinline__ void softmax_block(WaveState<NC>& st, LAS float* wsf, int r32, int hi) {
    f32x16& p0 = st.p0; f32x16& p1 = st.p1;
    float mx = fmaxf(p0[0], p1[0]);
#pragma unroll
    for (int r = 1; r < 16; ++r) mx = fmaxf(mx, fmaxf(p0[r], p1[r]));
    mx = fmaxf(mx, __shfl_xor(mx, 32));
    if (__any(mx > st.m + THR)) {
        const float mn = fmaxf(st.m, mx), alpha = __builtin_amdgcn_exp2f(st.m - mn);
        st.m = mn; st.l *= alpha;
        if (hi == 0) wsf[r32] = alpha;
#pragma unroll
        for (int r = 0; r < 16; ++r) { const float a = wsf[crow(r, hi)];
#pragma unroll
            for (int c = 0; c < NC; ++c) st.o[c][r] *= a; }
    }
    float rs = 0.f;
#pragma unroll
    for (int r = 0; r < 16; ++r) { p0[r] = __builtin_amdgcn_exp2f(p0[r] - st.m); p1[r] = __builtin_amdgcn_exp2f(p1[r] - st.m); rs += p0[r] + p1[r]; }
    st.l += rs;
#pragma unroll
    for (int i = 0; i < 4; ++i) { st.pw[0][i] = pk2(p0[2 * i], p0[2 * i + 1]); st.pw[1][i] = pk2(p0[8 + 2 * i], p0[9 + 2 * i]); st.pw[2][i] = pk2(p1[2 * i], p1[2 * i + 1]); st.pw[3][i] = pk2(p1[8 + 2 * i], p1[9 + 2 * i]); }
}
template <int NC> __device__ __forceinline__ void state_init(WaveState<NC>& st, const bf16_t* qrow) {
#pragma unroll
    for (int d0 = 0; d0 < 4; ++d0) st.qr[d0] = *(const bf16x8*)(qrow + 16 * d0);
#pragma unroll
    for (int c = 0; c < NC; ++c)
#pragma unroll
        for (int r = 0; r < 16; ++r) st.o[c][r] = 0.f;
#pragma unroll
    for (int s = 0; s < 4; ++s) st.pw[s] = (u32x4){0u, 0u, 0u, 0u};
    st.m = NEGBIG; st.l = 0.f;
}

struct DiffCtx { const bf16_t* qkv; const bf16_t* kvc; int b, h; unsigned lds0; int wid, lane; };
__device__ __forceinline__ TileSrc diff_tile(const DiffCtx& c, int t) {
    if (t < 32) { const bf16_t* base = c.qkv + (size_t)(c.b * SEQ + t * 64) * NQKV; return TileSrc{base + 1024 + 128 * c.h, base + 2048 + 128 * c.h, NQKV}; }
    const bf16_t* base = c.kvc + (size_t)(c.b * CTX + (t - 32) * 64) * NKVC; return TileSrc{base + 128 * c.h, base + 1024 + 128 * c.h, NKVC};
}
__device__ __forceinline__ float max3f(float a, float b, float c) { float r; asm("v_max3_f32 %0, %1, %2, %3" : "=v"(r) : "v"(a), "v"(b), "v"(c)); return r; }
__device__ __forceinline__ float rowmax32(const f32x16& p0, const f32x16& p1) {
    float a = max3f(p0[0], p0[1], p1[0]), b = max3f(p0[2], p0[3], p1[1]); a = max3f(a, p1[2], p1[3]);
#pragma unroll
    for (int r = 4; r < 16; r += 4) { a = max3f(a, p0[r], p0[r + 1]); b = max3f(b, p0[r + 2], p0[r + 3]); a = max3f(a, p1[r], p1[r + 1]); b = max3f(b, p1[r + 2], p1[r + 3]); }
    float m = max3f(a, b, b);
    auto rr = __builtin_amdgcn_permlane32_swap(__float_as_uint(m), __float_as_uint(m), false, false);
    return max3f(__uint_as_float(rr[0]), __uint_as_float(rr[1]), __uint_as_float(rr[1]));
}
__device__ __forceinline__ void exp_pack(const f32x16& s0, const f32x16& s1, const float m, u32x4 (&pw)[4], float& rs_out) {
    float p0[16], p1[16]; float rs = 0.f;
#pragma unroll
    for (int r = 0; r < 16; ++r) { p0[r] = __builtin_amdgcn_exp2f(s0[r] - m); p1[r] = __builtin_amdgcn_exp2f(s1[r] - m); rs += p0[r] + p1[r]; }
    rs_out = rs;
#pragma unroll
    for (int i = 0; i < 4; ++i) { pw[0][i] = pk2(p0[2 * i], p0[2 * i + 1]); pw[1][i] = pk2(p0[8 + 2 * i], p0[9 + 2 * i]); pw[2][i] = pk2(p1[2 * i], p1[2 * i + 1]); pw[3][i] = pk2(p1[8 + 2 * i], p1[9 + 2 * i]); }
}
__device__ __forceinline__ void exp_pack_rel(const f32x16& s0, const f32x16& s1, u32x4 (&pw)[4], float& rs_out) {
    float p0[16], p1[16]; float rs = 0.f;
#pragma unroll
    for (int r = 0; r < 16; ++r) { p0[r] = __builtin_amdgcn_exp2f(s0[r]); p1[r] = __builtin_amdgcn_exp2f(s1[r]); rs += p0[r] + p1[r]; }
    rs_out = rs;
#pragma unroll
    for (int i = 0; i < 4; ++i) { pw[0][i] = pk2(p0[2 * i], p0[2 * i + 1]); pw[1][i] = pk2(p0[8 + 2 * i], p0[9 + 2 * i]); pw[2][i] = pk2(p1[2 * i], p1[2 * i + 1]); pw[3][i] = pk2(p1[8 + 2 * i], p1[9 + 2 * i]); }
}
template <bool DIFF> __device__ __forceinline__ void qkt_from(f32x16& p0, f32x16& p1, const f32x16& init, LAS const unsigned char* kimg, const Lay<DIFF>& L, const bf16x8 (&qr)[4]) {
#pragma unroll
    for (int d0 = 0; d0 < 4; ++d0) {
        const bf16x8 b0 = *(LAS const bf16x8*)(kimg + L.koff[d0]), b1 = *(LAS const bf16x8*)(kimg + L.koff[d0] + (DIFF ? 8192 : 4096));
        p0 = __builtin_amdgcn_mfma_f32_32x32x16_bf16(b0, qr[d0], d0 == 0 ? init : p0, 0, 0, 0);
        p1 = __builtin_amdgcn_mfma_f32_32x32x16_bf16(b1, qr[d0], d0 == 0 ? init : p1, 0, 0, 0);
    }
}
__device__ __forceinline__ void diff_loop3(WaveState<4>& st, f32x16& negm, const DiffCtx& c, LAS unsigned char* lds, LAS float* wsf, const Lay<true>& L, int r32, int hi) {
    constexpr int NT = 36;
    for (int t = 0; t < NT; ++t) {
        if (t + 2 < NT) tile_dma<true>(diff_tile(c, t + 2), c.lds0 + ((t + 2) & 3) * RING_BUF, c.wid, c.lane);
        const int tv = t ? t - 1 : 0, tk = (t + 1 < NT) ? t + 1 : t;
        const float mx = rowmax32(st.p0, st.p1);
        const bool need = __any(mx > THR) || t == 0;
        float alpha = 1.f;
        if (need) {
            const float dm = (t == 0) ? mx : fmaxf(mx, 0.f);
            alpha = (t == 0) ? 0.f : __builtin_amdgcn_exp2f(-dm);
            st.m += dm;
#pragma unroll
            for (int r = 0; r < 16; ++r) { st.p0[r] -= dm; st.p1[r] -= dm; negm[r] = -st.m; }
        }
        u32x4 pwn[4]; float rs; f32x16 n0, n1;
        exp_pack_rel(st.p0, st.p1, pwn, rs);
        pv<true, 4>(st, lds + (tv & 3) * RING_BUF + 16384, L);
        qkt_from<true>(n0, n1, negm, lds + (tk & 3) * RING_BUF, L, st.qr);
        __builtin_amdgcn_sched_group_barrier(0x100, 6, 0);
#pragma unroll
        for (int i = 0; i < 24; ++i) { __builtin_amdgcn_sched_group_barrier(0x008, 1, 0); __builtin_amdgcn_sched_group_barrier(0x100, 2, 0); __builtin_amdgcn_sched_group_barrier(0x402, 4, 0); }
        asm volatile("" : "+v"(pwn[0]), "+v"(pwn[1]), "+v"(pwn[2]), "+v"(pwn[3]), "+v"(rs));
        if (need) {
            if (hi == 0) wsf[r32] = alpha;
#pragma unroll
            for (int r = 0; r < 16; ++r) { const float a = wsf[crow(r, hi)];
#pragma unroll
                for (int cc = 0; cc < 4; ++cc) st.o[cc][r] *= a; }
            st.l *= alpha;
        }
        st.l += rs;
#pragma unroll
        for (int s = 0; s < 4; ++s) st.pw[s] = pwn[s];
        st.p0 = n0; st.p1 = n1;
        ATT_WAIT_BAR(0);
    }
    pv<true, 4>(st, lds + ((NT - 1) & 3) * RING_BUF + 16384, L);
    ATT_WAIT_BAR(0);
}
__device__ __forceinline__ void diff_unit(const Params& p, LAS unsigned char* lds, const int tid_in, int b, int h, int qb, float lam) {
    int tid = tid_in; asm volatile("" : "+v"(tid));
    const int lane = tid & 63, r32 = lane & 31, hi = lane >> 5, wid = __builtin_amdgcn_readfirstlane(tid >> 6), rg = wid & 3, map = wid >> 2;
    const bf16_t* qkv = (const bf16_t*)(p.ws + WS_QKV); bf16_t* mix = (bf16_t*)(p.ws + WS_MIX);
    LAS float* wsf = (LAS float*)(lds + OFF_WSF) + wid * 64;
    Lay<true> L; lay_init<true>(L, lane, map);
    const DiffCtx c{qkv, (const bf16_t*)(p.ws + WS_KVC), b, h, (unsigned)(uintptr_t)lds, wid, lane};
    tile_dma<true>(diff_tile(c, 0), c.lds0, wid, lane); tile_dma<true>(diff_tile(c, 1), c.lds0 + RING_BUF, wid, lane);
    WaveState<4> st;
    state_init<4>(st, qkv + (size_t)(b * SEQ + qb * 128 + rg * 32 + r32) * NQKV + 128 * h + 64 * map + 8 * hi);
    ATT_WAIT_BAR(0);
    f32x16 negm;
#pragma unroll
    for (int r = 0; r < 16; ++r) negm[r] = 0.f;
    st.m = 0.f;
    qkt<true>(st.p0, st.p1, lds, L, st.qr);
    diff_loop3(st, negm, c, lds, wsf, L, r32, hi);
    {   int tid2 = tid; asm volatile("" : "+v"(tid2));
        const int lane2 = tid2 & 63, r32b = lane2 & 31, hib = lane2 >> 5;
        float lt = st.l + __shfl_xor(st.l, 32);
        if (hib == 0) wsf[r32b] = 1.0f / lt;
        LAS float* stg = (LAS float*)(lds + OFF_STAGE);
#pragma unroll
        for (int r = 0; r < 16; ++r) { const float inv = wsf[crow(r, hib)]; const int R = map * 128 + rg * 32 + crow(r, hib);
#pragma unroll
            for (int cc = 0; cc < 4; ++cc) stg[R * 132 + 32 * cc + r32b] = st.o[cc][r] * inv; }
        __syncthreads();
        const int row = tid2 >> 2, part = tid2 & 3;
        float o[32]; float ss = 0.f;
#pragma unroll
        for (int i = 0; i < 8; ++i) { const f32x4 a = *(LAS const f32x4*)(stg + row * 132 + part * 32 + 4 * i), bb = *(LAS const f32x4*)(stg + (128 + row) * 132 + part * 32 + 4 * i);
#pragma unroll
            for (int e = 0; e < 4; ++e) { const float v = a[e] - lam * bb[e]; o[4 * i + e] = v; ss += v * v; } }
        ss += __shfl_xor(ss, 1); ss += __shfl_xor(ss, 2);
        const float rstd = rsqrtf(ss * (1.0f / 128.0f) + EPS) * (1.0f - LAM_INIT);
        bf16_t* dst = mix + (size_t)(b * SEQ + qb * 128 + row) * DM + 128 * h + part * 32;
#pragma unroll
        for (int i = 0; i < 4; ++i) { const f32x4 g0 = *(const f32x4*)(p.subln_g + part * 32 + 8 * i), g1 = *(const f32x4*)(p.subln_g + part * 32 + 8 * i + 4);
            u32x4 w; w.x = pk2(o[8 * i] * rstd * g0.x, o[8 * i + 1] * rstd * g0.y); w.y = pk2(o[8 * i + 2] * rstd * g0.z, o[8 * i + 3] * rstd * g0.w);
            w.z = pk2(o[8 * i + 4] * rstd * g1.x, o[8 * i + 5] * rstd * g1.y); w.w = pk2(o[8 * i + 6] * rstd * g1.z, o[8 * i + 7] * rstd * g1.w);
            *(u32x4*)(dst + 8 * i) = w; }
        asm volatile("s_waitcnt vmcnt(0)" ::: "memory");
        __syncthreads();
    }
}
constexpr int NA_SLOT = 16384;
constexpr float MASKV = -3.0e38f;
struct NaCtx { const bf16_t* qkv; const bf16_t* kvc; int b, hh, lo0, nrows; unsigned lds0; int wid, lane; };
__device__ __forceinline__ TileSrc na_tile(const NaCtx& c, int i) {
    if (i < c.nrows) { const bf16_t* base = c.qkv + (size_t)(c.b * SEQ + (c.lo0 + i) * 64) * NQKV; return TileSrc{base + 1536 + 64 * c.hh, base + 2560 + 64 * c.hh, NQKV}; }
    const bf16_t* base = c.kvc + (size_t)(c.b * CTX + (i - c.nrows) * 64) * NKVC; return TileSrc{base + 512 + 64 * c.hh, base + 1536 + 64 * c.hh, NKVC};
}
struct NaState { f32x16 o[2]; f32x16 s0, s1; u32x4 pw[4]; float m, l; bf16x8 qr[4]; };
template <int NK> __device__ __forceinline__ void na_pv(NaState& st, LAS const unsigned char* vimg, const int (&vb)[2]) {
#pragma unroll
    for (int cc = 0; cc < 2; ++cc)
#pragma unroll
        for (int s = 0; s < NK; ++s) {
            const s16x4 lo = vtr(vimg + vb[cc] + s * 2048), hv = vtr(vimg + vb[cc] + s * 2048 + 1024);
            const bf16x8 vf = {lo[0], lo[1], lo[2], lo[3], hv[0], hv[1], hv[2], hv[3]};
            st.o[cc] = __builtin_amdgcn_mfma_f32_32x32x16_bf16(__builtin_bit_cast(bf16x8, st.pw[s]), vf, st.o[cc], 0, 0, 0);
        }
}
template <bool TWO> __device__ __forceinline__ void na_qk(f32x16& n0, f32x16& n1, LAS const unsigned char* kimg, const int (&koff)[4], const bf16x8 (&qr)[4]) {
#pragma unroll
    for (int r = 0; r < 16; ++r) { n0[r] = 0.f; if (TWO) n1[r] = 0.f; }
#pragma unroll
    for (int d0 = 0; d0 < 4; ++d0) {
        n0 = __builtin_amdgcn_mfma_f32_32x32x16_bf16(*(LAS const bf16x8*)(kimg + koff[d0]), qr[d0], n0, 0, 0, 0);
        if (TWO) n1 = __builtin_amdgcn_mfma_f32_32x32x16_bf16(*(LAS const bf16x8*)(kimg + koff[d0] + 4096), qr[d0], n1, 0, 0, 0);
    }
}
__device__ __forceinline__ void na_rescale(NaState& st, LAS float* wsf, float alpha, float m_use, int r32, int hi) {
    if (hi == 0) wsf[r32] = alpha;
#pragma unroll
    for (int r = 0; r < 16; ++r) { const float a = wsf[crow(r, hi)]; st.o[0][r] *= a; st.o[1][r] *= a; }
    st.l *= alpha; st.m = m_use;
}
__device__ __forceinline__ void na_unit(const Params& p, LAS unsigned char* lds, const int tid_in, int b, int hh, int rg4) {
    int tid = tid_in; asm volatile("" : "+v"(tid));
    const int lane = tid & 63, r32 = lane & 31, hi = lane >> 5, wid = __builtin_amdgcn_readfirstlane(tid >> 6), pr = wid >> 2, cb = wid & 3;
    const bf16_t* qkv = (const bf16_t*)(p.ws + WS_QKV); bf16_t* mix = (bf16_t*)(p.ws + WS_MIX);
    LAS float* wsf = (LAS float*)(lds + OFF_WSF) + wid * 64;
    LAS float* rpbL = (LAS float*)(lds + OFF_RPB);
    const int r0 = 4 * rg4;
    const int lo0 = min(max(r0 - 4, 0), 24), hi0 = min(max(r0 - 3, 0), 24) + 7, lo1 = min(max(r0 - 2, 0), 24), hi1 = min(max(r0 - 1, 0), 24) + 7;
    const int d = lo1 - lo0, nrows = hi1 - lo0 + 1, n0c = hi0 - lo0 + 1, n1c = hi1 - lo1 + 1, S_lat = max(n0c, n1c), ntiles = nrows + 4;
    const int off = pr ? d : 0, np = pr ? n1c : n0c;
    const NaCtx c{qkv, (const bf16_t*)(p.ws + WS_KVC), b, hh, lo0, nrows, (unsigned)(uintptr_t)lds, wid, lane};
    for (int i = 0; i < d + 3; ++i) tile_dma<false>(na_tile(c, i), c.lds0 + (i & 7) * NA_SLOT, wid, lane);
    if (tid < 465) rpbL[tid] = p.rpb[hh * 465 + tid] * LOG2E;
    const int qrow = r0 + 2 * pr + (r32 >> 4), jq = 16 * cb + (r32 & 15), kc0 = (cb == 0) ? 0 : (cb == 1) ? 8 : (cb == 2) ? 24 : 32;
    const int qstart = min(max(qrow - 4, 0), 24), cs = min(max(jq - 8, 0), 48);
    NaState st;
#pragma unroll
    for (int d0 = 0; d0 < 4; ++d0) st.qr[d0] = *(const bf16x8*)(qkv + (size_t)(b * SEQ + qrow * 64 + jq) * NQKV + 512 + 64 * hh + 8 * hi + 16 * d0);
#pragma unroll
    for (int r = 0; r < 16; ++r) { st.o[0][r] = 0.f; st.o[1][r] = 0.f; }
#pragma unroll
    for (int s = 0; s < 4; ++s) st.pw[s] = (u32x4){0u, 0u, 0u, 0u};
    st.m = NEGBIG; st.l = 0.f;
    unsigned cmask = 0u;
#pragma unroll
    for (int r = 0; r < 16; ++r) { const int jk = kc0 + crow(r, hi); if (jk >= cs && jk < cs + 16) cmask |= 1u << r; }
    int koffL[4], koffC[4], vbL[2], vbC[2];
    {   const int q = (lane & 15) >> 2, g1 = (lane >> 4) & 1, pp = lane & 3, keyL = kc0 + r32;
#pragma unroll
        for (int d0 = 0; d0 < 4; ++d0) { koffL[d0] = keyL * 128 + (((2 * d0 + hi) ^ ((keyL >> 1) & 7)) << 4); koffC[d0] = r32 * 128 + (((2 * d0 + hi) ^ ((r32 >> 1) & 7)) << 4); }
#pragma unroll
        for (int cc = 0; cc < 2; ++cc) { vbC[cc] = (4 * hi + q) * 128 + ((cc ^ ((q >> 1) & 1)) << 6) + g1 * 32 + pp * 8; vbL[cc] = vbC[cc] + kc0 * 128; } }
    const int bias_base = 15 - jq + kc0 + 4 * hi;
    asm volatile("s_waitcnt vmcnt(2) lgkmcnt(0)\n\ts_barrier" ::: "memory");
    na_qk<false>(st.s0, st.s1, lds + (off & 7) * NA_SLOT, koffL, st.qr);
    for (int s = 0; s < S_lat; ++s) {
        if (s + d + 3 < ntiles) tile_dma<false>(na_tile(c, s + d + 3), c.lds0 + ((s + d + 3) & 7) * NA_SLOT, wid, lane);
        const bool live = s < np;
        const int ic = off + (live ? s : np - 1), ipv = off + (s ? min(s, np) - 1 : 0), inx = off + min(s + 1, np - 1);
        const int kr = lo0 + ic;
        {   const bool rowok = live && kr >= qstart && kr < qstart + 8;
            LAS const float* bp = rpbL + (kr - qrow + 7) * 31 + bias_base;
#pragma unroll
            for (int r = 0; r < 16; ++r) { const float bv = bp[(r & 3) + 8 * (r >> 2)]; st.s0[r] = (rowok && ((cmask >> r) & 1u)) ? st.s0[r] + bv : MASKV; } }
        float mx = max3f(st.s0[0], st.s0[1], st.s0[2]);
#pragma unroll
        for (int r = 3; r < 15; r += 2) mx = max3f(mx, st.s0[r], st.s0[r + 1]);
        mx = max3f(mx, st.s0[15], st.s0[15]);
        { auto rr = __builtin_amdgcn_permlane32_swap(__float_as_uint(mx), __float_as_uint(mx), false, false); mx = max3f(__uint_as_float(rr[0]), __uint_as_float(rr[1]), __uint_as_float(rr[1])); }
        const bool need = __any(mx > st.m + THR);
        const float m_use = need ? fmaxf(st.m, mx) : st.m, alpha = __builtin_amdgcn_exp2f(st.m - m_use);
        u32x4 pwn[2]; float rs = 0.f;
        {   float e[16];
#pragma unroll
            for (int r = 0; r < 16; ++r) { e[r] = __builtin_amdgcn_exp2f(st.s0[r] - m_use); rs += e[r]; }
#pragma unroll
            for (int i = 0; i < 4; ++i) { pwn[0][i] = pk2(e[2 * i], e[2 * i + 1]); pwn[1][i] = pk2(e[8 + 2 * i], e[9 + 2 * i]); } }
        f32x16 n0, n1;
        na_pv<2>(st, lds + (ipv & 7) * NA_SLOT + 8192, vbL);
        na_qk<false>(n0, n1, lds + (inx & 7) * NA_SLOT, koffL, st.qr);
        __builtin_amdgcn_sched_group_barrier(0x100, 4, 0);
#pragma unroll
        for (int i = 0; i < 8; ++i) { __builtin_amdgcn_sched_group_barrier(0x008, 1, 0); __builtin_amdgcn_sched_group_barrier(0x100, 2, 0); __builtin_amdgcn_sched_group_barrier(0x402, 12, 0); }
        asm volatile("" : "+v"(pwn[0]), "+v"(pwn[1]), "+v"(rs));
        if (need) na_rescale(st, wsf, alpha, m_use, r32, hi);
        st.l += rs; st.pw[0] = pwn[0]; st.pw[1] = pwn[1]; st.s0 = n0;
        if (s + d + 3 < ntiles) asm volatile("s_waitcnt vmcnt(2) lgkmcnt(0)\n\ts_barrier" ::: "memory");
        else asm volatile("s_waitcnt vmcnt(0) lgkmcnt(0)\n\ts_barrier" ::: "memory");
    }
    na_pv<2>(st, lds + ((off + np - 1) & 7) * NA_SLOT + 8192, vbL);
    na_qk<true>(st.s0, st.s1, lds + (nrows & 7) * NA_SLOT, koffC, st.qr);
#pragma unroll
    for (int s = 0; s < 4; ++s) st.pw[s] = (u32x4){0u, 0u, 0u, 0u};
    for (int cs4 = 0; cs4 < 4; ++cs4) {
        const int gs = S_lat + cs4;
        if (gs + d + 3 < ntiles) tile_dma<false>(na_tile(c, gs + d + 3), c.lds0 + ((gs + d + 3) & 7) * NA_SLOT, wid, lane);
        const int ipv = nrows + (cs4 ? cs4 - 1 : 0), inx = nrows + min(cs4 + 1, 3);
        const float mx = rowmax32(st.s0, st.s1);
        const bool need = __any(mx > st.m + THR);
        const float m_use = need ? fmaxf(st.m, mx) : st.m, alpha = __builtin_amdgcn_exp2f(st.m - m_use);
        u32x4 pwn[4]; float rs; f32x16 n0, n1;
        exp_pack(st.s0, st.s1, m_use, pwn, rs);
        na_pv<4>(st, lds + (ipv & 7) * NA_SLOT + 8192, vbC);
        na_qk<true>(n0, n1, lds + (inx & 7) * NA_SLOT, koffC, st.qr);
        __builtin_amdgcn_sched_group_barrier(0x100, 6, 0);
#pragma unroll
        for (int i = 0; i < 16; ++i) { __builtin_amdgcn_sched_group_barrier(0x008, 1, 0); __builtin_amdgcn_sched_group_barrier(0x100, 2, 0); __builtin_amdgcn_sched_group_barrier(0x402, 8, 0); }
        asm volatile("" : "+v"(pwn[0]), "+v"(pwn[1]), "+v"(pwn[2]), "+v"(pwn[3]), "+v"(rs));
        if (need) na_rescale(st, wsf, alpha, m_use, r32, hi);
        st.l += rs;
#pragma unroll
        for (int s = 0; s < 4; ++s) st.pw[s] = pwn[s];
        st.s0 = n0; st.s1 = n1;
        if (gs + d + 3 < ntiles) asm volatile("s_waitcnt vmcnt(2) lgkmcnt(0)\n\ts_barrier" ::: "memory");
        else asm volatile("s_waitcnt vmcnt(0) lgkmcnt(0)\n\ts_barrier" ::: "memory");
    }
    na_pv<4>(st, lds + ((nrows + 3) & 7) * NA_SLOT + 8192, vbC);
    asm volatile("s_waitcnt vmcnt(0) lgkmcnt(0)\n\ts_barrier" ::: "memory");
    {   int tid2 = tid; asm volatile("" : "+v"(tid2));
        const int lane2 = tid2 & 63, r32b = lane2 & 31, hib = lane2 >> 5;
        float lt = st.l + __shfl_xor(st.l, 32);
        if (hib == 0) wsf[r32b] = 1.0f / lt;
        LAS float* stg = (LAS float*)(lds + OFF_STAGE) + wid * (32 * 68);
#pragma unroll
        for (int r = 0; r < 16; ++r) { const float inv = wsf[crow(r, hib)];
#pragma unroll
            for (int cc = 0; cc < 2; ++cc) stg[crow(r, hib) * 68 + 32 * cc + r32b] = st.o[cc][r] * inv; }
        const int row = lane2 >> 1, half = lane2 & 1;
        bf16_t* dst = mix + (size_t)(b * SEQ + (r0 + 2 * pr + (row >> 4)) * 64 + 16 * cb + (row & 15)) * DM + 512 + 64 * hh + half * 32;
#pragma unroll
        for (int i = 0; i < 4; ++i) { const f32x4 a = *(LAS const f32x4*)(stg + row * 68 + half * 32 + 8 * i), c4 = *(LAS const f32x4*)(stg + row * 68 + half * 32 + 8 * i + 4);
            u32x4 w; w.x = pk2(a.x, a.y); w.y = pk2(a.z, a.w); w.z = pk2(c4.x, c4.y); w.w = pk2(c4.z, c4.w);
            *(u32x4*)(dst + 8 * i) = w; }
        asm volatile("s_waitcnt vmcnt(0)" ::: "memory");
        __syncthreads();
    }
}
}
__device__ __forceinline__ void phase_attn(const Params& p, LAS unsigned char* lds) {
    const int G = (int)gridDim.x, bx = (int)blockIdx.x, vcu = (G % 8 == 0) ? (bx % 8) * (G / 8) + bx / 8 : bx;
    const float lam = *(const float*)(p.ws + WS_LAM);
    const int tid = opaque_tid();
    for (int u = vcu; u < 2048; u += G) att::diff_unit(p, lds, tid, u >> 6, (u >> 4) & 3, u & 15, lam);
    for (int u = vcu; u < 2048; u += G) att::na_unit(p, lds, tid, u >> 6, (u >> 3) & 7, u & 7);
}

__device__ __forceinline__ void phase_final(const Params& p, int gw, int NGW, int lane) {
    const float* ssq2 = (const float*)(p.ws + WS_SSQ2);
    for (int row = gw; row < MLAT; row += NGW) {
        const float sv = (lane < 16) ? ssq2[(size_t)row * 16 + lane] : 0.f;
        const float rstd = rsqrtf(wave_sum(sv) * (1.0f / DM) + EPS);
        float* o = p.out + (size_t)row * DM;
#pragma unroll
        for (int j = 0; j < 4; ++j) { const int col = 4 * lane + 256 * j; const f32x4 v = *(const f32x4*)(o + col), g = *(const f32x4*)(p.final_g + col); __builtin_nontemporal_store(v * rstd * g, (f32x4*)(o + col)); }
    }
}

constexpr int LDS_MISC = 163840 - 64;
constexpr int CW_BAR = 4096;
#define RLX_AGENT __ATOMIC_RELAXED, __HIP_MEMORY_SCOPE_AGENT
#define XB_TMO      128
#define XB_XCNT(j)  (256  + 64 * (j))
#define XB_XSUB(j)  (1280 + 64 * (j))
#define XB_XGEN(j)  (2304 + 64 * (j))
#define XB_TOP      3328
#define XB_TOPGEN   3392
#define XCD_BAR_WORDS 3456
#define XB_SPIN_CAP (1u << 18)

__device__ __forceinline__ unsigned xb_ld(unsigned* p)              { return __hip_atomic_load(p, __ATOMIC_RELAXED, __HIP_MEMORY_SCOPE_AGENT); }
__device__ __forceinline__ unsigned xb_add(unsigned* p, unsigned v) { return __hip_atomic_fetch_add(p, v, __ATOMIC_RELAXED, __HIP_MEMORY_SCOPE_AGENT); }
__device__ __forceinline__ unsigned xb_xcc_id() { return (unsigned)__builtin_amdgcn_s_getreg((3 << 11) | 20) & 0xFu; }
#define XB_SPIN(cond, bar) do { unsigned _sp = 0; while (cond) { __builtin_amdgcn_s_sleep(1); \
    if ((++_sp & 255u) == 0u) { if (xb_ld(&(bar)[XB_TMO])) break; if (_sp > XB_SPIN_CAP) { atomicAdd(&(bar)[XB_TMO], 1u); break; } } } } while (0)

struct XcdBarrier {
    unsigned* bar; unsigned x;
    volatile LAS unsigned* st;
};

__device__ __forceinline__ XcdBarrier xcd_barrier_post(unsigned* bar, volatile LAS unsigned* st) {
    XcdBarrier b; b.bar = bar; b.x = xb_xcc_id(); b.st = st;
    if (threadIdx.x == 0) (void)xb_add(&bar[XB_XCNT(b.x)], 1u);
    return b;
}
__device__ __forceinline__ void xcd_barrier_complete(unsigned* bar, unsigned x, unsigned& nloc, unsigned& nx) {
    const unsigned G = gridDim.x * gridDim.y * gridDim.z;
    unsigned sum, cnt, mine, sp = 0u;
    for (;;) {
        sum = 0u; cnt = 0u; mine = 0u;
#pragma unroll
        for (unsigned j = 0; j < 16; ++j) { const unsigned c = xb_ld(&bar[XB_XCNT(j)]); sum += c; cnt += (c > 0u) ? 1u : 0u; mine = (j == x) ? c : mine; }
        if (sum == G) break;
        __builtin_amdgcn_s_sleep(1);
        if ((++sp & 255u) == 0u) { if (xb_ld(&bar[XB_TMO])) break; if (sp > XB_SPIN_CAP) { atomicAdd(&bar[XB_TMO], 1u); break; } }
    }
    nloc = mine > 0u ? mine : 1u; nx = cnt > 0u ? cnt : 1u;
}

__device__ __forceinline__ void xcd_barrier(const XcdBarrier& b) {
    asm volatile("s_waitcnt vmcnt(0)" ::: "memory");
    __syncthreads();
    if (threadIdx.x == 0) {
        unsigned* bar = b.bar;
        __builtin_amdgcn_s_waitcnt(0);
        unsigned nloc = b.st[0], nx = b.st[1];
        if (nloc == 0u) { xcd_barrier_complete(bar, b.x, nloc, nx); b.st[0] = nloc; b.st[1] = nx; }
        const unsigned old = xb_add(&bar[XB_XSUB(b.x)], 1u);
        const unsigned gen = old / nloc;
        if (old + 1u == (gen + 1u) * nloc) {
            __builtin_amdgcn_fence(__ATOMIC_RELEASE, "agent");
            asm volatile("s_waitcnt vmcnt(0)" ::: "memory");
            const unsigned og = xb_add(&bar[XB_TOP], 1u);
            const unsigned tg = og / nx;
            if (og + 1u == (tg + 1u) * nx) xb_add(&bar[XB_TOPGEN], 1u);
            else XB_SPIN(xb_ld(&bar[XB_TOPGEN]) == tg, bar);
            __builtin_amdgcn_fence(__ATOMIC_ACQUIRE, "agent");
            xb_add(&bar[XB_XGEN(b.x)], 1u);
            asm volatile("s_waitcnt vmcnt(0)" ::: "memory");
        } else {
            XB_SPIN(xb_ld(&bar[XB_XGEN(b.x)]) == gen, bar);
            __builtin_amdgcn_fence(__ATOMIC_ACQUIRE, "agent");
            asm volatile("s_waitcnt vmcnt(0)" ::: "memory");
        }
    }
    __syncthreads();
}

typedef const Params __attribute__((address_space(4))) CParams;
__device__ __forceinline__ Params kparams() {
#if defined(__HIP_DEVICE_COMPILE__)
    CParams* k = (CParams*)__builtin_amdgcn_kernarg_segment_ptr(); asm volatile("" : "+s"(k)); return *k;
#else
    return Params{};
#endif
}
#define PH_IDS const int tid_ = opaque_tid(), wid = tid_ >> 6, lane = tid_ & 63, gw = blockIdx.x * 8 + wid, NGW = gridDim.x * 8
__global__ __launch_bounds__(512, 2) void k_mega(Params p_unused) {
    extern __shared__ __attribute__((aligned(16))) unsigned char lds[];
    volatile LAS unsigned* MISC = (volatile LAS unsigned*)((LAS unsigned char*)lds + LDS_MISC);
    if (threadIdx.x < 16) MISC[threadIdx.x] = 0u;
    __syncthreads();
    XcdBarrier bar;
    { const Params p = kparams(); bar = xcd_barrier_post((unsigned*)(p.ws + WS_CTL) + CW_BAR, MISC); }
#define SEAM() xcd_barrier(bar)
    { const Params p = kparams(); PH_IDS; phase_prep_a(p, (float*)lds + wid * 2112, gw, NGW, lane); }
    SEAM();
    { const Params p = kparams(); PH_IDS; phase_prep_b(p, (float*)lds + wid * 2112, gw, NGW, lane); }
    SEAM();
    { const Params p = kparams(); phase_qkv(p, (LAS unsigned char*)lds); }
    SEAM();
    { const Params p = kparams(); phase_attn(p, (LAS unsigned char*)lds); }
    SEAM();
    { const Params p = kparams(); phase_outproj(p, (LAS unsigned char*)lds); }
    SEAM();
    { const Params p = kparams(); phase_rstd1(p); }
    SEAM();
    { const Params p = kparams(); phase_fc1(p, (LAS unsigned char*)lds); }
    SEAM();
    { const Params p = kparams(); phase_fc2(p, (LAS unsigned char*)lds); }
    SEAM();
    { const Params p = kparams(); PH_IDS; phase_final(p, gw, NGW, lane); }
}

extern "C" void kernel_launch(void* const* d_in, const int* in_sizes, int n_in, void* d_out, int out_size, void* d_ws, size_t ws_size, hipStream_t stream) {
    if (n_in != 19 || in_sizes[0] != MLAT * DM || out_size != MLAT * DM || ws_size < WS_END) {
        fprintf(stderr, "kernel_launch: unexpected shapes: n_in %d in0 %d out %d ws %zu (need %zu)\n", n_in, n_in > 0 ? in_sizes[0] : -1, out_size, ws_size, (size_t)WS_END);
        return;
    }
    Params p{};
    const float** pf = (const float**)&p;
    for (int i = 0; i < 19; ++i) pf[i] = (const float*)d_in[i];
    p.out = (float*)d_out; p.ws = (unsigned char*)d_ws;
    unsigned char* ws = p.ws;
    static int grid_blocks = 0;
    if (grid_blocks == 0) {
        int dev = 0, cus = 0, per_cu = 0;
        (void)hipGetDevice(&dev);
        (void)hipDeviceGetAttribute(&cus, hipDeviceAttributeMultiprocessorCount, dev);
        (void)hipFuncSetAttribute((const void*)k_mega, hipFuncAttributeMaxDynamicSharedMemorySize, LDS_BYTES);
        (void)hipOccupancyMaxActiveBlocksPerMultiprocessor(&per_cu, (const void*)k_mega, 512, LDS_BYTES);
        if (per_cu < 1) { fprintf(stderr, "kernel_launch: occupancy query reports %d blocks per CU\n", per_cu); per_cu = 1; }
        grid_blocks = cus;
        (void)hipGetLastError();
    }
    (void)hipMemsetAsync(ws, 0, WS_ZERO_BYTES, stream);
    void* args[] = {&p};
    hipError_t e = hipLaunchCooperativeKernel((const void*)k_mega, dim3(grid_blocks), dim3(512), args, LDS_BYTES, stream);
    if (e != hipSuccess) fprintf(stderr, "kernel_launch: cooperative launch failed: %s (grid %d)\n", hipGetErrorString(e), grid_blocks);
}
```

```cpp
#include <hip/hip_runtime.h>
#include <cstdio>
#include <cstdint>

typedef unsigned short bf16_t;
typedef float f32x4 __attribute__((ext_vector_type(4)));
typedef float f32x2 __attribute__((ext_vector_type(2)));
typedef unsigned u32x4 __attribute__((ext_vector_type(4)));
typedef unsigned u32x2 __attribute__((ext_vector_type(2)));
typedef __bf16 bf16x2_t __attribute__((ext_vector_type(2)));

constexpr int NB = 32, SEQ = 2048, DM = 1024, CTX = 256, FF = 4096, NQKV = 3072, NKVC = 2048;
constexpr int MLAT = NB * SEQ, MCTX = NB * CTX, MALL = MLAT + MCTX;
constexpr int MODN = 6 * DM;
constexpr float EPS = 1e-6f;
constexpr float LOG2E = 1.4426950408889634f;
constexpr float C2 = 0.125f * LOG2E;
constexpr float LAM_INIT = 0.2f;
constexpr float NEGBIG = -1e30f;

constexpr size_t MiB = 1u << 20;
constexpr size_t WS_CTL = 0;
constexpr size_t WS_MOD = 1 * MiB;
constexpr size_t WS_BIAS1 = 2 * MiB;
constexpr size_t WS_ROPE = 3 * MiB;
constexpr size_t WS_LAM = 3 * MiB + 65536;
constexpr size_t WS_ZERO_BYTES = 3 * MiB;
constexpr size_t WS_SSQ1 = 4 * MiB;
constexpr size_t WS_SSQ2 = 8 * MiB;
constexpr size_t WS_RSTD1 = 3 * MiB + 131072;
constexpr size_t WS_WIN = 12 * MiB;
constexpr size_t WS_WOUT = 18 * MiB;
constexpr size_t WS_W1 = 20 * MiB;
constexpr size_t WS_W2 = 28 * MiB;
constexpr size_t WS_KVC = 36 * MiB;
constexpr size_t WS_A2 = 84 * MiB;
constexpr size_t WS_MIX = 212 * MiB;
constexpr size_t WS_A1 = 340 * MiB;
constexpr size_t WS_QKV = 484 * MiB;
constexpr size_t WS_HID = 340 * MiB;
constexpr size_t WS_X1B = 868 * MiB;
constexpr size_t WS_END = 996 * MiB;

struct Params {
    const float *x, *c, *ctx, *c_ctx, *w_mod, *b_mod, *norm1_g, *w_in, *lam_q1, *lam_k1, *lam_q2, *lam_k2, *subln_g, *rpb, *w_out, *norm2_g, *w_fc1, *w_fc2, *final_g;
    float* out; unsigned char* ws;
};

__device__ __forceinline__ unsigned pk2(float lo, float hi) { f32x2 v = {lo, hi}; bf16x2_t b = __builtin_convertvector(v, bf16x2_t); return __builtin_bit_cast(unsigned, b); }
__device__ __forceinline__ float bf_lo(unsigned w) { return __uint_as_float(w << 16); }
__device__ __forceinline__ float bf_hi(unsigned w) { return __uint_as_float(w & 0xffff0000u); }
__device__ __forceinline__ float bf2f(bf16_t v) { return __uint_as_float(((unsigned)v) << 16); }
__device__ __forceinline__ float wave_sum(float v) {
#pragma unroll
    for (int o = 1; o < 64; o <<= 1) v += __shfl_xor(v, o);
    return v;
}
__device__ __forceinline__ float wave_max(float v) {
#pragma unroll
    for (int o = 1; o < 64; o <<= 1) v = fmaxf(v, __shfl_xor(v, o));
    return v;
}
__host__ __device__ __forceinline__ int win_src_col(int n) {
    const bool perm = (n < 512) || (n >= 1024 && n < 1536);
    if (!perm) return n;
    const int nd = n & 63, base = n - nd, i = nd >> 1, par = nd & 1;
    const int old = (i < 16 ? i : 32 + (i - 16)) + 16 * par;
    return base + old;
}

template <bool PERMW>
__device__ __forceinline__ void transpose_item(const float* __restrict__ W, int K, int N, bf16_t* __restrict__ WT, float* scr, int item, int lane) {
    const int nblk = N / 32, kb = item / nblk, nb = item % nblk, k0 = 64 * kb, n0 = 32 * nb;
    const int nsrc = PERMW ? win_src_col(n0 + (lane & 31)) : (n0 + (lane & 31));
#pragma unroll 8
    for (int i = 0; i < 32; ++i) { const int kk = 2 * i + (lane >> 5); scr[kk * 33 + (lane & 31)] = W[(size_t)(k0 + kk) * N + nsrc]; }
    __builtin_amdgcn_s_waitcnt(0xC07F); asm volatile("" ::: "memory");
    const int c = lane & 7;
#pragma unroll
    for (int j = 0; j < 4; ++j) { const int n = (lane >> 3) + 8 * j; const float* s = scr + (8 * c) * 33 + n;
        u32x4 o; o.x = pk2(s[0 * 33], s[1 * 33]); o.y = pk2(s[2 * 33], s[3 * 33]); o.z = pk2(s[4 * 33], s[5 * 33]); o.w = pk2(s[6 * 33], s[7 * 33]);
        *(u32x4*)(WT + (size_t)(n0 + n) * K + k0 + 8 * c) = o; }
    __builtin_amdgcn_s_waitcnt(0xC07F); asm volatile("" ::: "memory");
}
template <int NR, bool SILU>
__device__ __forceinline__ void small_mm_task(const float* __restrict__ src, size_t src_stride, const float* __restrict__ last_row, const float* __restrict__ W, int N,
                                              int k0, int n0, float* out, size_t out_stride, const float* __restrict__ bias, float* scr, int lane) {
#pragma unroll
    for (int r = 0; r < NR; ++r) {
        const float* sr = (last_row && r == NR - 1) ? last_row : src + (size_t)r * src_stride;
        float v = sr[k0 + lane];
        if (SILU) v = v / (1.0f + __expf(-v));
        scr[r * 64 + lane] = v;
    }
    __builtin_amdgcn_s_waitcnt(0xC07F); asm volatile("" ::: "memory");
    float acc[NR];
#pragma unroll
    for (int r = 0; r < NR; ++r) acc[r] = 0.f;
#pragma unroll 1
    for (int kk = 0; kk < 64; kk += 4) {
        const float w0 = W[(size_t)(k0 + kk + 0) * N + n0 + lane], w1 = W[(size_t)(k0 + kk + 1) * N + n0 + lane];
        const float w2 = W[(size_t)(k0 + kk + 2) * N + n0 + lane], w3 = W[(size_t)(k0 + kk + 3) * N + n0 + lane];
#pragma unroll
        for (int r = 0; r < NR; ++r) { const f32x4 s = *(const f32x4*)(scr + r * 64 + kk); acc[r] += s.x * w0 + s.y * w1 + s.z * w2 + s.w * w3; }
    }
    const float bv = (bias && k0 == 0) ? bias[n0 + lane] : 0.f;
#pragma unroll
    for (int r = 0; r < NR; ++r) atomicAdd(out + (size_t)r * out_stride + n0 + lane, acc[r] + bv);
    __builtin_amdgcn_s_waitcnt(0xC07F); asm volatile("" ::: "memory");
}

__device__ __forceinline__ void phase_prep_a(const Params& p, float* scr  , int gw, int NGW, int lane) {
    unsigned char* ws = p.ws;
    constexpr int T_MOD = (MODN / 64) * (DM / 64);
    constexpr int I_IN = (DM / 64) * (NQKV / 32), I_OUT = (DM / 64) * (DM / 32), I_1 = (DM / 64) * (FF / 32), I_2 = (FF / 64) * (DM / 32);
    constexpr int T_ALL = T_MOD + I_IN + I_OUT + I_1 + I_2 + 17;
    for (int t = gw; t < T_ALL; t += NGW) {
        int r = t;
        if (r < T_MOD) { const int nb = r % (MODN / 64), kc = r / (MODN / 64);
            small_mm_task<33, true>(p.c, DM, p.c_ctx, p.w_mod, MODN, kc * 64, nb * 64, (float*)(ws + WS_MOD), MODN, p.b_mod, scr, lane); continue; }
        r -= T_MOD;
        if (r < I_IN) { transpose_item<true>(p.w_in, DM, NQKV, (bf16_t*)(ws + WS_WIN), scr, r, lane); continue; } r -= I_IN;
        if (r < I_OUT) { transpose_item<false>(p.w_out, DM, DM, (bf16_t*)(ws + WS_WOUT), scr, r, lane); continue; } r -= I_OUT;
        if (r < I_1) { transpose_item<false>(p.w_fc1, DM, FF, (bf16_t*)(ws + WS_W1), scr, r, lane); continue; } r -= I_1;
        if (r < I_2) { transpose_item<false>(p.w_fc2, FF, DM, (bf16_t*)(ws + WS_W2), scr, r, lane); continue; } r -= I_2;
        if (r < 16) {
            const int pos = 4 * r + (lane >> 4), f = lane & 15;
            const float inv = powf(10000.0f, -(float)f / 16.0f);
            const float ang = (float)pos * inv;
            float* T = (float*)(ws + WS_ROPE) + (pos * 16 + f) * 2;
            T[0] = cosf(ang); T[1] = sinf(ang);
        } else {
            const float a = wave_sum(p.lam_q1[lane] * p.lam_k1[lane]), b = wave_sum(p.lam_q2[lane] * p.lam_k2[lane]);
            if (lane == 0) *(float*)(ws + WS_LAM) = expf(a) - expf(b) + LAM_INIT;
        }
    }
}
__device__ __forceinline__ void phase_prep_b(const Params& p, float* scr, int gw, int NGW, int lane) {
    unsigned char* ws = p.ws;
    const float* mod = (const float*)(ws + WS_MOD);
    constexpr int T_B1 = (FF / 64) * (DM / 64);
    for (int t = gw; t < T_B1; t += NGW) { const int nb = t % (FF / 64), kc = t / (FF / 64);
        small_mm_task<32, false>(mod + 3 * DM, MODN, nullptr, p.w_fc1, FF, kc * 64, nb * 64, (float*)(ws + WS_BIAS1), FF, nullptr, scr, lane); }
    bf16_t* A1 = (bf16_t*)(ws + WS_A1);
    for (int row = gw; row < MALL; row += NGW) {
        const float* xr; const float* mrow;
        if (row < MLAT) { xr = p.x + (size_t)row * DM; mrow = mod + (size_t)(row >> 11) * MODN; }
        else { xr = p.ctx + (size_t)(row - MLAT) * DM; mrow = mod + (size_t)32 * MODN; }
        f32x4 v[4]; float ss = 0.f;
#pragma unroll
        for (int j = 0; j < 4; ++j) { v[j] = *((const f32x4*)xr + lane + 64 * j); ss += (v[j].x * v[j].x + v[j].y * v[j].y) + (v[j].z * v[j].z + v[j].w * v[j].w); }
        const float rstd = rsqrtf(wave_sum(ss) * (1.0f / DM) + EPS);
#pragma unroll
        for (int j = 0; j < 4; ++j) {
            const int col = 4 * lane + 256 * j;
            const f32x4 g = *(const f32x4*)(p.norm1_g + col), sh = *(const f32x4*)(mrow + col), sc = *(const f32x4*)(mrow + DM + col);
            const f32x4 h = (v[j] * rstd) * g * (sc + 1.0f) + sh;
            u32x2 o; o.x = pk2(h.x, h.y); o.y = pk2(h.z, h.w);
            *(u32x2*)(A1 + (size_t)row * DM + col) = o;
        }
    }
}
#define LAS __attribute__((address_space(3)))
constexpr int LDS_SPARE = 131072;
struct E_QKV {
    static constexpr bool SSQ = false; static constexpr int PB = 4;
    bf16_t* qkv; bf16_t* kvc; LAS const float* rope;
    struct Col {};
    struct Pre { f32x4 t0, t1; };
    template <class U> __device__ __forceinline__ float rowval(const U&, int) const { return 0.f; }
    template <class U> __device__ __forceinline__ Col col_prep(const U&, int, int) const { return Col{}; }
    __device__ __forceinline__ static bool rope_cols(int col0) { return (col0 < 512) || (col0 >= 1024 && col0 < 1536); }
    __device__ __forceinline__ Pre preload(int row, int col0) const {
        Pre pr; pr.t0 = (f32x4){1.f, 0.f, 1.f, 0.f}; pr.t1 = pr.t0;
        if (row < MLAT && rope_cols(col0)) {
            const int s = row & (SEQ - 1), gr = s >> 6, gc = s & 63;
            const int i0 = (col0 & 63) >> 1, pos = (i0 >= 16) ? gc : gr, f0 = i0 & 15;
            LAS const f32x4* T = (LAS const f32x4*)(rope + (pos * 16 + f0) * 2);
            pr.t0 = T[0]; pr.t1 = T[1];
        }
        return pr;
    }
    __device__ __forceinline__ float epi8(int row, int col0, const Col&, const float (&a)[8], float, const Pre& pr) const {
        float v[8];
#pragma unroll
        for (int j = 0; j < 8; ++j) v[j] = a[j];
        if (row < MLAT) {
            if (rope_cols(col0)) {
                const float cs[4] = {pr.t0.x, pr.t0.z, pr.t1.x, pr.t1.z}, sn[4] = {pr.t0.y, pr.t0.w, pr.t1.y, pr.t1.w};
#pragma unroll
                for (int q = 0; q < 4; ++q) { const float x1 = v[2 * q], x2 = v[2 * q + 1]; v[2 * q] = x1 * cs[q] - x2 * sn[q]; v[2 * q + 1] = x1 * sn[q] + x2 * cs[q]; }
            }
            if (col0 < 1024) {
#pragma unroll
                for (int j = 0; j < 8; ++j) v[j] *= C2;
            }
            u32x4 o; o.x = pk2(v[0], v[1]); o.y = pk2(v[2], v[3]); o.z = pk2(v[4], v[5]); o.w = pk2(v[6], v[7]);
            *(u32x4*)(qkv + (size_t)row * NQKV + col0) = o;
        } else if (col0 >= 1024) {
            u32x4 o; o.x = pk2(v[0], v[1]); o.y = pk2(v[2], v[3]); o.z = pk2(v[4], v[5]); o.w = pk2(v[6], v[7]);
            *(u32x4*)(kvc + (size_t)(row - MLAT) * NKVC + (col0 - 1024)) = o;
        }
        return 0.f;
    }
};
struct E_OUT {
    static constexpr bool SSQ = true; static constexpr int PB = 2;
    const float* x; bf16_t* x1b; bf16_t* a2; const float* mod; const float* g2;
    struct Col { f32x4 ga0, ga1, gm0, gm1; };
    struct Pre { f32x4 x0, x4; };
    template <class U> __device__ __forceinline__ float rowval(const U&, int) const { return 0.f; }
    template <class U> __device__ __forceinline__ Col col_prep(const U&, int b, int col0) const {
        Col c; const float* m = mod + (size_t)b * MODN + col0;
        c.ga0 = *(const f32x4*)(m + 2 * DM); c.ga1 = *(const f32x4*)(m + 2 * DM + 4);
        c.gm0 = *(const f32x4*)(g2 + col0) * (*(const f32x4*)(m + 4 * DM) + 1.0f); c.gm1 = *(const f32x4*)(g2 + col0 + 4) * (*(const f32x4*)(m + 4 * DM + 4) + 1.0f);
        return c;
    }
    __device__ __forceinline__ Pre preload(int row, int col0) const { const size_t off = (size_t)row * DM + col0; Pre pr; pr.x0 = *(const f32x4*)(x + off); pr.x4 = *(const f32x4*)(x + off + 4); return pr; }
    __device__ __forceinline__ float epi8(int row, int col0, const Col& c, const float (&a)[8], float, const Pre& pr) const {
        const size_t off = (size_t)row * DM + col0;
        const f32x4 v0 = pr.x0 + c.ga0 * (f32x4){a[0], a[1], a[2], a[3]}, v1 = pr.x4 + c.ga1 * (f32x4){a[4], a[5], a[6], a[7]};
        { u32x4 xb; xb.x = pk2(v0.x, v0.y); xb.y = pk2(v0.z, v0.w); xb.z = pk2(v1.x, v1.y); xb.w = pk2(v1.z, v1.w); __builtin_nontemporal_store(xb, (u32x4*)(x1b + off)); }
        const f32x4 h0 = v0 * c.gm0, h1 = v1 * c.gm1;
        u32x4 o; o.x = pk2(h0.x, h0.y); o.y = pk2(h0.z, h0.w); o.z = pk2(h1.x, h1.y); o.w = pk2(h1.z, h1.w);
        *(u32x4*)(a2 + off) = o;
        const f32x4 q = v0 * v0 + v1 * v1;
        return (q.x + q.y) + (q.z + q.w);
    }
};
struct E_FC1 {
    static constexpr bool SSQ = false; static constexpr int PB = 4;
    LAS const float* tab; bf16_t* hid;
    struct Col { f32x4 b0, b1; };
    struct Pre {};
    __device__ __forceinline__ Pre preload(int, int) const { return Pre{}; }
    template <class U> __device__ __forceinline__ float rowval(const U& u, int row) const { return tab[u.aux * 512 + (row - u.pm * 256)]; }
    template <class U> __device__ __forceinline__ Col col_prep(const U& u, int, int col0) const { Col c; LAS const f32x4* t = (LAS const f32x4*)(tab + u.aux * 512 + 256 + (col0 - u.pn * 256)); c.b0 = t[0]; c.b1 = t[1]; return c; }
    __device__ __forceinline__ float epi8(int row, int col0, const Col& c, const float (&a)[8], float rv, const Pre&) const {
        const float bs[8] = {c.b0.x, c.b0.y, c.b0.z, c.b0.w, c.b1.x, c.b1.y, c.b1.z, c.b1.w};
        float v[8];
#pragma unroll
        for (int j = 0; j < 8; ++j) { const float z = fmaxf(rv * a[j] + bs[j], 0.f); v[j] = z * z; }
        u32x4 o; o.x = pk2(v[0], v[1]); o.y = pk2(v[2], v[3]); o.z = pk2(v[4], v[5]); o.w = pk2(v[6], v[7]);
        __builtin_nontemporal_store(o, (u32x4*)(hid + (size_t)row * FF + col0));
        return 0.f;
    }
};
struct E_FC2 {
    static constexpr bool SSQ = true; static constexpr int PB = 4;
    const bf16_t* x1b; float* xout; const float* mod;
    struct Col { f32x4 gm0, gm1; };
    struct Pre { u32x4 xb; };
    template <class U> __device__ __forceinline__ float rowval(const U&, int) const { return 0.f; }
    template <class U> __device__ __forceinline__ Col col_prep(const U&, int b, int col0) const { Col c; const float* m = mod + (size_t)b * MODN + 5 * DM + col0; c.gm0 = *(const f32x4*)m; c.gm1 = *(const f32x4*)(m + 4); return c; }
    __device__ __forceinline__ Pre preload(int row, int col0) const { Pre pr; pr.xb = *(const u32x4*)(x1b + (size_t)row * DM + col0); return pr; }
    __device__ __forceinline__ float epi8(int row, int col0, const Col& c, const float (&a)[8], float, const Pre& pr) const {
        const size_t off = (size_t)row * DM + col0;
        const f32x4 x0 = {bf_lo(pr.xb.x), bf_hi(pr.xb.x), bf_lo(pr.xb.y), bf_hi(pr.xb.y)}, x4 = {bf_lo(pr.xb.z), bf_hi(pr.xb.z), bf_lo(pr.xb.w), bf_hi(pr.xb.w)};
        const f32x4 v0 = x0 + c.gm0 * (f32x4){a[0], a[1], a[2], a[3]}, v1 = x4 + c.gm1 * (f32x4){a[4], a[5], a[6], a[7]};
        *(f32x4*)(xout + off) = v0; *(f32x4*)(xout + off + 4) = v1;
        const f32x4 q = v0 * v0 + v1 * v1;
        return (q.x + q.y) + (q.z + q.w);
    }
};

__device__ __forceinline__ int opaque_tid() { int t = threadIdx.x; asm volatile("" : "+v"(t)); return t; }
namespace pg8 {
#define PG8_LAS __attribute__((address_space(3)))
typedef unsigned short bf16_t;
typedef short bf16x8 __attribute__((ext_vector_type(8)));
typedef float f32x4 __attribute__((ext_vector_type(4)));
typedef unsigned u32x4 __attribute__((ext_vector_type(4)));
constexpr int BM = 256, BK = 64, HALF = 128, HTB = HALF * BK * 2  , STAGE_BYTES = 8 * HTB, NXCD = 8, WGM = 8;

__host__ __device__ __forceinline__ int lds_byte(int r, int c) { const int st = (r >> 4) * 2 + (c >> 5), rr = r & 15, cc = c & 31, ob = rr * 64 + cc * 2; return st * 1024 + (ob ^ (((ob >> 9) & 1) << 5)); }
__host__ __device__ __forceinline__ void stage_rc(int b, int& R, int& C) { const int st = b / 1024, sb = b % 1024, swz = sb ^ (((sb >> 9) & 1) << 5); R = (st >> 1) * 16 + swz / 64; C = (st & 1) * 32 + (swz % 64) / 2; }
__host__ __device__ __forceinline__ int perm32(int rho) { const int n = rho >> 4, i = rho & 15; return 8 * (i >> 2) + 4 * n + (i & 3); }

struct Unit { int pm, pn, aux; };
struct Gemm { const bf16_t* A; const bf16_t* Bt; int M, N, K; };

struct StaticOrder {
    int nM, nN, nwg, G, c;
    __host__ __device__ void init(int M, int N, int G_, int c_) { nM = M / BM; nN = N / BM; nwg = nM * nN; G = G_; c = c_; }
    __host__ __device__ bool next(int i, Unit& u) const {
        const long L = (long)i * G + c; if (L >= nwg) return false;
        int wgid = (int)L; { const int q = nwg / NXCD, r = nwg % NXCD, xcd = wgid % NXCD, off = wgid / NXCD; wgid = (xcd < r ? xcd * (q + 1) : r * (q + 1) + (xcd - r) * q) + off; }
        const int nig = WGM * nN, gid = wgid / nig, fm = gid * WGM, gsz = (nM - fm) < WGM ? (nM - fm) : WGM;
        u.pm = fm + ((wgid % nig) % gsz); u.pn = (wgid % nig) / gsz; return true;
    }
    __device__ __forceinline__ void a_ready(const Unit&) const {}
    __device__ __forceinline__ void done(const Unit&) const {}
};


template <class Epi, class Sched, bool ALIGN_EPI = false, bool SP2 = false>
__device__ __forceinline__ void gemm_phase(PG8_LAS unsigned char* lds, const Gemm g, const Sched& S, const Epi& E) {
    const int tid = opaque_tid(), wid = __builtin_amdgcn_readfirstlane(tid >> 6), lane = tid & 63, wr = wid >> 2, wc = wid & 3, fr = lane & 15, fq = lane >> 4;
    const int K = g.K, nt = K / BK;
    unsigned voffA[2], voffB[2];
#pragma unroll
    for (int i = 0; i < 2; ++i) { int R, C; stage_rc(tid * 16 + i * 8192, R, C); const int Rb = Epi::PERM ? ((R & ~31) + perm32(R & 31)) : R;
        voffA[i] = (unsigned)(R * K + C) * 2u; voffB[i] = (unsigned)(Rb * K + C) * 2u; }
    const size_t kstep = (size_t)(BK * 2);
    const size_t hstep = (size_t)HALF * K * 2;
    const size_t tstep = 2 * hstep;
    const unsigned ldsw = (unsigned)wid * 1024u;
    const int aoff = lds_byte(wr * 64 + fr, fq * 8), boff = lds_byte(wc * 32 + fr, fq * 8);
#define PG8_SA(b, h) (((b) * 2 + (h)) * HTB)
#define PG8_SB(b, h) ((4 + (b) * 2 + (h)) * HTB)
#define PG8_STAGE(bufoff, gbase, voff) do { _Pragma("unroll") for (int _i = 0; _i < 2; ++_i) \
        __builtin_amdgcn_global_load_lds((const unsigned*)((const char*)(gbase) + (voff)[_i]), (PG8_LAS unsigned*)(lds + (bufoff) + ldsw + _i * 8192), 16, 0, 0); } while (0)
#define PG8_LDA(dst, b, h) do { _Pragma("unroll") for (int m = 0; m < 4; ++m) _Pragma("unroll") for (int k = 0; k < 2; ++k) dst[m][k] = *(const PG8_LAS bf16x8*)(lds + PG8_SA(b, h) + aoff + m * 2048 + k * 1024); } while (0)
#define PG8_LDB(dst, b, h) do { _Pragma("unroll") for (int n = 0; n < 2; ++n) _Pragma("unroll") for (int k = 0; k < 2; ++k) dst[n][k] = *(const PG8_LAS bf16x8*)(lds + PG8_SB(b, h) + boff + n * 2048 + k * 1024); } while (0)
#define PG8_MMA(ai, bj, At, Bt) do { __builtin_amdgcn_s_setprio(1); _Pragma("unroll") for (int m = 0; m < 4; ++m) _Pragma("unroll") for (int n = 0; n < 2; ++n) _Pragma("unroll") for (int k = 0; k < 2; ++k) \
        acc[ai][bj][m][n] = __builtin_amdgcn_mfma_f32_16x16x32_bf16(Bt[n][k], At[m][k], acc[ai][bj][m][n], 0, 0, 0); __builtin_amdgcn_s_setprio(0); } while (0)
#define PG8_WAIT_V(n) asm volatile("s_waitcnt vmcnt(" #n ")" ::: "memory")
#define PG8_WAIT_L(n) asm volatile("s_waitcnt lgkmcnt(" #n ")" ::: "memory")
#define PG8_BAR __builtin_amdgcn_s_barrier()
#define PG8_SCHED __builtin_amdgcn_sched_barrier(0)
    Unit cur, nxt; int ui = 0;
    if (!S.next(0, cur)) return;
    f32x4 acc[2][2][4][2];
#pragma unroll
    for (int a = 0; a < 2; ++a)
#pragma unroll
        for (int b = 0; b < 2; ++b)
#pragma unroll
            for (int m = 0; m < 4; ++m)
#pragma unroll
                for (int n = 0; n < 2; ++n) acc[a][b][m][n] = (f32x4){0.f, 0.f, 0.f, 0.f};
    bf16x8 At[4][2], B0[2][2], B1[2][2];
    const char* cA = (const char*)g.A + (size_t)cur.pm * tstep; const char* cB = (const char*)g.Bt + (size_t)cur.pn * tstep;
    S.a_ready(cur);
    if constexpr (SP2) {
        PG8_STAGE(PG8_SB(0, 0), cB, voffB); PG8_STAGE(PG8_SB(0, 1), cB + hstep, voffB); PG8_STAGE(PG8_SA(0, 0), cA, voffA); PG8_STAGE(PG8_SA(0, 1), cA + hstep, voffA);
        if (wr == 1) PG8_BAR;
        PG8_WAIT_V(2); PG8_BAR;
        PG8_STAGE(PG8_SB(1, 0), cB + kstep, voffB); PG8_STAGE(PG8_SA(1, 0), cA + kstep, voffA); PG8_STAGE(PG8_SB(1, 1), cB + hstep + kstep, voffB);
        PG8_WAIT_V(6); PG8_BAR;
    } else {
        PG8_STAGE(PG8_SB(0, 0), cB, voffB); PG8_STAGE(PG8_SA(0, 0), cA, voffA); PG8_STAGE(PG8_SB(0, 1), cB + hstep, voffB); PG8_STAGE(PG8_SA(0, 1), cA + hstep, voffA);
        if (wr == 1) PG8_BAR;
        PG8_WAIT_V(4); PG8_BAR;
        PG8_STAGE(PG8_SB(1, 0), cB + kstep, voffB); PG8_STAGE(PG8_SA(1, 0), cA + kstep, voffA); PG8_STAGE(PG8_SB(1, 1), cB + hstep + kstep, voffB);
        PG8_WAIT_V(6); PG8_BAR;
    }
    for (;;) {
        const bool has_next = S.next(ui + 1, nxt);
        const char* nA = has_next ? (const char*)g.A + (size_t)nxt.pm * tstep : cA; const char* nB = has_next ? (const char*)g.Bt + (size_t)nxt.pn * tstep : cB;
        for (int t = 0; t < nt; t += 2) {
            const bool last = (t == nt - 2);
            const char* a1 = cA + (size_t)(t + 1) * kstep;
            const char* a2 = last ? nA : cA + (size_t)(t + 2) * kstep; const char* b2 = last ? nB : cB + (size_t)(t + 2) * kstep;
            const char* a3 = a2 + kstep; const char* b3 = b2 + kstep;
            if (last && has_next) S.a_ready(nxt);
            if constexpr (SP2) {
            PG8_LDB(B0, 0, 0); PG8_LDB(B1, 0, 1); PG8_SCHED; PG8_LDA(At, 0, 0); PG8_STAGE(PG8_SA(1, 1), a1 + hstep, voffA);
            PG8_WAIT_V(8); PG8_WAIT_L(0); PG8_BAR; PG8_MMA(0, 0, At, B0); PG8_MMA(0, 1, At, B1); PG8_BAR; PG8_SCHED;
            PG8_LDA(At, 0, 1); PG8_STAGE(PG8_SB(0, 0), b2, voffB); PG8_STAGE(PG8_SB(0, 1), b2 + hstep, voffB); PG8_STAGE(PG8_SA(0, 0), a2, voffA);
            PG8_WAIT_V(8); PG8_WAIT_L(0); PG8_BAR; PG8_MMA(1, 0, At, B0); PG8_MMA(1, 1, At, B1); PG8_BAR; PG8_SCHED;
            PG8_LDB(B0, 1, 0); PG8_LDB(B1, 1, 1); PG8_SCHED; PG8_LDA(At, 1, 0); PG8_STAGE(PG8_SA(0, 1), a2 + hstep, voffA);
            PG8_WAIT_V(8); PG8_WAIT_L(0); PG8_BAR; PG8_MMA(0, 0, At, B0); PG8_MMA(0, 1, At, B1); PG8_BAR; PG8_SCHED;
            PG8_LDA(At, 1, 1); PG8_STAGE(PG8_SB(1, 0), b3, voffB); PG8_STAGE(PG8_SB(1, 1), b3 + hstep, voffB); PG8_STAGE(PG8_SA(1, 0), a3, voffA);
            PG8_WAIT_V(8); PG8_WAIT_L(0); PG8_BAR; PG8_MMA(1, 0, At, B0); PG8_MMA(1, 1, At, B1); PG8_BAR; PG8_SCHED;
            } else {
            PG8_LDB(B0, 0, 0); PG8_SCHED; PG8_LDA(At, 0, 0); PG8_STAGE(PG8_SA(1, 1), a1 + hstep, voffA);
            PG8_WAIT_L(8); PG8_BAR; PG8_WAIT_L(0); PG8_MMA(0, 0, At, B0); PG8_BAR; PG8_SCHED;
            PG8_LDB(B1, 0, 1); PG8_STAGE(PG8_SB(0, 0), b2, voffB);
            PG8_BAR; PG8_WAIT_L(0); PG8_MMA(0, 1, At, B1); PG8_BAR;
            PG8_LDA(At, 0, 1); PG8_STAGE(PG8_SA(0, 0), a2, voffA);
            PG8_BAR; PG8_WAIT_L(0); PG8_MMA(1, 0, At, B0); PG8_BAR; PG8_SCHED;
            PG8_STAGE(PG8_SB(0, 1), b2 + hstep, voffB);
            PG8_WAIT_V(6); PG8_BAR; PG8_MMA(1, 1, At, B1); PG8_BAR;
            PG8_LDB(B0, 1, 0); PG8_SCHED; PG8_LDA(At, 1, 0); PG8_STAGE(PG8_SA(0, 1), a2 + hstep, voffA);
            PG8_WAIT_L(8); PG8_BAR; PG8_WAIT_L(0); PG8_MMA(0, 0, At, B0); PG8_BAR; PG8_SCHED;
            PG8_LDB(B1, 1, 1); PG8_STAGE(PG8_SB(1, 0), b3, voffB);
            PG8_BAR; PG8_WAIT_L(0); PG8_MMA(0, 1, At, B1); PG8_BAR;
            PG8_LDA(At, 1, 1); PG8_STAGE(PG8_SA(1, 0), a3, voffA);
            PG8_BAR; PG8_WAIT_L(0); PG8_MMA(1, 0, At, B0); PG8_BAR; PG8_SCHED;
            PG8_STAGE(PG8_SB(1, 1), b3 + hstep, voffB);
            PG8_WAIT_V(6); PG8_BAR; PG8_MMA(1, 1, At, B1); PG8_BAR;
            }
        }
        if constexpr (ALIGN_EPI) { if (wr == 0) PG8_BAR; }
        if constexpr (!Epi::AFTER_DRAIN) { E(acc, cur, wr, wc, fr, fq); S.done(cur); }
        if (!has_next) break;
#pragma unroll
        for (int a = 0; a < 2; ++a)
#pragma unroll
            for (int b = 0; b < 2; ++b)
#pragma unroll
                for (int m = 0; m < 4; ++m)
#pragma unroll
                    for (int n = 0; n < 2; ++n) acc[a][b][m][n] = (f32x4){0.f, 0.f, 0.f, 0.f};
        cur = nxt; cA = nA; cB = nB; ++ui;
        if constexpr (ALIGN_EPI) { if (wr == 1) PG8_BAR; }
    }
    PG8_WAIT_V(0);
    if constexpr (!ALIGN_EPI) { if (wr == 0) PG8_BAR; }
    PG8_BAR;
    if constexpr (Epi::AFTER_DRAIN) { E.fused(acc, cur, wr, wc, fr, fq, lds, wid, lane); S.done(cur); }
#undef PG8_SA
#undef PG8_SB
#undef PG8_STAGE
#undef PG8_LDA
#undef PG8_LDB
#undef PG8_MMA
#undef PG8_WAIT_V
#undef PG8_WAIT_L
#undef PG8_BAR
#undef PG8_SCHED
}
}


template <class E8> struct EpiWrap {
    static constexpr bool PERM = true, AFTER_DRAIN = false;
    E8 e; float* ssq;
    __device__ __forceinline__ void operator()(const pg8::f32x4 (&acc)[2][2][4][2], const pg8::Unit& u, int wr, int wc, int fr, int fq) const {
        const int rowb = u.pm * 256 + wr * 64 + fr;
        const int b = (u.pm < 256) ? (u.pm >> 3) : 0;
        float rv[2][4], ss[2][4];
#pragma unroll
        for (int ai = 0; ai < 2; ++ai)
#pragma unroll
            for (int m = 0; m < 4; ++m) { rv[ai][m] = e.rowval(u, rowb + ai * 128 + m * 16); ss[ai][m] = 0.f; }
#pragma unroll
        for (int bj = 0; bj < 2; ++bj) {
            const int col0 = u.pn * 256 + bj * 128 + wc * 32 + 8 * fq;
            const typename E8::Col cc = e.col_prep(u, b, col0);
#pragma unroll
            for (int ai = 0; ai < 2; ++ai)
#pragma unroll
                for (int mb = 0; mb < 4; mb += E8::PB) {
                    typename E8::Pre pre[E8::PB];
#pragma unroll
                    for (int m = 0; m < E8::PB; ++m) pre[m] = e.preload(rowb + ai * 128 + (mb + m) * 16, col0);
#pragma unroll
                    for (int m = 0; m < E8::PB; ++m) {
                        const pg8::f32x4 v0 = acc[ai][bj][mb + m][0], v1 = acc[ai][bj][mb + m][1];
                        const float a[8] = {v0[0], v0[1], v0[2], v0[3], v1[0], v1[1], v1[2], v1[3]};
                        ss[ai][mb + m] += e.epi8(rowb + ai * 128 + (mb + m) * 16, col0, cc, a, rv[ai][mb + m], pre[m]);
                    }
                    asm volatile("" ::: "memory");
                }
        }
        if (E8::SSQ) {
#pragma unroll
            for (int ai = 0; ai < 2; ++ai)
#pragma unroll
                for (int m = 0; m < 4; ++m) { float s = ss[ai][m]; s += __shfl_xor(s, 16); s += __shfl_xor(s, 32);
                    if (fq == 0) ssq[(size_t)(rowb + ai * 128 + m * 16) * 16 + u.pn * 4 + wc] = s; }
        }
    }
};
__device__ __forceinline__ void glds16(const void* gsrc, unsigned lds_dst) { unsigned keep;
    asm volatile("s_mov_b32 %0, m0\n\ts_mov_b32 m0, %2\n\ts_nop 0\n\tglobal_load_lds_dwordx4 %1, off\n\ts_mov_b32 m0, %0" : "=&s"(keep) : "v"(gsrc), "s"(lds_dst) : "memory"); }
struct QkvOrder {
    pg8::StaticOrder base; int G, c;
    __device__ __forceinline__ void init(int G_, int c_) { base.init(MLAT, NQKV, G_, c_); G = G_; c = c_; }
    __device__ __forceinline__ bool next(int i, pg8::Unit& u) const {
        u.aux = 0;
        if (base.next(i, u)) return true;
        const long L = (long)i * G + c - base.nwg; if (L < 0 || L >= 256) return false;
        const int id = (int)L, w = (id & 7) * 32 + (id >> 3);
        u.pm = 256 + (w >> 3); u.pn = 4 + (w & 7); return true;
    }
    __device__ __forceinline__ void a_ready(const pg8::Unit&) const {}
    __device__ __forceinline__ void done(const pg8::Unit&) const {}
};
__device__ __forceinline__ void phase_qkv(const Params& p, LAS unsigned char* lds) {
    unsigned char* ws = p.ws;
    pg8::Gemm g{(const bf16_t*)(ws + WS_A1), (const bf16_t*)(ws + WS_WIN), MALL, NQKV, DM};
    QkvOrder S; S.init((int)gridDim.x, (int)blockIdx.x);
    {   const int t = opaque_tid();
        *(LAS f32x4*)(lds + LDS_SPARE + t * 16) = *(const f32x4*)(ws + WS_ROPE + t * 16);
        __syncthreads(); }
    EpiWrap<E_QKV> E{{(bf16_t*)(ws + WS_QKV), (bf16_t*)(ws + WS_KVC), (LAS const float*)(lds + LDS_SPARE)}, nullptr};
    pg8::gemm_phase<EpiWrap<E_QKV>, QkvOrder, true, true>(lds, g, S, E);
}
__device__ __forceinline__ void phase_outproj(const Params& p, LAS unsigned char* lds) {
    unsigned char* ws = p.ws;
    pg8::Gemm g{(const bf16_t*)(ws + WS_MIX), (const bf16_t*)(ws + WS_WOUT), MLAT, DM, DM};
    pg8::StaticOrder S; S.init(MLAT, DM, (int)gridDim.x, (int)blockIdx.x);
    EpiWrap<E_OUT> E{{p.x, (bf16_t*)(ws + WS_X1B), (bf16_t*)(ws + WS_A2), (const float*)(ws + WS_MOD), p.norm2_g}, (float*)(ws + WS_SSQ1)};
    pg8::gemm_phase<EpiWrap<E_OUT>, pg8::StaticOrder, true, true>(lds, g, S, E);
}
struct Fc1Order {
    pg8::StaticOrder base; const float* rstd; const float* bias1; unsigned tab_lds;
    __device__ __forceinline__ bool next(int i, pg8::Unit& u) const { u.aux = i & 1; return base.next(i, u); }
    __device__ __forceinline__ void a_ready(const pg8::Unit& u) const {
        const int wid = __builtin_amdgcn_readfirstlane(threadIdx.x >> 6), lane = threadIdx.x & 63;
        if (wid == 0) glds16(rstd + (size_t)u.pm * 256 + lane * 4, (unsigned)__builtin_amdgcn_readfirstlane(tab_lds + u.aux * 2048));
        else if (wid == 1) glds16(bias1 + (size_t)(u.pm >> 3) * FF + u.pn * 256 + lane * 4, (unsigned)__builtin_amdgcn_readfirstlane(tab_lds + u.aux * 2048 + 1024));
    }
    __device__ __forceinline__ void done(const pg8::Unit&) const {}
};
__device__ __forceinline__ void phase_rstd1(const Params& p) {
    const float* ssq = (const float*)(p.ws + WS_SSQ1); float* rs = (float*)(p.ws + WS_RSTD1);
    for (int row = blockIdx.x * 512 + opaque_tid(); row < MLAT; row += gridDim.x * 512) {
        const f32x4* s = (const f32x4*)(ssq + (size_t)row * 16); const f32x4 a = s[0], b = s[1], c = s[2], d = s[3];
        const float t = ((a.x + a.y) + (a.z + a.w)) + ((b.x + b.y) + (b.z + b.w)) + ((c.x + c.y) + (c.z + c.w)) + ((d.x + d.y) + (d.z + d.w));
        rs[row] = rsqrtf(t * (1.0f / DM) + EPS);
    }
}
__device__ __forceinline__ void phase_fc1(const Params& p, LAS unsigned char* lds) {
    unsigned char* ws = p.ws;
    pg8::Gemm g{(const bf16_t*)(ws + WS_A2), (const bf16_t*)(ws + WS_W1), MLAT, FF, DM};
    Fc1Order S; S.base.init(MLAT, FF, (int)gridDim.x, (int)blockIdx.x); S.rstd = (const float*)(ws + WS_RSTD1); S.bias1 = (const float*)(ws + WS_BIAS1); S.tab_lds = (unsigned)(uintptr_t)(lds + LDS_SPARE);
    EpiWrap<E_FC1> E{{(LAS const float*)(lds + LDS_SPARE), (bf16_t*)(ws + WS_HID)}, nullptr};
    pg8::gemm_phase<EpiWrap<E_FC1>, Fc1Order, true, true>(lds, g, S, E);
}
__device__ __forceinline__ void phase_fc2(const Params& p, LAS unsigned char* lds) {
    unsigned char* ws = p.ws;
    pg8::Gemm g{(const bf16_t*)(ws + WS_HID), (const bf16_t*)(ws + WS_W2), MLAT, DM, FF};
    pg8::StaticOrder S; S.init(MLAT, DM, (int)gridDim.x, (int)blockIdx.x);
    EpiWrap<E_FC2> E{{(const bf16_t*)(ws + WS_X1B), p.out, (const float*)(ws + WS_MOD)}, (float*)(ws + WS_SSQ2)};
    pg8::gemm_phase<EpiWrap<E_FC2>, pg8::StaticOrder, true, true>(lds, g, S, E);
}
constexpr int LDS_BYTES = 163840;

namespace att {
typedef short bf16x8 __attribute__((ext_vector_type(8)));
typedef short s16x4 __attribute__((ext_vector_type(4)));
typedef short v4i16_t __attribute__((ext_vector_type(4)));
typedef float f32x16 __attribute__((ext_vector_type(16)));
constexpr int NBUF = 4, RING_BUF = 32768;
constexpr int OFF_STAGE = 0;
constexpr int OFF_WSF = 135168;
constexpr int OFF_RPB = 137216;
constexpr float THR = 8.0f;
__device__ __forceinline__ int crow(int r, int hi) { return (r & 3) + 8 * (r >> 2) + 4 * hi; }
__device__ __forceinline__ s16x4 vtr(LAS const unsigned char* p) { return __builtin_bit_cast(s16x4, __builtin_amdgcn_ds_read_tr16_b64_v4i16((LAS v4i16_t*)p)); }
struct TileSrc { const bf16_t* k; const bf16_t* v; int pitch; };
template <bool DIFF> __device__ __forceinline__ void tile_dma(const TileSrc& s, unsigned ldsbuf, int wid, int lane) {
    if (DIFF) {
#pragma unroll
        for (int i = 0; i < 2; ++i) { const int pc = wid * 2 + i, key = pc * 4 + (lane >> 4), u = lane & 15;
            glds16(s.k + (size_t)key * s.pitch + ((u ^ (key & 15)) << 3), (unsigned)__builtin_amdgcn_readfirstlane(ldsbuf + pc * 1024));
            glds16(s.v + (size_t)key * s.pitch + (((u >> 2) ^ (key & 3)) << 5) + ((u & 3) << 3), (unsigned)__builtin_amdgcn_readfirstlane(ldsbuf + 16384 + pc * 1024)); }
    } else {
        const int key = wid * 8 + (lane >> 3), u = lane & 7;
        glds16(s.k + (size_t)key * s.pitch + ((u ^ ((key >> 1) & 7)) << 3), (unsigned)__builtin_amdgcn_readfirstlane(ldsbuf + wid * 1024));
        glds16(s.v + (size_t)key * s.pitch + (((u >> 2) ^ ((key >> 1) & 1)) << 5) + ((u & 3) << 3), (unsigned)__builtin_amdgcn_readfirstlane(ldsbuf + 8192 + wid * 1024));
    }
}
template <bool DIFF> struct Lay { int koff[4]; int vb[DIFF ? 4 : 2]; };
template <bool DIFF> __device__ __forceinline__ void lay_init(Lay<DIFF>& L, int lane, int map) {
    const int r32 = lane & 31, hi = lane >> 5, q = (lane & 15) >> 2, g1 = (lane >> 4) & 1, pp = lane & 3;
#pragma unroll
    for (int d0 = 0; d0 < 4; ++d0) L.koff[d0] = DIFF ? r32 * 256 + (((8 * map + 2 * d0 + hi) ^ (r32 & 15)) << 4) : r32 * 128 + (((2 * d0 + hi) ^ ((r32 >> 1) & 7)) << 4);
#pragma unroll
    for (int c = 0; c < (DIFF ? 4 : 2); ++c) L.vb[c] = DIFF ? (4 * hi + q) * 256 + ((c ^ q) << 6) + g1 * 32 + pp * 8 : (4 * hi + q) * 128 + ((c ^ ((q >> 1) & 1)) << 6) + g1 * 32 + pp * 8;
}
#define ATT_BAR() asm volatile("s_waitcnt lgkmcnt(0)\n\ts_barrier" ::: "memory")
#define ATT_WAIT_BAR(N) asm volatile("s_waitcnt vmcnt(" #N ") lgkmcnt(0)\n\ts_barrier" ::: "memory")
template <int NC> struct WaveState { f32x16 o[NC]; f32x16 p0, p1; u32x4 pw[4]; float m, l; bf16x8 qr[4]; };
template <bool DIFF> __device__ __forceinline__ void qkt(f32x16& p0, f32x16& p1, LAS const unsigned char* kimg, const Lay<DIFF>& L, const bf16x8 (&qr)[4]) {
#pragma unroll
    for (int r = 0; r < 16; ++r) { p0[r] = 0.f; p1[r] = 0.f; }
#pragma unroll
    for (int d0 = 0; d0 < 4; ++d0) {
        const bf16x8 b0 = *(LAS const bf16x8*)(kimg + L.koff[d0]), b1 = *(LAS const bf16x8*)(kimg + L.koff[d0] + (DIFF ? 8192 : 4096));
        p0 = __builtin_amdgcn_mfma_f32_32x32x16_bf16(b0, qr[d0], p0, 0, 0, 0);
        p1 = __builtin_amdgcn_mfma_f32_32x32x16_bf16(b1, qr[d0], p1, 0, 0, 0);
    }
}
template <bool DIFF, int NC> __device__ __forceinline__ void pv(WaveState<NC>& st, LAS const unsigned char* vimg, const Lay<DIFF>& L) {
    constexpr int SS = DIFF ? 4096 : 2048;
#pragma unroll
    for (int c = 0; c < NC; ++c)
#pragma unroll
        for (int s = 0; s < 4; ++s) {
            const s16x4 lo = vtr(vimg + L.vb[c] + s * SS), hv = vtr(vimg + L.vb[c] + s * SS + SS / 2);
            const bf16x8 vf = {lo[0], lo[1], lo[2], lo[3], hv[0], hv[1], hv[2], hv[3]};
            st.o[c] = __builtin_amdgcn_mfma_f32_32x32x16_bf16(__builtin_bit_cast(bf16x8, st.pw[s]), vf, st.o[c], 0, 0, 0);
        }
}
template <bool DIFF, int NC, bool DO_PV, bool DO_QK> __device__ __forceinline__ void mblock(WaveState<NC>& st, LAS const unsigned char* vimg, LAS const unsigned char* kimg, const Lay<DIFF>& L) {
    if (DO_PV) pv<DIFF, NC>(st, vimg, L);
    if (DO_QK) qkt<DIFF>(st.p0, st.p1, kimg, L, st.qr);
    constexpr int NM = (DO_PV ? NC * 4 : 0) + (DO_QK ? 8 : 0);
    __builtin_amdgcn_sched_group_barrier(0x100, 6, 0);
#pragma unroll
    for (int i = 0; i < NM; ++i) { __builtin_amdgcn_sched_group_barrier(0x008, 1, 0); __builtin_amdgcn_sched_group_barrier(0x100, 2, 0); }
}
template <int NC> __device__ __forceinline__ void softmax_block(WaveState<NC>& st, LAS float* wsf, int r32, int hi) {
    f32x16& p0 = st.p0; f32x16& p1 = st.p1;
    float mx = fmaxf(p0[0], p1[0]);
#pragma unroll
    for (int r = 1; r < 16; ++r) mx = fmaxf(mx, fmaxf(p0[r], p1[r]));
    mx = fmaxf(mx, __shfl_xor(mx, 32));
    if (__any(mx > st.m + THR)) {
        const float mn = fmaxf(st.m, mx), alpha = __builtin_amdgcn_exp2f(st.m - mn);
        st.m = mn; st.l *= alpha;
        if (hi == 0) wsf[r32] = alpha;
#pragma unroll
        for (int r = 0; r < 16; ++r) { const float a = wsf[crow(r, hi)];
#pragma unroll
            for (int c = 0; c < NC; ++c) st.o[c][r] *= a; }
    }
    float rs = 0.f;
#pragma unroll
    for (int r = 0; r < 16; ++r) { p0[r] = __builtin_amdgcn_exp2f(p0[r] - st.m); p1[r] = __builtin_amdgcn_exp2f(p1[r] - st.m); rs += p0[r] + p1[r]; }
    st.l += rs;
#pragma unroll
    for (int i = 0; i < 4; ++i) { st.pw[0][i] = pk2(p0[2 * i], p0[2 * i + 1]); st.pw[1][i] = pk2(p0[8 + 2 * i], p0[9 + 2 * i]); st.pw[2][i] = pk2(p1[2 * i], p1[2 * i + 1]); st.pw[3][i] = pk2(p1[8 + 2 * i], p1[9 + 2 * i]); }
}
template <int NC> __device__ __forceinline__ void state_init(WaveState<NC>& st, const bf16_t* qrow) {
#pragma unroll
    for (int d0 = 0; d0 < 4; ++d0) st.qr[d0] = *(const bf16x8*)(qrow + 16 * d0);
#pragma unroll
    for (int c = 0; c < NC; ++c)
#pragma unroll
        for (int r = 0; r < 16; ++r) st.o[c][r] = 0.f;
#pragma unroll
    for (int s = 0; s < 4; ++s) st.pw[s] = (u32x4){0u, 0u, 0u, 0u};
    st.m = NEGBIG; st.l = 0.f;
}

struct DiffCtx { const bf16_t* qkv; const bf16_t* kvc; int b, h; unsigned lds0; int wid, lane; };
__device__ __forceinline__ TileSrc diff_tile(const DiffCtx& c, int t) {
    if (t < 32) { const bf16_t* base = c.qkv + (size_t)(c.b * SEQ + t * 64) * NQKV; return TileSrc{base + 1024 + 128 * c.h, base + 2048 + 128 * c.h, NQKV}; }
    const bf16_t* base = c.kvc + (size_t)(c.b * CTX + (t - 32) * 64) * NKVC; return TileSrc{base + 128 * c.h, base + 1024 + 128 * c.h, NKVC};
}
__device__ __forceinline__ float max3f(float a, float b, float c) { float r; asm("v_max3_f32 %0, %1, %2, %3" : "=v"(r) : "v"(a), "v"(b), "v"(c)); return r; }
__device__ __forceinline__ float rowmax32(const f32x16& p0, const f32x16& p1) {
    float a = max3f(p0[0], p0[1], p1[0]), b = max3f(p0[2], p0[3], p1[1]); a = max3f(a, p1[2], p1[3]);
#pragma unroll
    for (int r = 4; r < 16; r += 4) { a = max3f(a, p0[r], p0[r + 1]); b = max3f(b, p0[r + 2], p0[r + 3]); a = max3f(a, p1[r], p1[r + 1]); b = max3f(b, p1[r + 2], p1[r + 3]); }
    float m = max3f(a, b, b);
    auto rr = __builtin_amdgcn_permlane32_swap(__float_as_uint(m), __float_as_uint(m), false, false);
    return max3f(__uint_as_float(rr[0]), __uint_as_float(rr[1]), __uint_as_float(rr[1]));
}
__device__ __forceinline__ void exp_pack(const f32x16& s0, const f32x16& s1, const float m, u32x4 (&pw)[4], float& rs_out) {
    float p0[16], p1[16]; float rs = 0.f;
#pragma unroll
    for (int r = 0; r < 16; ++r) { p0[r] = __builtin_amdgcn_exp2f(s0[r] - m); p1[r] = __builtin_amdgcn_exp2f(s1[r] - m); rs += p0[r] + p1[r]; }
    rs_out = rs;
#pragma unroll
    for (int i = 0; i < 4; ++i) { pw[0][i] = pk2(p0[2 * i], p0[2 * i + 1]); pw[1][i] = pk2(p0[8 + 2 * i], p0[9 + 2 * i]); pw[2][i] = pk2(p1[2 * i], p1[2 * i + 1]); pw[3][i] = pk2(p1[8 + 2 * i], p1[9 + 2 * i]); }
}
__device__ __forceinline__ void exp_pack_rel(const f32x16& s0, const f32x16& s1, u32x4 (&pw)[4], float& rs_out) {
    float p0[16], p1[16]; float rs = 0.f;
#pragma unroll
    for (int r = 0; r < 16; ++r) { p0[r] = __builtin_amdgcn_exp2f(s0[r]); p1[r] = __builtin_amdgcn_exp2f(s1[r]); rs += p0[r] + p1[r]; }
    rs_out = rs;
#pragma unroll
    for (int i = 0; i < 4; ++i) { pw[0][i] = pk2(p0[2 * i], p0[2 * i + 1]); pw[1][i] = pk2(p0[8 + 2 * i], p0[9 + 2 * i]); pw[2][i] = pk2(p1[2 * i], p1[2 * i + 1]); pw[3][i] = pk2(p1[8 + 2 * i], p1[9 + 2 * i]); }
}
template <bool DIFF> __device__ __forceinline__ void qkt_from(f32x16& p0, f32x16& p1, const f32x16& init, LAS const unsigned char* kimg, const Lay<DIFF>& L, const bf16x8 (&qr)[4]) {
#pragma unroll
    for (int d0 = 0; d0 < 4; ++d0) {
        const bf16x8 b0 = *(LAS const bf16x8*)(kimg + L.koff[d0]), b1 = *(LAS const bf16x8*)(kimg + L.koff[d0] + (DIFF ? 8192 : 4096));
        p0 = __builtin_amdgcn_mfma_f32_32x32x16_bf16(b0, qr[d0], d0 == 0 ? init : p0, 0, 0, 0);
        p1 = __builtin_amdgcn_mfma_f32_32x32x16_bf16(b1, qr[d0], d0 == 0 ? init : p1, 0, 0, 0);
    }
}
__device__ __forceinline__ void diff_loop3(WaveState<4>& st, f32x16& negm, const DiffCtx& c, LAS unsigned char* lds, LAS float* wsf, const Lay<true>& L, int r32, int hi) {
    constexpr int NT = 36;
    for (int t = 0; t < NT; ++t) {
        if (t + 2 < NT) tile_dma<true>(diff_tile(c, t + 2), c.lds0 + ((t + 2) & 3) * RING_BUF, c.wid, c.lane);
        const int tv = t ? t - 1 : 0, tk = (t + 1 < NT) ? t + 1 : t;
        const float mx = rowmax32(st.p0, st.p1);
        const bool need = __any(mx > THR) || t == 0;
        float alpha = 1.f;
        if (need) {
            const float dm = (t == 0) ? mx : fmaxf(mx, 0.f);
            alpha = (t == 0) ? 0.f : __builtin_amdgcn_exp2f(-dm);
            st.m += dm;
#pragma unroll
            for (int r = 0; r < 16; ++r) { st.p0[r] -= dm; st.p1[r] -= dm; negm[r] = -st.m; }
        }
        u32x4 pwn[4]; float rs; f32x16 n0, n1;
        exp_pack_rel(st.p0, st.p1, pwn, rs);
        pv<true, 4>(st, lds + (tv & 3) * RING_BUF + 16384, L);
        qkt_from<true>(n0, n1, negm, lds + (tk & 3) * RING_BUF, L, st.qr);
        __builtin_amdgcn_sched_group_barrier(0x100, 6, 0);
#pragma unroll
        for (int i = 0; i < 24; ++i) { __builtin_amdgcn_sched_group_barrier(0x008, 1, 0); __builtin_amdgcn_sched_group_barrier(0x100, 2, 0); __builtin_amdgcn_sched_group_barrier(0x402, 4, 0); }
        asm volatile("" : "+v"(pwn[0]), "+v"(pwn[1]), "+v"(pwn[2]), "+v"(pwn[3]), "+v"(rs));
        if (need) {
            if (hi == 0) wsf[r32] = alpha;
#pragma unroll
            for (int r = 0; r < 16; ++r) { const float a = wsf[crow(r, hi)];
#pragma unroll
                for (int cc = 0; cc < 4; ++cc) st.o[cc][r] *= a; }
            st.l *= alpha;
        }
        st.l += rs;
#pragma unroll
        for (int s = 0; s < 4; ++s) st.pw[s] = pwn[s];
        st.p0 = n0; st.p1 = n1;
        ATT_WAIT_BAR(0);
    }
    pv<true, 4>(st, lds + ((NT - 1) & 3) * RING_BUF + 16384, L);
    ATT_WAIT_BAR(0);
}
__device__ __forceinline__ void diff_unit(const Params& p, LAS unsigned char* lds, const int tid_in, int b, int h, int qb, float lam) {
    int tid = tid_in; asm volatile("" : "+v"(tid));
    const int lane = tid & 63, r32 = lane & 31, hi = lane >> 5, wid = __builtin_amdgcn_readfirstlane(tid >> 6), rg = wid & 3, map = wid >> 2;
    const bf16_t* qkv = (const bf16_t*)(p.ws + WS_QKV); bf16_t* mix = (bf16_t*)(p.ws + WS_MIX);
    LAS float* wsf = (LAS float*)(lds + OFF_WSF) + wid * 64;
    Lay<true> L; lay_init<true>(L, lane, map);
    const DiffCtx c{qkv, (const bf16_t*)(p.ws + WS_KVC), b, h, (unsigned)(uintptr_t)lds, wid, lane};
    tile_dma<true>(diff_tile(c, 0), c.lds0, wid, lane); tile_dma<true>(diff_tile(c, 1), c.lds0 + RING_BUF, wid, lane);
    WaveState<4> st;
    state_init<4>(st, qkv + (size_t)(b * SEQ + qb * 128 + rg * 32 + r32) * NQKV + 128 * h + 64 * map + 8 * hi);
    ATT_WAIT_BAR(0);
    f32x16 negm;
#pragma unroll
    for (int r = 0; r < 16; ++r) negm[r] = 0.f;
    st.m = 0.f;
    qkt<true>(st.p0, st.p1, lds, L, st.qr);
    diff_loop3(st, negm, c, lds, wsf, L, r32, hi);
    {   int tid2 = tid; asm volatile("" : "+v"(tid2));
        const int lane2 = tid2 & 63, r32b = lane2 & 31, hib = lane2 >> 5;
        float lt = st.l + __shfl_xor(st.l, 32);
        if (hib == 0) wsf[r32b] = 1.0f / lt;
        LAS float* stg = (LAS float*)(lds + OFF_STAGE);
#pragma unroll
        for (int r = 0; r < 16; ++r) { const float inv = wsf[crow(r, hib)]; const int R = map * 128 + rg * 32 + crow(r, hib);
#pragma unroll
            for (int cc = 0; cc < 4; ++cc) stg[R * 132 + 32 * cc + r32b] = st.o[cc][r] * inv; }
        __syncthreads();
        const int row = tid2 >> 2, part = tid2 & 3;
        float o[32]; float ss = 0.f;
#pragma unroll
        for (int i = 0; i < 8; ++i) { const f32x4 a = *(LAS const f32x4*)(stg + row * 132 + part * 32 + 4 * i), bb = *(LAS const f32x4*)(stg + (128 + row) * 132 + part * 32 + 4 * i);
#pragma unroll
            for (int e = 0; e < 4; ++e) { const float v = a[e] - lam * bb[e]; o[4 * i + e] = v; ss += v * v; } }
        ss += __shfl_xor(ss, 1); ss += __shfl_xor(ss, 2);
        const float rstd = rsqrtf(ss * (1.0f / 128.0f) + EPS) * (1.0f - LAM_INIT);
        bf16_t* dst = mix + (size_t)(b * SEQ + qb * 128 + row) * DM + 128 * h + part * 32;
#pragma unroll
        for (int i = 0; i < 4; ++i) { const f32x4 g0 = *(const f32x4*)(p.subln_g + part * 32 + 8 * i), g1 = *(const f32x4*)(p.subln_g + part * 32 + 8 * i + 4);
            u32x4 w; w.x = pk2(o[8 * i] * rstd * g0.x, o[8 * i + 1] * rstd * g0.y); w.y = pk2(o[8 * i + 2] * rstd * g0.z, o[8 * i + 3] * rstd * g0.w);
            w.z = pk2(o[8 * i + 4] * rstd * g1.x, o[8 * i + 5] * rstd * g1.y); w.w = pk2(o[8 * i + 6] * rstd * g1.z, o[8 * i + 7] * rstd * g1.w);
            *(u32x4*)(dst + 8 * i) = w; }
        asm volatile("s_waitcnt vmcnt(0)" ::: "memory");
        __syncthreads();
    }
}
constexpr int NA_SLOT = 16384;
constexpr float MASKV = -3.0e38f;
struct NaCtx { const bf16_t* qkv; const bf16_t* kvc; int b, hh, lo0, nrows; unsigned lds0; int wid, lane; };
__device__ __forceinline__ TileSrc na_tile(const NaCtx& c, int i) {
    if (i < c.nrows) { const bf16_t* base = c.qkv + (size_t)(c.b * SEQ + (c.lo0 + i) * 64) * NQKV; return TileSrc{base + 1536 + 64 * c.hh, base + 2560 + 64 * c.hh, NQKV}; }
    const bf16_t* base = c.kvc + (size_t)(c.b * CTX + (i - c.nrows) * 64) * NKVC; return TileSrc{base + 512 + 64 * c.hh, base + 1536 + 64 * c.hh, NKVC};
}
struct NaState { f32x16 o[2]; f32x16 s0, s1; u32x4 pw[4]; float m, l; bf16x8 qr[4]; };
template <int NK> __device__ __forceinline__ void na_pv(NaState& st, LAS const unsigned char* vimg, const int (&vb)[2]) {
#pragma unroll
    for (int cc = 0; cc < 2; ++cc)
#pragma unroll
        for (int s = 0; s < NK; ++s) {
            const s16x4 lo = vtr(vimg + vb[cc] + s * 2048), hv = vtr(vimg + vb[cc] + s * 2048 + 1024);
            const bf16x8 vf = {lo[0], lo[1], lo[2], lo[3], hv[0], hv[1], hv[2], hv[3]};
            st.o[cc] = __builtin_amdgcn_mfma_f32_32x32x16_bf16(__builtin_bit_cast(bf16x8, st.pw[s]), vf, st.o[cc], 0, 0, 0);
        }
}
template <bool TWO> __device__ __forceinline__ void na_qk(f32x16& n0, f32x16& n1, LAS const unsigned char* kimg, const int (&koff)[4], const bf16x8 (&qr)[4]) {
#pragma unroll
    for (int r = 0; r < 16; ++r) { n0[r] = 0.f; if (TWO) n1[r] = 0.f; }
#pragma unroll
    for (int d0 = 0; d0 < 4; ++d0) {
        n0 = __builtin_amdgcn_mfma_f32_32x32x16_bf16(*(LAS const bf16x8*)(kimg + koff[d0]), qr[d0], n0, 0, 0, 0);
        if (TWO) n1 = __builtin_amdgcn_mfma_f32_32x32x16_bf16(*(LAS const bf16x8*)(kimg + koff[d0] + 4096), qr[d0], n1, 0, 0, 0);
    }
}
__device__ __forceinline__ void na_rescale(NaState& st, LAS float* wsf, float alpha, float m_use, int r32, int hi) {
    if (hi == 0) wsf[r32] = alpha;
#pragma unroll
    for (int r = 0; r < 16; ++r) { const float a = wsf[crow(r, hi)]; st.o[0][r] *= a; st.o[1][r] *= a; }
    st.l *= alpha; st.m = m_use;
}
__device__ __forceinline__ void na_unit(const Params& p, LAS unsigned char* lds, const int tid_in, int b, int hh, int rg4) {
    int tid = tid_in; asm volatile("" : "+v"(tid));
    const int lane = tid & 63, r32 = lane & 31, hi = lane >> 5, wid = __builtin_amdgcn_readfirstlane(tid >> 6), pr = wid >> 2, cb = wid & 3;
    const bf16_t* qkv = (const bf16_t*)(p.ws + WS_QKV); bf16_t* mix = (bf16_t*)(p.ws + WS_MIX);
    LAS float* wsf = (LAS float*)(lds + OFF_WSF) + wid * 64;
    LAS float* rpbL = (LAS float*)(lds + OFF_RPB);
    const int r0 = 4 * rg4;
    const int lo0 = min(max(r0 - 4, 0), 24), hi0 = min(max(r0 - 3, 0), 24) + 7, lo1 = min(max(r0 - 2, 0), 24), hi1 = min(max(r0 - 1, 0), 24) + 7;
    const int d = lo1 - lo0, nrows = hi1 - lo0 + 1, n0c = hi0 - lo0 + 1, n1c = hi1 - lo1 + 1, S_lat = max(n0c, n1c), ntiles = nrows + 4;
    const int off = pr ? d : 0, np = pr ? n1c : n0c;
    const NaCtx c{qkv, (const bf16_t*)(p.ws + WS_KVC), b, hh, lo0, nrows, (unsigned)(uintptr_t)lds, wid, lane};
    for (int i = 0; i < d + 3; ++i) tile_dma<false>(na_tile(c, i), c.lds0 + (i & 7) * NA_SLOT, wid, lane);
    if (tid < 465) rpbL[tid] = p.rpb[hh * 465 + tid] * LOG2E;
    const int qrow = r0 + 2 * pr + (r32 >> 4), jq = 16 * cb + (r32 & 15), kc0 = (cb == 0) ? 0 : (cb == 1) ? 8 : (cb == 2) ? 24 : 32;
    const int qstart = min(max(qrow - 4, 0), 24), cs = min(max(jq - 8, 0), 48);
    NaState st;
#pragma unroll
    for (int d0 = 0; d0 < 4; ++d0) st.qr[d0] = *(const bf16x8*)(qkv + (size_t)(b * SEQ + qrow * 64 + jq) * NQKV + 512 + 64 * hh + 8 * hi + 16 * d0);
#pragma unroll
    for (int r = 0; r < 16; ++r) { st.o[0][r] = 0.f; st.o[1][r] = 0.f; }
#pragma unroll
    for (int s = 0; s < 4; ++s) st.pw[s] = (u32x4){0u, 0u, 0u, 0u};
    st.m = NEGBIG; st.l = 0.f;
    unsigned cmask = 0u;
#pragma unroll
    for (int r = 0; r < 16; ++r) { const int jk = kc0 + crow(r, hi); if (jk >= cs && jk < cs + 16) cmask |= 1u << r; }
    int koffL[4], koffC[4], vbL[2], vbC[2];
    {   const int q = (lane & 15) >> 2, g1 = (lane >> 4) & 1, pp = lane & 3, keyL = kc0 + r32;
#pragma unroll
        for (int d0 = 0; d0 < 4; ++d0) { koffL[d0] = keyL * 128 + (((2 * d0 + hi) ^ ((keyL >> 1) & 7)) << 4); koffC[d0] = r32 * 128 + (((2 * d0 + hi) ^ ((r32 >> 1) & 7)) << 4); }
#pragma unroll
        for (int cc = 0; cc < 2; ++cc) { vbC[cc] = (4 * hi + q) * 128 + ((cc ^ ((q >> 1) & 1)) << 6) + g1 * 32 + pp * 8; vbL[cc] = vbC[cc] + kc0 * 128; } }
    const int bias_base = 15 - jq + kc0 + 4 * hi;
    asm volatile("s_waitcnt vmcnt(2) lgkmcnt(0)\n\ts_barrier" ::: "memory");
    na_qk<false>(st.s0, st.s1, lds + (off & 7) * NA_SLOT, koffL, st.qr);
    for (int s = 0; s < S_lat; ++s) {
        if (s + d + 3 < ntiles) tile_dma<false>(na_tile(c, s + d + 3), c.lds0 + ((s + d + 3) & 7) * NA_SLOT, wid, lane);
        const bool live = s < np;
        const int ic = off + (live ? s : np - 1), ipv = off + (s ? min(s, np) - 1 : 0), inx = off + min(s + 1, np - 1);
        const int kr = lo0 + ic;
        {   const bool rowok = live && kr >= qstart && kr < qstart + 8;
            LAS const float* bp = rpbL + (kr - qrow + 7) * 31 + bias_base;
#pragma unroll
            for (int r = 0; r < 16; ++r) { const float bv = bp[(r & 3) + 8 * (r >> 2)]; st.s0[r] = (rowok && ((cmask >> r) & 1u)) ? st.s0[r] + bv : MASKV; } }
        float mx = max3f(st.s0[0], st.s0[1], st.s0[2]);
#pragma unroll
        for (int r = 3; r < 15; r += 2) mx = max3f(mx, st.s0[r], st.s0[r + 1]);
        mx = max3f(mx, st.s0[15], st.s0[15]);
        { auto rr = __builtin_amdgcn_permlane32_swap(__float_as_uint(mx), __float_as_uint(mx), false, false); mx = max3f(__uint_as_float(rr[0]), __uint_as_float(rr[1]), __uint_as_float(rr[1])); }
        const bool need = __any(mx > st.m + THR);
        const float m_use = need ? fmaxf(st.m, mx) : st.m, alpha = __builtin_amdgcn_exp2f(st.m - m_use);
        u32x4 pwn[2]; float rs = 0.f;
        {   float e[16];
#pragma unroll
            for (int r = 0; r < 16; ++r) { e[r] = __builtin_amdgcn_exp2f(st.s0[r] - m_use); rs += e[r]; }
#pragma unroll
            for (int i = 0; i < 4; ++i) { pwn[0][i] = pk2(e[2 * i], e[2 * i + 1]); pwn[1][i] = pk2(e[8 + 2 * i], e[9 + 2 * i]); } }
        f32x16 n0, n1;
        na_pv<2>(st, lds + (ipv & 7) * NA_SLOT + 8192, vbL);
        na_qk<false>(n0, n1, lds + (inx & 7) * NA_SLOT, koffL, st.qr);
        __builtin_amdgcn_sched_group_barrier(0x100, 4, 0);
#pragma unroll
        for (int i = 0; i < 8; ++i) { __builtin_amdgcn_sched_group_barrier(0x008, 1, 0); __builtin_amdgcn_sched_group_barrier(0x100, 2, 0); __builtin_amdgcn_sched_group_barrier(0x402, 12, 0); }
        asm volatile("" : "+v"(pwn[0]), "+v"(pwn[1]), "+v"(rs));
        if (need) na_rescale(st, wsf, alpha, m_use, r32, hi);
        st.l += rs; st.pw[0] = pwn[0]; st.pw[1] = pwn[1]; st.s0 = n0;
        if (s + d + 3 < ntiles) asm volatile("s_waitcnt vmcnt(2) lgkmcnt(0)\n\ts_barrier" ::: "memory");
        else asm volatile("s_waitcnt vmcnt(0) lgkmcnt(0)\n\ts_barrier" ::: "memory");
    }
    na_pv<2>(st, lds + ((off + np - 1) & 7) * NA_SLOT + 8192, vbL);
    na_qk<true>(st.s0, st.s1, lds + (nrows & 7) * NA_SLOT, koffC, st.qr);
#pragma unroll
    for (int s = 0; s < 4; ++s) st.pw[s] = (u32x4){0u, 0u, 0u, 0u};
    for (int cs4 = 0; cs4 < 4; ++cs4) {
        const int gs = S_lat + cs4;
        if (gs + d + 3 < ntiles) tile_dma<false>(na_tile(c, gs + d + 3), c.lds0 + ((gs + d + 3) & 7) * NA_SLOT, wid, lane);
        const int ipv = nrows + (cs4 ? cs4 - 1 : 0), inx = nrows + min(cs4 + 1, 3);
        const float mx = rowmax32(st.s0, st.s1);
        const bool need = __any(mx > st.m + THR);
        const float m_use = need ? fmaxf(st.m, mx) : st.m, alpha = __builtin_amdgcn_exp2f(st.m - m_use);
        u32x4 pwn[4]; float rs; f32x16 n0, n1;
        exp_pack(st.s0, st.s1, m_use, pwn, rs);
        na_pv<4>(st, lds + (ipv & 7) * NA_SLOT + 8192, vbC);
        na_qk<true>(n0, n1, lds + (inx & 7) * NA_SLOT, koffC, st.qr);
        __builtin_amdgcn_sched_group_barrier(0x100, 6, 0);
#pragma unroll
        for (int i = 0; i < 16; ++i) { __builtin_amdgcn_sched_group_barrier(0x008, 1, 0); __builtin_amdgcn_sched_group_barrier(0x100, 2, 0); __builtin_amdgcn_sched_group_barrier(0x402, 8, 0); }
        asm volatile("" : "+v"(pwn[0]), "+v"(pwn[1]), "+v"(pwn[2]), "+v"(pwn[3]), "+v"(rs));
        if (need) na_rescale(st, wsf, alpha, m_use, r32, hi);
        st.l += rs;
#pragma unroll
        for (int s = 0; s < 4; ++s) st.pw[s] = pwn[s];
        st.s0 = n0; st.s1 = n1;
        if (gs + d + 3 < ntiles) asm volatile("s_waitcnt vmcnt(2) lgkmcnt(0)\n\ts_barrier" ::: "memory");
        else asm volatile("s_waitcnt vmcnt(0) lgkmcnt(0)\n\ts_barrier" ::: "memory");
    }
    na_pv<4>(st, lds + ((nrows + 3) & 7) * NA_SLOT + 8192, vbC);
    asm volatile("s_waitcnt vmcnt(0) lgkmcnt(0)\n\ts_barrier" ::: "memory");
    {   int tid2 = tid; asm volatile("" : "+v"(tid2));
        const int lane2 = tid2 & 63, r32b = lane2 & 31, hib = lane2 >> 5;
        float lt = st.l + __shfl_xor(st.l, 32);
        if (hib == 0) wsf[r32b] = 1.0f / lt;
        LAS float* stg = (LAS float*)(lds + OFF_STAGE) + wid * (32 * 68);
#pragma unroll
        for (int r = 0; r < 16; ++r) { const float inv = wsf[crow(r, hib)];
#pragma unroll
            for (int cc = 0; cc < 2; ++cc) stg[crow(r, hib) * 68 + 32 * cc + r32b] = st.o[cc][r] * inv; }
        const int row = lane2 >> 1, half = lane2 & 1;
        bf16_t* dst = mix + (size_t)(b * SEQ + (r0 + 2 * pr + (row >> 4)) * 64 + 16 * cb + (row & 15)) * DM + 512 + 64 * hh + half * 32;
#pragma unroll
        for (int i = 0; i < 4; ++i) { const f32x4 a = *(LAS const f32x4*)(stg + row * 68 + half * 32 + 8 * i), c4 = *(LAS const f32x4*)(stg + row * 68 + half * 32 + 8 * i + 4);
            u32x4 w; w.x = pk2(a.x, a.y); w.y = pk2(a.z, a.w); w.z = pk2(c4.x, c4.y); w.w = pk2(c4.z, c4.w);
            *(u32x4*)(dst + 8 * i) = w; }
        asm volatile("s_waitcnt vmcnt(0)" ::: "memory");
        __syncthreads();
    }
}
}
__device__ __forceinline__ void phase_attn(const Params& p, LAS unsigned char* lds) {
    const int G = (int)gridDim.x, bx = (int)blockIdx.x, vcu = (G % 8 == 0) ? (bx % 8) * (G / 8) + bx / 8 : bx;
    const float lam = *(const float*)(p.ws + WS_LAM);
    const int tid = opaque_tid();
    for (int u = vcu; u < 2048; u += G) att::diff_unit(p, lds, tid, u >> 6, (u >> 4) & 3, u & 15, lam);
    for (int u = vcu; u < 2048; u += G) att::na_unit(p, lds, tid, u >> 6, (u >> 3) & 7, u & 7);
}

__device__ __forceinline__ void phase_final(const Params& p, int gw, int NGW, int lane) {
    const float* ssq2 = (const float*)(p.ws + WS_SSQ2);
    for (int row = gw; row < MLAT; row += NGW) {
        const float sv = (lane < 16) ? ssq2[(size_t)row * 16 + lane] : 0.f;
        const float rstd = rsqrtf(wave_sum(sv) * (1.0f / DM) + EPS);
        float* o = p.out + (size_t)row * DM;
#pragma unroll
        for (int j = 0; j < 4; ++j) { const int col = 4 * lane + 256 * j; const f32x4 v = *(const f32x4*)(o + col), g = *(const f32x4*)(p.final_g + col); __builtin_nontemporal_store(v * rstd * g, (f32x4*)(o + col)); }
    }
}

constexpr int LDS_MISC = 163840 - 64;
constexpr int CW_BAR = 4096;
#define RLX_AGENT __ATOMIC_RELAXED, __HIP_MEMORY_SCOPE_AGENT
#define XB_TMO      128
#define XB_XCNT(j)  (256  + 64 * (j))
#define XB_XSUB(j)  (1280 + 64 * (j))
#define XB_XGEN(j)  (2304 + 64 * (j))
#define XB_TOP      3328
#define XB_TOPGEN   3392
#define XCD_BAR_WORDS 3456
#define XB_SPIN_CAP (1u << 18)

__device__ __forceinline__ unsigned xb_ld(unsigned* p)              { return __hip_atomic_load(p, __ATOMIC_RELAXED, __HIP_MEMORY_SCOPE_AGENT); }
__device__ __forceinline__ unsigned xb_add(unsigned* p, unsigned v) { return __hip_atomic_fetch_add(p, v, __ATOMIC_RELAXED, __HIP_MEMORY_SCOPE_AGENT); }
__device__ __forceinline__ unsigned xb_xcc_id() { return (unsigned)__builtin_amdgcn_s_getreg((3 << 11) | 20) & 0xFu; }
#define XB_SPIN(cond, bar) do { unsigned _sp = 0; while (cond) { __builtin_amdgcn_s_sleep(1); \
    if ((++_sp & 255u) == 0u) { if (xb_ld(&(bar)[XB_TMO])) break; if (_sp > XB_SPIN_CAP) { atomicAdd(&(bar)[XB_TMO], 1u); break; } } } } while (0)

struct XcdBarrier {
    unsigned* bar; unsigned x;
    volatile LAS unsigned* st;
};

__device__ __forceinline__ XcdBarrier xcd_barrier_post(unsigned* bar, volatile LAS unsigned* st) {
    XcdBarrier b; b.bar = bar; b.x = xb_xcc_id(); b.st = st;
    if (threadIdx.x == 0) (void)xb_add(&bar[XB_XCNT(b.x)], 1u);
    return b;
}
__device__ __forceinline__ void xcd_barrier_complete(unsigned* bar, unsigned x, unsigned& nloc, unsigned& nx) {
    const unsigned G = gridDim.x * gridDim.y * gridDim.z;
    unsigned sum, cnt, mine, sp = 0u;
    for (;;) {
        sum = 0u; cnt = 0u; mine = 0u;
#pragma unroll
        for (unsigned j = 0; j < 16; ++j) { const unsigned c = xb_ld(&bar[XB_XCNT(j)]); sum += c; cnt += (c > 0u) ? 1u : 0u; mine = (j == x) ? c : mine; }
        if (sum == G) break;
        __builtin_amdgcn_s_sleep(1);
        if ((++sp & 255u) == 0u) { if (xb_ld(&bar[XB_TMO])) break; if (sp > XB_SPIN_CAP) { atomicAdd(&bar[XB_TMO], 1u); break; } }
    }
    nloc = mine > 0u ? mine : 1u; nx = cnt > 0u ? cnt : 1u;
}

__device__ __forceinline__ void xcd_barrier(const XcdBarrier& b) {
    asm volatile("s_waitcnt vmcnt(0)" ::: "memory");
    __syncthreads();
    if (threadIdx.x == 0) {
        unsigned* bar = b.bar;
        __builtin_amdgcn_s_waitcnt(0);
        unsigned nloc = b.st[0], nx = b.st[1];
        if (nloc == 0u) { xcd_barrier_complete(bar, b.x, nloc, nx); b.st[0] = nloc; b.st[1] = nx; }
        const unsigned old = xb_add(&bar[XB_XSUB(b.x)], 1u);
        const unsigned gen = old / nloc;
        if (old + 1u == (gen + 1u) * nloc) {
            __builtin_amdgcn_fence(__ATOMIC_RELEASE, "agent");
            asm volatile("s_waitcnt vmcnt(0)" ::: "memory");
            const unsigned og = xb_add(&bar[XB_TOP], 1u);
            const unsigned tg = og / nx;
            if (og + 1u == (tg + 1u) * nx) xb_add(&bar[XB_TOPGEN], 1u);
            else XB_SPIN(xb_ld(&bar[XB_TOPGEN]) == tg, bar);
            __builtin_amdgcn_fence(__ATOMIC_ACQUIRE, "agent");
            xb_add(&bar[XB_XGEN(b.x)], 1u);
            asm volatile("s_waitcnt vmcnt(0)" ::: "memory");
        } else {
            XB_SPIN(xb_ld(&bar[XB_XGEN(b.x)]) == gen, bar);
            __builtin_amdgcn_fence(__ATOMIC_ACQUIRE, "agent");
            asm volatile("s_waitcnt vmcnt(0)" ::: "memory");
        }
    }
    __syncthreads();
}

typedef const Params __attribute__((address_space(4))) CParams;
__device__ __forceinline__ Params kparams() {
#if defined(__HIP_DEVICE_COMPILE__)
    CParams* k = (CParams*)__builtin_amdgcn_kernarg_segment_ptr(); asm volatile("" : "+s"(k)); return *k;
#else
    return Params{};
#endif
}
#define PH_IDS const int tid_ = opaque_tid(), wid = tid_ >> 6, lane = tid_ & 63, gw = blockIdx.x * 8 + wid, NGW = gridDim.x * 8
__global__ __launch_bounds__(512, 2) void k_mega(Params p_unused) {
    extern __shared__ __attribute__((aligned(16))) unsigned char lds[];
    volatile LAS unsigned* MISC = (volatile LAS unsigned*)((LAS unsigned char*)lds + LDS_MISC);
    if (threadIdx.x < 16) MISC[threadIdx.x] = 0u;
    __syncthreads();
    XcdBarrier bar;
    { const Params p = kparams(); bar = xcd_barrier_post((unsigned*)(p.ws + WS_CTL) + CW_BAR, MISC); }
#define SEAM() xcd_barrier(bar)
    { const Params p = kparams(); PH_IDS; phase_prep_a(p, (float*)lds + wid * 2112, gw, NGW, lane); }
    SEAM();
    { const Params p = kparams(); PH_IDS; phase_prep_b(p, (float*)lds + wid * 2112, gw, NGW, lane); }
    SEAM();
    { const Params p = kparams(); phase_qkv(p, (LAS unsigned char*)lds); }
    SEAM();
    { const Params p = kparams(); phase_attn(p, (LAS unsigned char*)lds); }
    SEAM();
    { const Params p = kparams(); phase_outproj(p, (LAS unsigned char*)lds); }
    SEAM();
    { const Params p = kparams(); phase_rstd1(p); }
    SEAM();
    { const Params p = kparams(); phase_fc1(p, (LAS unsigned char*)lds); }
    SEAM();
    { const Params p = kparams(); phase_fc2(p, (LAS unsigned char*)lds); }
    SEAM();
    { const Params p = kparams(); PH_IDS; phase_final(p, gw, NGW, lane); }
}

extern "C" void kernel_launch(void* const* d_in, const int* in_sizes, int n_in, void* d_out, int out_size, void* d_ws, size_t ws_size, hipStream_t stream) {
    if (n_in != 19 || in_sizes[0] != MLAT * DM || out_size != MLAT * DM || ws_size < WS_END) {
        fprintf(stderr, "kernel_launch: unexpected shapes: n_in %d in0 %d out %d ws %zu (need %zu)\n", n_in, n_in > 0 ? in_sizes[0] : -1, out_size, ws_size, (size_t)WS_END);
        return;
    }
    Params p{};
    const float** pf = (const float**)&p;
    for (int i = 0; i < 19; ++i) pf[i] = (const float*)d_in[i];
    p.out = (float*)d_out; p.ws = (unsigned char*)d_ws;
    unsigned char* ws = p.ws;
    static int grid_blocks = 0;
    if (grid_blocks == 0) {
        int dev = 0, cus = 0, per_cu = 0;
        (void)hipGetDevice(&dev);
        (void)hipDeviceGetAttribute(&cus, hipDeviceAttributeMultiprocessorCount, dev);
        (void)hipFuncSetAttribute((const void*)k_mega, hipFuncAttributeMaxDynamicSharedMemorySize, LDS_BYTES);
        (void)hipOccupancyMaxActiveBlocksPerMultiprocessor(&per_cu, (const void*)k_mega, 512, LDS_BYTES);
        if (per_cu < 1) { fprintf(stderr, "kernel_launch: occupancy query reports %d blocks per CU\n", per_cu); per_cu = 1; }
        grid_blocks = cus;
        (void)hipGetLastError();
    }
    (void)hipMemsetAsync(ws, 0, WS_ZERO_BYTES, stream);
    void* args[] = {&p};
    hipError_t e = hipLaunchCooperativeKernel((const void*)k_mega, dim3(grid_blocks), dim3(512), args, LDS_BYTES, stream);
    if (e != hipSuccess) fprintf(stderr, "kernel_launch: cooperative launch failed: %s (grid %d)\n", hipGetErrorString(e), grid_blocks);
}
```
